# Optimizing an MI355X kernel written in HIP

```python
import math
import jax
import jax.numpy as jnp
from jax import lax
import numpy as np


D_MODEL = 1024
BATCH = 4
SEQ = 8192
DEPTH = 2

HEAD_DIM = 64
EPS = 1e-6
WIN_Q_HEADS = 6
WIN_KV_HEADS = 2
WIN_GROUP = WIN_Q_HEADS // WIN_KV_HEADS
WINDOW = 128
WIN_BLOCK = WINDOW
DIFF_HEADS = 4
DIFF_QK_DIM = HEAD_DIM // 2
DIFF_V_DIM = HEAD_DIM
Q_BLOCK = 128
DN_HEADS = 6
DN_DK = HEAD_DIM
DN_DV = HEAD_DIM
DN_CHUNK = 64
CONV_W = 5
WIN_WIDTH = WIN_Q_HEADS * HEAD_DIM
DIFF_WIDTH = DIFF_HEADS * DIFF_V_DIM
DN_WIDTH = DN_HEADS * DN_DV
MIX_WIDTH = WIN_WIDTH + DIFF_WIDTH + DN_WIDTH
IN_SPLITS = (
    WIN_Q_HEADS * HEAD_DIM,
    WIN_KV_HEADS * HEAD_DIM,
    WIN_KV_HEADS * HEAD_DIM,
    DIFF_HEADS * 2 * DIFF_QK_DIM,
    DIFF_HEADS * 2 * DIFF_QK_DIM,
    DIFF_HEADS * DIFF_V_DIM,
    DN_HEADS * (2 * DN_DK + DN_DV),
    DN_HEADS * DN_DV,
    2 * DN_HEADS,
    2 * DN_HEADS,
)
MIX_IN = sum(IN_SPLITS)
D_FF = 2752

kernel_name = 'hybrid_parallel_head_encoder'


def rms_norm(x, g):
    xf = x.astype(jnp.float32)
    y = xf * lax.rsqrt(jnp.mean(xf * xf, axis=-1, keepdims=True) + EPS)
    return (y * g.astype(jnp.float32)).astype(x.dtype)


def l2_norm(x):
    xf = x.astype(jnp.float32)
    return xf * lax.rsqrt(jnp.sum(xf * xf, axis=-1, keepdims=True) + EPS)


def swiglu(h, w_in, w_out):
    gate, up = jnp.split(h @ w_in, 2, axis=-1)
    return (jax.nn.silu(gate) * up) @ w_out


def alibi_slopes(n):
    return 2.0 ** (-8.0 * jnp.arange(1, n + 1, dtype=jnp.float32) / n)


def window_attention(q, k, v, sink, slopes):
    B, S, KH, G, d = q.shape
    nb = S // WIN_BLOCK
    kw_len = 3 * WIN_BLOCK

    def band(t):
        tp = jnp.pad(t, ((0, 0), (WIN_BLOCK, WIN_BLOCK), (0, 0), (0, 0)))
        tb = tp.reshape(B, nb + 2, WIN_BLOCK, KH, d)
        return jnp.concatenate([tb[:, :-2], tb[:, 1:-1], tb[:, 2:]], axis=2)

    kw, vw = band(k), band(v)
    qb = q.reshape(B, nb, WIN_BLOCK, KH, G, d)
    rel = jnp.arange(kw_len)[None, :] - WIN_BLOCK - jnp.arange(WIN_BLOCK)[:, None]
    kpos = jnp.arange(nb)[:, None] * WIN_BLOCK - WIN_BLOCK + jnp.arange(kw_len)[None, :]
    valid = (jnp.abs(rel) <= WINDOW)[None] & ((kpos >= 0) & (kpos < S))[:, None, :]
    dist = jnp.abs(rel).astype(jnp.float32)
    s = jnp.einsum('bnqhgd,bnkhd->bnhgqk', qb, kw).astype(jnp.float32) * (d ** -0.5)
    s = s - slopes[:, :, None, None] * dist
    s = jnp.where(valid[None, :, None, None], s, -1e30)
    sink_b = sink.astype(jnp.float32)[:, :, None, None]
    m = jnp.maximum(jnp.max(s, axis=-1, keepdims=True), sink_b)
    e = jnp.exp(s - m)
    p = e / (jnp.sum(e, axis=-1, keepdims=True) + jnp.exp(sink_b - m))
    o = jnp.einsum('bnhgqk,bnkhd->bnqhgd', p.astype(v.dtype), vw)
    return o.reshape(B, S, KH * G * d)


def diff_attention(q, k, v, lam, slopes):
    B, S, H, _, dq = q.shape
    dv = v.shape[-1]
    nb = S // Q_BLOCK
    qb = jnp.moveaxis(q.reshape(B, nb, Q_BLOCK, H, 2, dq), 1, 0)
    kpos = jnp.arange(S)

    def one_block(args):
        q_blk, i = args
        qpos = i * Q_BLOCK + jnp.arange(Q_BLOCK)
        dist = jnp.abs(qpos[:, None] - kpos[None, :]).astype(jnp.float32)
        s = jnp.einsum('bqhmd,bkhmd->bhmqk', q_blk, k).astype(jnp.float32) * (dq ** -0.5)
        s = s - slopes[:, None, None, None] * dist
        p = jax.nn.softmax(s, axis=-1)
        pd = p[:, :, 0] - lam * p[:, :, 1]
        return jnp.einsum('bhqk,bkhd->bqhd', pd.astype(v.dtype), v)

    o = lax.map(one_block, (qb, jnp.arange(nb)))
    return jnp.moveaxis(o, 0, 1).reshape(B, S, H, dv)


def short_conv(x, w):
    return lax.conv_general_dilated(
        x, w[:, None, :].astype(x.dtype), window_strides=(1,),
        padding=[(CONV_W // 2, CONV_W // 2)],
        dimension_numbers=('NWC', 'WIO', 'NWC'),
        feature_group_count=x.shape[-1])


def gated_delta_chunked(q, k, v, beta, g):
    B, S, H, dk = q.shape
    dv = v.shape[-1]
    C = DN_CHUNK
    n = S // C
    f32 = jnp.float32
    ch = lambda t: t.astype(f32).reshape(B, n, C, H, t.shape[-1]).transpose(0, 3, 1, 2, 4)
    chs = lambda t: t.astype(f32).reshape(B, n, C, H).transpose(0, 3, 1, 2)
    qc, kc, vc = ch(q), ch(k), ch(v)
    bc, gc = chs(beta), jnp.cumsum(chs(g), axis=-1)
    tril = jnp.tri(C, dtype=bool)
    tril_strict = jnp.tri(C, k=-1, dtype=bool)
    gdiff = gc[..., :, None] - gc[..., None, :]
    decay = jnp.where(tril, jnp.exp(jnp.where(tril, gdiff, 0.0)), 0.0)
    kb = kc * bc[..., None]
    vb = vc * bc[..., None]
    m_low = jnp.where(tril_strict, jnp.einsum('bhncd,bhnsd->bhncs', kb, kc) * decay, 0.0)
    a_mat = jnp.eye(C, dtype=f32) + m_low
    u = lax.linalg.triangular_solve(a_mat, vb, left_side=True, lower=True, unit_diagonal=True)
    w = lax.linalg.triangular_solve(a_mat, kb * jnp.exp(gc)[..., None], left_side=True,
                                    lower=True, unit_diagonal=True)
    qk = jnp.where(tril, jnp.einsum('bhncd,bhnsd->bhncs', qc, kc) * decay, 0.0)
    q_g = qc * jnp.exp(gc)[..., None]
    k_g = kc * jnp.exp(gc[..., -1:] - gc)[..., None]
    g_last = jnp.exp(gc[..., -1])

    def step(state, inp):
        u_i, w_i, qk_i, qg_i, kg_i, gl_i = inp
        v_new = u_i - jnp.einsum('bhck,bhkv->bhcv', w_i, state)
        o_i = jnp.einsum('bhck,bhkv->bhcv', qg_i, state) + jnp.einsum('bhcs,bhsv->bhcv', qk_i, v_new)
        state = state * gl_i[..., None, None] + jnp.einsum('bhck,bhcv->bhkv', kg_i, v_new)
        return state, o_i

    mv = lambda t: jnp.moveaxis(t, 2, 0)
    state0 = jnp.zeros((B, H, dk, dv), f32)
    _, o = lax.scan(step, state0, (mv(u), mv(w), mv(qk), mv(q_g), mv(k_g), mv(g_last)))
    o = o.transpose(1, 0, 3, 2, 4).reshape(B, S, H, dv)
    return o.astype(v.dtype)


def hybrid_mixer(h, w_in, conv_w, sink, diff_lam, diff_g, a_log, dt_bias, dn_g, w_out, lam_init):
    B, S, _ = h.shape
    f32 = jnp.float32
    cuts = [int(c) for c in np.cumsum(IN_SPLITS)[:-1]]
    (wq, wk, wv, dq, dk, dv, dn_qkv, dn_z, dn_beta, dn_a) = jnp.split(h @ w_in, cuts, axis=-1)

    o_win = window_attention(
        wq.reshape(B, S, WIN_KV_HEADS, WIN_GROUP, HEAD_DIM),
        wk.reshape(B, S, WIN_KV_HEADS, HEAD_DIM),
        wv.reshape(B, S, WIN_KV_HEADS, HEAD_DIM),
        sink.reshape(WIN_KV_HEADS, WIN_GROUP),
        alibi_slopes(WIN_Q_HEADS).reshape(WIN_KV_HEADS, WIN_GROUP))

    lq1, lk1, lq2, lk2 = diff_lam.astype(f32)
    lam = jnp.exp(jnp.sum(lq1 * lk1)) - jnp.exp(jnp.sum(lq2 * lk2)) + lam_init
    o_d = diff_attention(
        dq.reshape(B, S, DIFF_HEADS, 2, DIFF_QK_DIM),
        dk.reshape(B, S, DIFF_HEADS, 2, DIFF_QK_DIM),
        dv.reshape(B, S, DIFF_HEADS, DIFF_V_DIM),
        lam, alibi_slopes(DIFF_HEADS))
    o_diff = (rms_norm(o_d, diff_g) * (1.0 - lam_init)).reshape(B, S, DIFF_WIDTH)

    qkv = jax.nn.silu(short_conv(dn_qkv, conv_w))
    q, k, v = jnp.split(qkv, [DN_HEADS * DN_DK, 2 * DN_HEADS * DN_DK], axis=-1)
    q = (l2_norm(q.reshape(B, S, DN_HEADS, DN_DK)) * (DN_DK ** -0.5)).astype(h.dtype)
    k = l2_norm(k.reshape(B, S, DN_HEADS, DN_DK)).astype(h.dtype)
    v = v.reshape(B, S, DN_HEADS, DN_DV)
    beta = jax.nn.sigmoid(dn_beta.astype(f32)).reshape(B, S, 2, DN_HEADS)
    g = -jnp.exp(a_log.astype(f32)) * jax.nn.softplus(
        dn_a.astype(f32).reshape(B, S, 2, DN_HEADS) + dt_bias.astype(f32))
    o_fwd = gated_delta_chunked(q, k, v, beta[:, :, 0], g[:, :, 0])
    flip = lambda t: jnp.flip(t, axis=1)
    o_bwd = flip(gated_delta_chunked(flip(q), flip(k), flip(v), flip(beta[:, :, 1]), flip(g[:, :, 1])))
    o_c = o_fwd + o_bwd
    o_dn = (rms_norm(o_c, dn_g) * jax.nn.silu(dn_z.reshape(B, S, DN_HEADS, DN_DV))).reshape(B, S, DN_WIDTH)

    o = jnp.concatenate([o_win, o_diff.astype(h.dtype), o_dn.astype(h.dtype)], axis=-1)
    return o @ w_out


def setup_inputs(seed: int = 0) -> dict:
    key = jax.random.key(seed)
    ks = jax.random.split(key, 20)
    f32 = jnp.float32

    def dense(k, shape, fan_in):
        return jax.random.normal(k, shape, f32) * fan_in ** -0.5

    def gain(k, shape):
        return 1.0 + 0.02 * jax.random.normal(k, shape, f32)

    x = jax.random.normal(ks[0], (BATCH, SEQ, D_MODEL), f32)
    ln_ffn1 = gain(ks[1], (DEPTH, D_MODEL))
    ffn1_w_in = dense(ks[2], (DEPTH, D_MODEL, 2 * D_FF), D_MODEL)
    ffn1_w_out = dense(ks[3], (DEPTH, D_FF, D_MODEL), D_FF)
    ln_mix = gain(ks[4], (DEPTH, D_MODEL))
    w_mix_in = dense(ks[5], (DEPTH, D_MODEL, MIX_IN), D_MODEL)
    conv_w = dense(ks[6], (DEPTH, CONV_W, DN_HEADS * (2 * DN_DK + DN_DV)), CONV_W)
    sink_logits = 0.5 * jax.random.normal(ks[7], (DEPTH, WIN_Q_HEADS), f32)
    diff_lambda = 0.1 * jax.random.normal(ks[8], (DEPTH, 4, DIFF_QK_DIM), f32)
    diff_norm_g = gain(ks[9], (DEPTH, DIFF_V_DIM))
    dn_A_log = jnp.log(jax.random.uniform(ks[10], (DEPTH, 2, DN_HEADS), f32, 1.0, 16.0))
    dt = jnp.exp(jax.random.uniform(ks[11], (DEPTH, 2, DN_HEADS), f32, math.log(1e-3), math.log(1e-1)))
    dn_dt_bias = dt + jnp.log(-jnp.expm1(-dt))
    dn_norm_g = gain(ks[12], (DEPTH, DN_DV))
    w_mix_out = dense(ks[13], (DEPTH, MIX_WIDTH, D_MODEL), MIX_WIDTH)
    ln_ffn2 = gain(ks[14], (DEPTH, D_MODEL))
    ffn2_w_in = dense(ks[15], (DEPTH, D_MODEL, 2 * D_FF), D_MODEL)
    ffn2_w_out = dense(ks[16], (DEPTH, D_FF, D_MODEL), D_FF)
    ln_final = gain(ks[17], (D_MODEL,))
    return {'x': x, 'ln_ffn1': ln_ffn1, 'ffn1_w_in': ffn1_w_in, 'ffn1_w_out': ffn1_w_out,
            'ln_mix': ln_mix, 'w_mix_in': w_mix_in, 'conv_w': conv_w, 'sink_logits': sink_logits,
            'diff_lambda': diff_lambda, 'diff_norm_g': diff_norm_g, 'dn_A_log': dn_A_log,
            'dn_dt_bias': dn_dt_bias, 'dn_norm_g': dn_norm_g, 'w_mix_out': w_mix_out,
            'ln_ffn2': ln_ffn2, 'ffn2_w_in': ffn2_w_in, 'ffn2_w_out': ffn2_w_out, 'ln_final': ln_final}


def reference(x, ln_ffn1, ffn1_w_in, ffn1_w_out, ln_mix, w_mix_in, conv_w, sink_logits,
              diff_lambda, diff_norm_g, dn_A_log, dn_dt_bias, dn_norm_g, w_mix_out,
              ln_ffn2, ffn2_w_in, ffn2_w_out, ln_final):
    for l in range(DEPTH):
        lam_init = 0.8 - 0.6 * math.exp(-0.3 * l)
        x = x + 0.5 * swiglu(rms_norm(x, ln_ffn1[l]), ffn1_w_in[l], ffn1_w_out[l])
        h = rms_norm(x, ln_mix[l])
        x = x + hybrid_mixer(h, w_mix_in[l], conv_w[l], sink_logits[l], diff_lambda[l],
                             diff_norm_g[l], dn_A_log[l], dn_dt_bias[l], dn_norm_g[l],
                             w_mix_out[l], lam_init)
        x = x + 0.5 * swiglu(rms_norm(x, ln_ffn2[l]), ffn2_w_in[l], ffn2_w_out[l])
    return rms_norm(x, ln_final)
```

```cpp
#include <hip/hip_runtime.h>
#include <hip/hip_cooperative_groups.h>
#include <cstdio>
namespace cg = cooperative_groups;


#ifndef REPMASK
#define REPMASK 0
#endif
#define REP(k) for (int rep_ = 0; rep_ < (((REPMASK >> (k)) & 1) ? 2 : 1); ++rep_)
#ifndef MULTI
#define MULTI 0
#endif

#ifdef ONLY
#define EN(k) (ONLY==(k))
#else
#define EN(k) 1
#endif
#define DI __device__ __forceinline__
#define LAS __attribute__((address_space(3)))
typedef unsigned short bf16_t;
typedef short bf16x8 __attribute__((ext_vector_type(8)));
typedef short s16x4 __attribute__((ext_vector_type(4)));
typedef float f32x4 __attribute__((ext_vector_type(4)));
typedef float f32x16 __attribute__((ext_vector_type(16)));
typedef float f32x2 __attribute__((ext_vector_type(2)));
typedef unsigned u32x4 __attribute__((ext_vector_type(4)));
typedef unsigned u32x2 __attribute__((ext_vector_type(2)));
typedef __bf16 bf16v2 __attribute__((ext_vector_type(2)));

constexpr int DM = 1024, NBATCH = 4, SEQ = 8192, MTOK = NBATCH * SEQ, DFF = 2752, DFFP = 2816, NFF = 2 * DFFP, NMIX = 3072;
constexpr int LDAB = 1792, LDC = 1280;
constexpr float EPS = 1e-6f, LOG2E = 1.4426950408889634f;
constexpr int LDS_BYTES = 131072;

constexpr size_t SZ_W_FFNIN = (size_t)NFF * DM * 2, SZ_W_FFNOUT = (size_t)DM * DFFP * 2, SZ_W_MIXIN = (size_t)NMIX * DM * 2, SZ_W_MIXOUT = (size_t)DM * DM * 2;
constexpr size_t OFF_W_FFN1IN = 0;
constexpr size_t OFF_W_FFN1OUT = OFF_W_FFN1IN + SZ_W_FFNIN;
constexpr size_t OFF_W_MIXIN = OFF_W_FFN1OUT + SZ_W_FFNOUT;
constexpr size_t OFF_W_MIXOUT = OFF_W_MIXIN + SZ_W_MIXIN;
constexpr size_t OFF_W_FFN2IN = OFF_W_MIXOUT + SZ_W_MIXOUT;
constexpr size_t OFF_W_FFN2OUT = OFF_W_FFN2IN + SZ_W_FFNIN;
constexpr size_t OFF_XB = OFF_W_FFN2OUT + SZ_W_FFNOUT;
constexpr size_t SZ_TILE = (size_t)3072 * 4096 * 2;
constexpr size_t OFF_QC = OFF_XB, OFF_KTC = OFF_XB + SZ_TILE;
constexpr size_t OFF_OB = OFF_XB + (size_t)MTOK * DM * 2;
constexpr size_t OFF_BIG = OFF_OB + (size_t)MTOK * DM * 2;
constexpr size_t OFF_PAB = OFF_BIG, OFF_PC = OFF_BIG + (size_t)MTOK * LDAB * 2;
constexpr size_t OFF_U = OFF_PC, OFF_WB = OFF_PC + (size_t)6144 * 8192;
constexpr size_t OFF_BG = OFF_WB + (size_t)6144 * 8192;
constexpr size_t OFF_RSS = OFF_BG + (size_t)MTOK * 24 * 4;
constexpr size_t OFF_VT = OFF_RSS + (size_t)2 * MTOK * 16 * 4;
constexpr size_t OFF_KC = OFF_VT + (size_t)NBATCH * 6 * 64 * SEQ * 2;
constexpr size_t OFF_VTC = OFF_KC + SZ_TILE;
constexpr size_t OFF_SST = OFF_KC;
constexpr size_t OFF_QK = OFF_VTC + SZ_TILE;
constexpr size_t OFF_GC = OFF_QK + (size_t)6144 * 8192;
constexpr size_t OFF_MISC = OFF_GC + (size_t)6144 * 64 * 4;
constexpr size_t WS_TOTAL = OFF_MISC + 512;
static_assert(WS_TOTAL <= (size_t)536870912, "workspace too large");
static_assert((size_t)MTOK * DFFP * 2 <= OFF_BG - OFF_BIG, "hidden does not fit");

struct Params {
    const float* in[18];
    float* out;
    unsigned char* ws;
    int p0, p1;
};

DI unsigned pk2(float a, float b) { f32x2 v = {a, b}; bf16v2 r = __builtin_convertvector(v, bf16v2); return __builtin_bit_cast(unsigned, r); }
DI bf16_t f2bf(float a) { return (bf16_t)(pk2(a, 0.f) & 0xffffu); }
DI float bf2f(bf16_t v) { return __uint_as_float(((unsigned)v) << 16); }
DI float bflo(unsigned v) { return __uint_as_float(v << 16); }
DI float bfhi(unsigned v) { return __uint_as_float(v & 0xffff0000u); }
DI float wave_sum(float v) {
    v += __builtin_bit_cast(float, __builtin_amdgcn_update_dpp(0, __builtin_bit_cast(int, v), 0xB1, 0xf, 0xf, true));
    v += __builtin_bit_cast(float, __builtin_amdgcn_update_dpp(0, __builtin_bit_cast(int, v), 0x4E, 0xf, 0xf, true));
    v += __builtin_bit_cast(float, __builtin_amdgcn_update_dpp(0, __builtin_bit_cast(int, v), 0x141, 0xf, 0xf, true));
    v += __builtin_bit_cast(float, __builtin_amdgcn_update_dpp(0, __builtin_bit_cast(int, v), 0x140, 0xf, 0xf, true));
    const int iv = __builtin_bit_cast(int, v);
    const float a = __builtin_bit_cast(float, __builtin_amdgcn_readlane(iv, 0)), b = __builtin_bit_cast(float, __builtin_amdgcn_readlane(iv, 16));
    const float c = __builtin_bit_cast(float, __builtin_amdgcn_readlane(iv, 32)), d = __builtin_bit_cast(float, __builtin_amdgcn_readlane(iv, 48));
    return (a + b) + (c + d);
}
DI bf16x8 ld2x8(const bf16_t* a, const bf16_t* b) { u32x2 x = *(const u32x2*)a, y = *(const u32x2*)b; u32x4 r = {x.x, x.y, y.x, y.y}; return __builtin_bit_cast(bf16x8, r); }
DI unsigned rot16(unsigned x) { return (x >> 16) | (x << 16); }
DI bf16x8 ld2x8rev(const bf16_t* a, const bf16_t* b) {
    u32x2 x = *(const u32x2*)a, y = *(const u32x2*)b; u32x4 r = {rot16(x.y), rot16(x.x), rot16(y.y), rot16(y.x)}; return __builtin_bit_cast(bf16x8, r);
}
DI bf16x8 pack8(f32x4 a, f32x4 b) { u32x4 r = {pk2(a[0], a[1]), pk2(a[2], a[3]), pk2(b[0], b[1]), pk2(b[2], b[3])}; return __builtin_bit_cast(bf16x8, r); }
DI float fexp2(float x) { return __builtin_amdgcn_exp2f(x); }
DI float fexp(float x) { return __builtin_amdgcn_exp2f(x * LOG2E); }
DI float silu(float x) { return x * __builtin_amdgcn_rcpf(1.f + fexp(-x)); }
DI float row_rstd(const float* rp, int row) {
    const f32x4 a = *(const f32x4*)(rp + (size_t)row * 16), b = *(const f32x4*)(rp + (size_t)row * 16 + 4), c = *(const f32x4*)(rp + (size_t)row * 16 + 8), d = *(const f32x4*)(rp + (size_t)row * 16 + 12);
    const float s = ((a[0] + a[1]) + (a[2] + a[3])) + ((b[0] + b[1]) + (b[2] + b[3])) + ((c[0] + c[1]) + (c[2] + c[3])) + ((d[0] + d[1]) + (d[2] + d[3]));
    return __builtin_amdgcn_rsqf(s * (1.f / DM) + EPS);
}
#define MFMA16(a, b, c) __builtin_amdgcn_mfma_f32_16x16x32_bf16((a), (b), (c), 0, 0, 0)
#define MFMA32(a, b, c) __builtin_amdgcn_mfma_f32_32x32x16_bf16((a), (b), (c), 0, 0, 0)

namespace pg8 {
constexpr int BM = 256, BK = 64, HALF = 128, HTB = HALF * BK * 2, STAGE_BYTES = 8 * HTB, NXCD = 8, WGM = 8;
DI int lds_byte(int r, int c) { const int st = (r >> 4) * 2 + (c >> 5), rr = r & 15, cc = c & 31, ob = rr * 64 + cc * 2; return st * 1024 + (ob ^ (((ob >> 9) & 1) << 5)); }
DI void stage_rc(int b, int& R, int& C) { const int st = b / 1024, sb = b % 1024, swz = sb ^ (((sb >> 9) & 1) << 5); R = (st >> 1) * 16 + swz / 64; C = (st & 1) * 32 + (swz % 64) / 2; }
DI int perm32(int rho) { const int n = rho >> 4, i = rho & 15; return 8 * (i >> 2) + 4 * n + (i & 3); }
struct Unit { int pm, pn; };
struct Gemm { const bf16_t* A; const bf16_t* Bt; int M, N, K; };
struct StaticOrder {
    int nM, nN, nwg, G, c;
    DI void init(int M, int N, int G_, int c_) { nM = M / BM; nN = N / BM; nwg = nM * nN; G = G_; c = c_; }
    DI bool next(int i, Unit& u) const {
        const long L = (long)i * G + c; if (L >= nwg) return false;
        int wgid = (int)L; { const int q = nwg / NXCD, r = nwg % NXCD, xcd = wgid % NXCD, off = wgid / NXCD; wgid = (xcd < r ? xcd * (q + 1) : r * (q + 1) + (xcd - r) * q) + off; }
        const int nig = WGM * nN, gid = wgid / nig, fm = gid * WGM, gsz = (nM - fm) < WGM ? (nM - fm) : WGM;
        u.pm = fm + ((wgid % nig) % gsz); u.pn = (wgid % nig) / gsz; return true;
    }
};
template <class Epi>
DI void gemm_phase(int tid, LAS unsigned char* lds, const Gemm g, const StaticOrder& S, const Epi& E) {
    const int wid = __builtin_amdgcn_readfirstlane(tid >> 6), lane = tid & 63, wr = wid >> 2, wc = wid & 3, fr = lane & 15, fq = lane >> 4;
    const int K = g.K, nt = K / BK;
    unsigned voffA[2], voffB[2];
#pragma unroll
    for (int i = 0; i < 2; ++i) { int R, C; stage_rc(tid * 16 + i * 8192, R, C); const int Rb = (R & ~31) + perm32(R & 31);
        voffA[i] = (unsigned)(R * K + C) * 2u; voffB[i] = (unsigned)(Rb * K + C) * 2u; }
    const size_t kstep = (size_t)(BK * 2);
    const size_t hstep = (size_t)HALF * K * 2;
    const size_t tstep = 2 * hstep;
    const unsigned ldsw = (unsigned)wid * 1024u;
    const int aoff = lds_byte(wr * 64 + fr, fq * 8), boff = lds_byte(wc * 32 + fr, fq * 8);
#define PG8_SA(b, h) (((b) * 2 + (h)) * HTB)
#define PG8_SB(b, h) ((4 + (b) * 2 + (h)) * HTB)
#define PG8_STAGE(bufoff, gbase, voff) do { _Pragma("unroll") for (int _i = 0; _i < 2; ++_i) \
        __builtin_amdgcn_global_load_lds((const unsigned*)((const char*)(gbase) + (voff)[_i]), (LAS unsigned*)(lds + (bufoff) + ldsw + _i * 8192), 16, 0, 0); } while (0)
#define PG8_LDA(dst, b, h) do { _Pragma("unroll") for (int m = 0; m < 4; ++m) _Pragma("unroll") for (int k = 0; k < 2; ++k) dst[m][k] = *(const LAS bf16x8*)(lds + PG8_SA(b, h) + aoff + m * 2048 + k * 1024); } while (0)
#define PG8_LDB(dst, b, h) do { _Pragma("unroll") for (int n = 0; n < 2; ++n) _Pragma("unroll") for (int k = 0; k < 2; ++k) dst[n][k] = *(const LAS bf16x8*)(lds + PG8_SB(b, h) + boff + n * 2048 + k * 1024); } while (0)
#define PG8_MMA(ai, bj, At, Bt) do { __builtin_amdgcn_s_setprio(1); _Pragma("unroll") for (int m = 0; m < 4; ++m) _Pragma("unroll") for (int n = 0; n < 2; ++n) _Pragma("unroll") for (int k = 0; k < 2; ++k) \
        acc[ai][bj][m][n] = __builtin_amdgcn_mfma_f32_16x16x32_bf16(Bt[n][k], At[m][k], acc[ai][bj][m][n], 0, 0, 0); __builtin_amdgcn_s_setprio(0); } while (0)
#define PG8_WAIT_V(n) asm volatile("s_waitcnt vmcnt(" #n ")" ::: "memory")
#define PG8_WAIT_L(n) asm volatile("s_waitcnt lgkmcnt(" #n ")" ::: "memory")
#define PG8_BAR __builtin_amdgcn_s_barrier()
#define PG8_SCHED __builtin_amdgcn_sched_barrier(0)
    Unit cur, nxt; int ui = 0;
    if (!S.next(0, cur)) return;
    f32x4 acc[2][2][4][2];
#pragma unroll
    for (int a = 0; a < 2; ++a)
#pragma unroll
        for (int b = 0; b < 2; ++b)
#pragma unroll
            for (int m = 0; m < 4; ++m)
#pragma unroll
                for (int n = 0; n < 2; ++n) acc[a][b][m][n] = (f32x4){0.f, 0.f, 0.f, 0.f};
    bf16x8 At[4][2], B0[2][2], B1[2][2];
    const char* cA = (const char*)g.A + (size_t)cur.pm * tstep; const char* cB = (const char*)g.Bt + (size_t)cur.pn * tstep;
    PG8_STAGE(PG8_SB(0, 0), cB, voffB); PG8_STAGE(PG8_SA(0, 0), cA, voffA); PG8_STAGE(PG8_SB(0, 1), cB + hstep, voffB); PG8_STAGE(PG8_SA(0, 1), cA + hstep, voffA);
    if (wr == 1) PG8_BAR;
    PG8_WAIT_V(4); PG8_BAR;
    PG8_STAGE(PG8_SB(1, 0), cB + kstep, voffB); PG8_STAGE(PG8_SA(1, 0), cA + kstep, voffA); PG8_STAGE(PG8_SB(1, 1), cB + hstep + kstep, voffB);
    PG8_WAIT_V(6); PG8_BAR;
    for (;;) {
        const bool has_next = S.next(ui + 1, nxt);
        const char* nA = has_next ? (const char*)g.A + (size_t)nxt.pm * tstep : cA; const char* nB = has_next ? (const char*)g.Bt + (size_t)nxt.pn * tstep : cB;
        for (int t = 0; t < nt; t += 2) {
            const bool last = (t == nt - 2);
            const char* a1 = cA + (size_t)(t + 1) * kstep;
            const char* a2 = last ? nA : cA + (size_t)(t + 2) * kstep; const char* b2 = last ? nB : cB + (size_t)(t + 2) * kstep;
            const char* a3 = a2 + kstep; const char* b3 = b2 + kstep;
            PG8_LDB(B0, 0, 0); PG8_SCHED; PG8_LDA(At, 0, 0); PG8_STAGE(PG8_SA(1, 1), a1 + hstep, voffA);
            PG8_WAIT_L(8); PG8_BAR; PG8_WAIT_L(0); PG8_MMA(0, 0, At, B0); PG8_BAR; PG8_SCHED;
            PG8_LDB(B1, 0, 1); PG8_STAGE(PG8_SB(0, 0), b2, voffB);
            PG8_BAR; PG8_WAIT_L(0); PG8_MMA(0, 1, At, B1); PG8_BAR;
            PG8_LDA(At, 0, 1); PG8_STAGE(PG8_SA(0, 0), a2, voffA);
            PG8_BAR; PG8_WAIT_L(0); PG8_MMA(1, 0, At, B0); PG8_BAR; PG8_SCHED;
            PG8_STAGE(PG8_SB(0, 1), b2 + hstep, voffB);
            PG8_WAIT_V(6); PG8_BAR; PG8_MMA(1, 1, At, B1); PG8_BAR;
            PG8_LDB(B0, 1, 0); PG8_SCHED; PG8_LDA(At, 1, 0); PG8_STAGE(PG8_SA(0, 1), a2 + hstep, voffA);
            PG8_WAIT_L(8); PG8_BAR; PG8_WAIT_L(0); PG8_MMA(0, 0, At, B0); PG8_BAR; PG8_SCHED;
            PG8_LDB(B1, 1, 1); PG8_STAGE(PG8_SB(1, 0), b3, voffB);
            PG8_BAR; PG8_WAIT_L(0); PG8_MMA(0, 1, At, B1); PG8_BAR;
            PG8_LDA(At, 1, 1); PG8_STAGE(PG8_SA(1, 0), a3, voffA);
            PG8_BAR; PG8_WAIT_L(0); PG8_MMA(1, 0, At, B0); PG8_BAR; PG8_SCHED;
            PG8_STAGE(PG8_SB(1, 1), b3 + hstep, voffB);
            PG8_WAIT_V(6); PG8_BAR; PG8_MMA(1, 1, At, B1); PG8_BAR;
        }
        E(acc, cur, wr, wc, fr, fq);
        if (!has_next) break;
#pragma unroll
        for (int a = 0; a < 2; ++a)
#pragma unroll
            for (int b = 0; b < 2; ++b)
#pragma unroll
                for (int m = 0; m < 4; ++m)
#pragma unroll
                    for (int n = 0; n < 2; ++n) acc[a][b][m][n] = (f32x4){0.f, 0.f, 0.f, 0.f};
        cur = nxt; cA = nA; cB = nB; ++ui;
    }
    PG8_WAIT_V(0);
    if (wr == 0) PG8_BAR;
    PG8_BAR;
#undef PG8_SA
#undef PG8_SB
#undef PG8_STAGE
#undef PG8_LDA
#undef PG8_LDB
#undef PG8_MMA
#undef PG8_WAIT_V
#undef PG8_WAIT_L
#undef PG8_BAR
#undef PG8_SCHED
}
}
using pg8::Unit;
typedef f32x4 AccT[2][2][4][2];

struct EpiSwiglu {
    bf16_t* H; const float* rss;
    DI void operator()(const AccT& acc, const Unit& u, int wr, int wc, int fr, int fq) const {
        const int row0 = u.pm * 256 + wr * 64 + fr, col0 = u.pn * 128 + wc * 32 + 8 * fq;
#pragma unroll
        for (int ai = 0; ai < 2; ++ai)
#pragma unroll
            for (int m = 0; m < 4; ++m) {
                const int row = row0 + ai * 128 + m * 16;
                const float rstd = row_rstd(rss, row);
                float hv[8];
#pragma unroll
                for (int n = 0; n < 2; ++n)
#pragma unroll
                    for (int j = 0; j < 4; ++j) { const float gg = acc[ai][0][m][n][j] * rstd, uu = acc[ai][1][m][n][j] * rstd; hv[4 * n + j] = silu(gg) * uu; }
                u32x4 w = {pk2(hv[0], hv[1]), pk2(hv[2], hv[3]), pk2(hv[4], hv[5]), pk2(hv[6], hv[7])};
                *(u32x4*)(H + (size_t)row * DFFP + col0) = w;
            }
    }
};
struct EpiResid {
    float* X; bf16_t* XB; float* rssn; float scale;
    DI void operator()(const AccT& acc, const Unit& u, int wr, int wc, int fr, int fq) const {
        const int row0 = u.pm * 256 + wr * 64 + fr, col0 = u.pn * 256 + wc * 32 + 8 * fq;
#pragma unroll
        for (int ai = 0; ai < 2; ++ai)
#pragma unroll
            for (int m = 0; m < 4; ++m) {
                const int row = row0 + ai * 128 + m * 16; float ss = 0.f;
#pragma unroll
                for (int bj = 0; bj < 2; ++bj) {
                    float* xp = X + (size_t)row * DM + col0 + bj * 128;
                    f32x4 x0 = *(const f32x4*)xp, x1 = *(const f32x4*)(xp + 4);
                    x0 += acc[ai][bj][m][0] * scale; x1 += acc[ai][bj][m][1] * scale;
                    *(f32x4*)xp = x0; *(f32x4*)(xp + 4) = x1;
                    u32x4 w = {pk2(x0[0], x0[1]), pk2(x0[2], x0[3]), pk2(x1[0], x1[1]), pk2(x1[2], x1[3])};
                    *(u32x4*)(XB + (size_t)row * DM + col0 + bj * 128) = w;
#pragma unroll
                    for (int j = 0; j < 4; ++j) ss += x0[j] * x0[j] + x1[j] * x1[j];
                }
                ss += __shfl_xor(ss, 16); ss += __shfl_xor(ss, 32);
                if (fq == 0) rssn[(size_t)row * 16 + u.pn * 4 + wc] = ss;
            }
    }
};
struct EpiMixIn {
    bf16_t* PAB; bf16_t* PC; float* BG; const float* rss;
    DI void operator()(const AccT& acc, const Unit& u, int wr, int wc, int fr, int fq) const {
        const int row0 = u.pm * 256 + wr * 64 + fr;
        bf16_t* base; int ld, ct;
        if (u.pn < 7) { base = PAB; ld = LDAB; ct = u.pn * 256; } else { base = PC; ld = LDC; ct = (u.pn - 7) * 256; }
        const int col0 = ct + wc * 32 + 8 * fq;
        const bool isbg = (u.pn == 11) && (wc == 0) && (fq < 3);
#pragma unroll
        for (int ai = 0; ai < 2; ++ai)
#pragma unroll
            for (int m = 0; m < 4; ++m) {
                const int row = row0 + ai * 128 + m * 16;
                const float rstd = row_rstd(rss, row);
#pragma unroll
                for (int bj = 0; bj < 2; ++bj) {
                    const f32x4 v0 = acc[ai][bj][m][0] * rstd, v1 = acc[ai][bj][m][1] * rstd;
                    u32x4 w = {pk2(v0[0], v0[1]), pk2(v0[2], v0[3]), pk2(v1[0], v1[1]), pk2(v1[2], v1[3])};
                    *(u32x4*)(base + (size_t)row * ld + col0 + bj * 128) = w;
                    if (bj == 1 && isbg) { float* bp = BG + (size_t)row * 24 + 8 * fq; *(f32x4*)bp = v0; *(f32x4*)(bp + 4) = v1; }
                }
            }
    }
};

DI int map_src(int kind, int n) {
    if (kind == 0) return n;
    if (kind == 1) { const int pn = n >> 8, bj = (n >> 7) & 1, i = n & 127; const int hid = pn * 128 + i; return hid < DFF ? hid + bj * DFF : -1; }
    if (n < 1408) return n;
    if (n < 1792) return 2560 + (n - 1408);
    if (n < 2944) return 1408 + (n - 1792);
    if (n < 2968) return n;
    return -1;
}
DI void conv_w(const float* __restrict__ W, int ldw, int Kreal, bf16_t* __restrict__ Bt, int Np, int Kp, const float* __restrict__ gain, int kind, float* tile, int tid) {
    const int tnn = Np >> 6, ntile = tnn * (Kp >> 6);
    for (int t = blockIdx.x; t < ntile; t += gridDim.x) {
        const int n0 = (t % tnn) << 6, k0 = (t / tnn) << 6;
        {
            const int tn = tid & 63, tk = tid >> 6; const int src = map_src(kind, n0 + tn);
#pragma unroll
            for (int r = 0; r < 8; ++r) { const int kk = tk + 8 * r, k = k0 + kk; float v = 0.f;
                if (src >= 0 && k < Kreal) { v = W[(size_t)k * ldw + src]; if (gain) v *= gain[k]; }
                tile[kk * 65 + tn] = v; }
        }
        __syncthreads();
        {
            const int rn = tid >> 3, kk = (tid & 7) * 8; float a[8];
#pragma unroll
            for (int j = 0; j < 8; ++j) a[j] = tile[(kk + j) * 65 + rn];
            u32x4 w = {pk2(a[0], a[1]), pk2(a[2], a[3]), pk2(a[4], a[5]), pk2(a[6], a[7])};
            *(u32x4*)(Bt + (size_t)(n0 + rn) * Kp + k0 + kk) = w;
        }
        __syncthreads();
    }
}
DI void phase_convw(const Params& p, int l, unsigned char* shm, int tid) {
    float* tile = (float*)shm; unsigned char* ws = p.ws;
    conv_w(p.in[2] + (size_t)l * DM * 2 * DFF, 2 * DFF, DM, (bf16_t*)(ws + OFF_W_FFN1IN), NFF, DM, p.in[1] + l * DM, 1, tile, tid);
    conv_w(p.in[3] + (size_t)l * DFF * DM, DM, DFF, (bf16_t*)(ws + OFF_W_FFN1OUT), DM, DFFP, nullptr, 0, tile, tid);
    conv_w(p.in[5] + (size_t)l * DM * 2968, 2968, DM, (bf16_t*)(ws + OFF_W_MIXIN), NMIX, DM, p.in[4] + l * DM, 2, tile, tid);
    conv_w(p.in[13] + (size_t)l * DM * DM, DM, DM, (bf16_t*)(ws + OFF_W_MIXOUT), DM, DM, nullptr, 0, tile, tid);
    conv_w(p.in[15] + (size_t)l * DM * 2 * DFF, 2 * DFF, DM, (bf16_t*)(ws + OFF_W_FFN2IN), NFF, DM, p.in[14] + l * DM, 1, tile, tid);
    conv_w(p.in[16] + (size_t)l * DFF * DM, DM, DFF, (bf16_t*)(ws + OFF_W_FFN2OUT), DM, DFFP, nullptr, 0, tile, tid);
}

DI void phase_init(const Params& p, int gw, int nw, int lane) {
    const float* x = p.in[0]; float* X = p.out; bf16_t* XB = (bf16_t*)(p.ws + OFF_XB); float* rss = (float*)(p.ws + OFF_RSS);
    for (int row = gw; row < MTOK; row += nw) {
        float ss = 0.f;
#pragma unroll
        for (int i = 0; i < 4; ++i) {
            const size_t o = (size_t)row * DM + i * 256 + lane * 4;
            const f32x4 v = *(const f32x4*)(x + o); *(f32x4*)(X + o) = v;
            u32x2 w = {pk2(v[0], v[1]), pk2(v[2], v[3])}; *(u32x2*)(XB + o) = w;
            ss += v[0] * v[0] + v[1] * v[1] + v[2] * v[2] + v[3] * v[3];
        }
        ss = wave_sum(ss); if (lane < 16) rss[(size_t)row * 16 + lane] = lane == 0 ? ss : 0.f;
    }
    if (gw == 0) { unsigned* misc = (unsigned*)(p.ws + OFF_MISC); misc[lane] = 0u; misc[64 + lane] = 0u; }
}
DI void phase_final(const Params& p, int gw, int nw, int lane) {
    float* X = p.out; const float* rss = (const float*)(p.ws + OFF_RSS); const float* g = p.in[17];
    for (int row = gw; row < MTOK; row += nw) {
        const float rstd = row_rstd(rss, row);
#pragma unroll
        for (int i = 0; i < 4; ++i) {
            const int c = i * 256 + lane * 4; const size_t o = (size_t)row * DM + c;
            f32x4 v = *(const f32x4*)(X + o); const f32x4 gv = *(const f32x4*)(g + c);
            v = v * rstd * gv; *(f32x4*)(X + o) = v;
        }
    }
}

DI void store_row64(bf16_t* dst, const float (&val)[64]) {
#pragma unroll
    for (int i = 0; i < 8; ++i) { u32x4 w = {pk2(val[8 * i], val[8 * i + 1]), pk2(val[8 * i + 2], val[8 * i + 3]), pk2(val[8 * i + 4], val[8 * i + 5]), pk2(val[8 * i + 6], val[8 * i + 7])};
        *(u32x4*)(dst + 8 * i) = w; }
}
DI void phase_prep(const Params& p, int l, int gw, int nw, int lane0) {
    unsigned char* ws = p.ws;
    const bf16_t* PAB = (const bf16_t*)(ws + OFF_PAB); const bf16_t* PC = (const bf16_t*)(ws + OFF_PC);
    bf16_t* QC = (bf16_t*)(ws + OFF_QC); bf16_t* KC = (bf16_t*)(ws + OFF_KC); bf16_t* KTC = (bf16_t*)(ws + OFF_KTC); bf16_t* VTC = (bf16_t*)(ws + OFF_VTC);
    bf16_t* VT = (bf16_t*)(ws + OFF_VT);
    const float* cw = p.in[6] + (size_t)l * 5 * 1152;
    for (int u = gw; u < 512 * 25; u += nw) {
        int lane = lane0; asm volatile("" : "+v"(lane));
        const int grp = u % 25, ck = u / 25, b = ck >> 7, chunk = ck & 127;
        if (grp == 24) {
            const bf16_t* kr = PAB + ((size_t)b * SEQ + chunk * 64 + lane) * LDAB + 896;
            unsigned* kmx = (unsigned*)(ws + OFF_MISC) + l * 32 + b * 8;
#pragma unroll
            for (int hm = 0; hm < 8; ++hm) {
                float ss = 0.f;
#pragma unroll
                for (int c4 = 0; c4 < 4; ++c4) { const u32x4 v = *(const u32x4*)(kr + hm * 32 + c4 * 8);
#pragma unroll
                    for (int e = 0; e < 4; ++e) { const float a = bflo(v[e]), bb = bfhi(v[e]); ss += a * a + bb * bb; } }
#pragma unroll
                for (int o = 32; o > 0; o >>= 1) ss = fmaxf(ss, __shfl_xor(ss, o));
                if (lane == 0) atomicMax(kmx + hm, __float_as_uint(ss));
            }
            continue;
        }
        float val[64];
        if (grp < 18) {
            const int type = grp / 6, h = grp % 6, col = type * 384 + h * 64 + lane;
            const float w0 = cw[col], w1 = cw[1152 + col], w2 = cw[2 * 1152 + col], w3 = cw[3 * 1152 + col], w4 = cw[4 * 1152 + col];
            float xv[68];
#pragma unroll
            for (int i = 0; i < 68; ++i) { const int pos = chunk * 64 - 2 + i;
                xv[i] = (pos >= 0 && pos < SEQ) ? bf2f(PC[((size_t)b * SEQ + pos) * LDC + col]) : 0.f; }
#pragma unroll
            for (int t = 0; t < 64; ++t) { const float v = w0 * xv[t] + w1 * xv[t + 1] + w2 * xv[t + 2] + w3 * xv[t + 3] + w4 * xv[t + 4]; val[t] = silu(v); }
            if (type < 2) {
                const float sc = type == 0 ? 0.125f : 1.f;
#pragma unroll
                for (int t = 0; t < 64; ++t) { const float ss = wave_sum(val[t] * val[t]); val[t] *= __builtin_amdgcn_rsqf(ss + EPS) * sc; }
            }
            const size_t tb = ((size_t)(b * 6 + h) * 128 + chunk) * 4096;
            if (type == 0) {
#pragma unroll
                for (int t = 0; t < 64; ++t) QC[tb + t * 64 + lane] = f2bf(val[t]);
            } else if (type == 1) {
#pragma unroll
                for (int t = 0; t < 64; ++t) KC[tb + t * 64 + lane] = f2bf(val[t]);
                store_row64(KTC + tb + lane * 64, val);
            } else {
                store_row64(VTC + tb + lane * 64, val);
            }
        } else {
            const int vh = grp - 18; const int col = (vh < 2 ? 512 + vh * 64 : 1152 + (vh - 2) * 64) + lane;
            const size_t tok0 = (size_t)b * SEQ + chunk * 64;
#pragma unroll
            for (int t = 0; t < 64; ++t) val[t] = bf2f(PAB[(tok0 + t) * LDAB + col]);
            store_row64(VT + ((size_t)(b * 6 + vh) * 64 + lane) * SEQ + chunk * 64, val);
        }
    }
}

DI void phase_chunk(const Params& p, int l, int gw, int nw, int lane0, int wid, unsigned char* shm) {
    unsigned char* ws = p.ws;
    float* Mf = (float*)(shm + wid * 16384); bf16_t* AB = (bf16_t*)Mf; bf16_t* ABG = AB + 4096;
    const bf16_t* QC = (const bf16_t*)(ws + OFF_QC); const bf16_t* KC = (const bf16_t*)(ws + OFF_KC);
    const bf16_t* KTC = (const bf16_t*)(ws + OFF_KTC); const bf16_t* VTC = (const bf16_t*)(ws + OFF_VTC);
    const float* BG = (const float*)(ws + OFF_BG);
    bf16_t* U = (bf16_t*)(ws + OFF_U); bf16_t* WB = (bf16_t*)(ws + OFF_WB); bf16_t* QK = (bf16_t*)(ws + OFF_QK); float* GC = (float*)(ws + OFF_GC);
    for (int it = gw; it < 6144; it += nw) {
        int lane = lane0; asm volatile("" : "+v"(lane));
        const int fr = lane & 15, q = lane >> 4;
        const int chunk = it & 127, seq = it >> 7, dir = seq & 1, bh = seq >> 1, b = bh / 6, h = bh % 6;
        const int pch = dir ? 127 - chunk : chunk;
        const size_t tb = ((size_t)bh * 128 + pch) * 4096;
        const int tkl = dir ? 63 - lane : lane;
        const size_t tok = (size_t)b * SEQ + pch * 64 + tkl;
        const float braw = BG[tok * 24 + dir * 6 + h], araw = BG[tok * 24 + 12 + dir * 6 + h];
        const float beta = 1.f / (1.f + expf(-braw));
        const float Aa = expf(p.in[10][l * 12 + dir * 6 + h]); const float xx = araw + p.in[11][l * 12 + dir * 6 + h];
        const float sp = fmaxf(xx, 0.f) + log1pf(expf(-fabsf(xx)));
        const float g = -Aa * sp;
        float gc = g;
#pragma unroll
        for (int o = 1; o < 64; o <<= 1) { const float t = __shfl_up(gc, o); if (lane >= o) gc += t; }
        GC[(size_t)it * 64 + lane] = gc;
        bf16x8 kf[4][2], qf[4][2];
#pragma unroll
        for (int m = 0; m < 4; ++m)
#pragma unroll
            for (int s = 0; s < 2; ++s) { const int row = 16 * m + fr; const int tr = dir ? 63 - row : row;
                kf[m][s] = *(const bf16x8*)(KC + tb + tr * 64 + 32 * s + 8 * q); qf[m][s] = *(const bf16x8*)(QC + tb + tr * 64 + 32 * s + 8 * q); }
#pragma unroll
        for (int m = 0; m < 4; ++m)
#pragma unroll
            for (int n = 0; n <= m; ++n) {
                f32x4 acc = {0.f, 0.f, 0.f, 0.f};
                acc = MFMA16(kf[m][0], kf[n][0], acc); acc = MFMA16(kf[m][1], kf[n][1], acc);
                const int s_ = 16 * n + fr; const float gcs = __shfl(gc, s_);
#pragma unroll
                for (int r = 0; r < 4; ++r) { const int c = 16 * m + 4 * q + r; const float gcc = __shfl(gc, c), bc = __shfl(beta, c);
                    Mf[c * 64 + s_] = (s_ < c) ? bc * acc[r] * fexp(gcc - gcs) : 0.f; }
                __builtin_amdgcn_sched_barrier(0);
            }
#pragma unroll
        for (int n = 0; n < 4; ++n)
#pragma unroll
            for (int m = 0; m < 4; ++m) {
                f32x4 v = {0.f, 0.f, 0.f, 0.f};
                const int c = 16 * n + fr;
                if (m <= n) {
                    f32x4 acc = {0.f, 0.f, 0.f, 0.f};
                    acc = MFMA16(kf[m][0], qf[n][0], acc); acc = MFMA16(kf[m][1], qf[n][1], acc);
                    const float gcc = __shfl(gc, c);
#pragma unroll
                    for (int r = 0; r < 4; ++r) { const int s_ = 16 * m + 4 * q + r; const float gcs = __shfl(gc, s_); v[r] = (s_ <= c) ? acc[r] * fexp(gcc - gcs) : 0.f; }
                }
                u32x2 w = {pk2(v[0], v[1]), pk2(v[2], v[3])};
                *(u32x2*)(QK + (size_t)it * 4096 + c * 64 + 16 * m + 4 * q) = w;
                __builtin_amdgcn_sched_barrier(0);
            }
        __builtin_amdgcn_sched_barrier(0);
        bf16x8 vfr[4][2], ktf[4][2];
#pragma unroll
        for (int n = 0; n < 4; ++n) {
            const bf16_t* vp = VTC + tb + (16 * n + fr) * 64 + 8 * q; vfr[n][0] = *(const bf16x8*)vp; vfr[n][1] = *(const bf16x8*)(vp + 32);
            const bf16_t* kp = KTC + tb + (16 * n + fr) * 64 + 8 * q; ktf[n][0] = *(const bf16x8*)kp; ktf[n][1] = *(const bf16x8*)(kp + 32);
        }
        float x[64];
#pragma unroll
        for (int i = 0; i < 64; ++i) {
            float a = (i == lane) ? 1.f : 0.f;
#pragma unroll
            for (int m = 0; m < i; ++m) a -= Mf[i * 64 + m] * x[m];
            x[i] = a;
            __builtin_amdgcn_sched_barrier(0);
        }
        {
            const float bj = beta, bgj = beta * fexp(gc);
#pragma unroll
            for (int i = 0; i < 64; ++i) { AB[i * 64 + tkl] = f2bf(x[i] * bj); ABG[i * 64 + tkl] = f2bf(x[i] * bgj); }
        }
        __builtin_amdgcn_sched_barrier(0);
#pragma unroll
        for (int m = 0; m < 4; ++m) {
            const bf16x8 a0 = *(const bf16x8*)(AB + (16 * m + fr) * 64 + 8 * q), a1 = *(const bf16x8*)(AB + (16 * m + fr) * 64 + 32 + 8 * q);
#pragma unroll
            for (int n = 0; n < 4; ++n) {
                const bf16x8 b0 = vfr[n][0], b1 = vfr[n][1];
                f32x4 acc = {0.f, 0.f, 0.f, 0.f};
                acc = MFMA16(a0, b0, acc); acc = MFMA16(a1, b1, acc);
                u32x2 w = {pk2(acc[0], acc[1]), pk2(acc[2], acc[3])};
                *(u32x2*)(U + (size_t)it * 4096 + (16 * n + fr) * 64 + 16 * m + 4 * q) = w;
            }
        }
        __builtin_amdgcn_sched_barrier(0);
#pragma unroll
        for (int n = 0; n < 4; ++n) {
            const bf16x8 b0 = *(const bf16x8*)(ABG + (16 * n + fr) * 64 + 8 * q), b1 = *(const bf16x8*)(ABG + (16 * n + fr) * 64 + 32 + 8 * q);
#pragma unroll
            for (int m = 0; m < 4; ++m) {
                const bf16x8 a0 = ktf[m][0], a1 = ktf[m][1];
                f32x4 acc = {0.f, 0.f, 0.f, 0.f};
                acc = MFMA16(a0, b0, acc); acc = MFMA16(a1, b1, acc);
                u32x2 w = {pk2(acc[0], acc[1]), pk2(acc[2], acc[3])};
                *(u32x2*)(WB + (size_t)it * 4096 + (16 * n + fr) * 64 + 16 * m + 4 * q) = w;
            }
        }
    }
}

constexpr int SCAN_SLOT = 25600;
DI void scan_issue(LAS unsigned char* slot, const bf16_t* WB, const bf16_t* U, const bf16_t* KTC, const float* GC, int seq, int bh, int dir, int lw, int i, int lane) {
    const int it = seq * 128 + i; const int pch = dir ? 127 - i : i;
    const bf16_t* Wp = WB + (size_t)it * 4096; const bf16_t* Kp = KTC + ((size_t)bh * 128 + pch) * 4096;
    const bf16_t* Up = U + (size_t)it * 4096 + (16 * lw) * 64; const float* gcp = GC + (size_t)it * 64;
    const int r8 = lane >> 3, c8 = lane & 7;
#pragma unroll
    for (int jj = 0; jj < 2; ++jj) {
        const int j = 2 * lw + jj;
        const int row = 8 * j + r8; const int cid = c8 ^ (row & 7);
        __builtin_amdgcn_global_load_lds((const unsigned*)(Wp + row * 64 + cid * 8), (LAS unsigned*)(slot + j * 1024), 16, 0, 0);
        __builtin_amdgcn_global_load_lds((const unsigned*)(Kp + row * 64 + cid * 8), (LAS unsigned*)(slot + 8192 + j * 1024), 16, 0, 0);
    }
#pragma unroll
    for (int j = 0; j < 2; ++j) {
        const int row = 8 * j + r8; const int cid = c8 ^ (row & 7);
        __builtin_amdgcn_global_load_lds((const unsigned*)(Up + row * 64 + cid * 8), (LAS unsigned*)(slot + 16384 + lw * 2048 + j * 1024), 16, 0, 0);
    }
    __builtin_amdgcn_global_load_lds((const unsigned*)(gcp + (lane & 15) * 4), (LAS unsigned*)(slot + 24576), 16, 0, 0);
}
DI u32x2 lds_piece(const LAS unsigned char* tile, int row, int e) {
    return *(const LAS u32x2*)(tile + row * 128 + ((((e >> 3) ^ (row & 7))) << 4) + ((e & 4) << 1));
}
DI bf16x8 mk8(u32x2 x, u32x2 y) { u32x4 r = {x.x, x.y, y.x, y.y}; return __builtin_bit_cast(bf16x8, r); }
DI bf16x8 mk8rev(u32x2 x, u32x2 y) { u32x4 r = {rot16(x.y), rot16(x.x), rot16(y.y), rot16(y.x)}; return __builtin_bit_cast(bf16x8, r); }
DI void scan_step(const LAS unsigned char* slot, int vs, int dir, int fr, int q, f32x4 (&S)[4], bf16_t* sst) {
    bf16x8 Sb[2];
    Sb[0] = pack8(S[0], S[1]); Sb[1] = pack8(S[2], S[3]);
    {
        const u32x4 s0 = __builtin_bit_cast(u32x4, Sb[0]), s1 = __builtin_bit_cast(u32x4, Sb[1]);
        *(u32x2*)(sst + 0) = (u32x2){s0.x, s0.y}; *(u32x2*)(sst + 16) = (u32x2){s0.z, s0.w};
        *(u32x2*)(sst + 32) = (u32x2){s1.x, s1.y}; *(u32x2*)(sst + 48) = (u32x2){s1.z, s1.w};
    }
    const LAS unsigned char* ut = slot + 16384 + vs * 2048;
    const LAS float* gcl_p = (const LAS float*)(slot + 24576);
    const float gcl = gcl_p[63]; const float gl = fexp(gcl);
    f32x4 vg[4];
#pragma unroll
    for (int m = 0; m < 4; ++m) {
        const int c = 16 * m + fr;
        const bf16x8 w0 = mk8(lds_piece(slot, c, 4 * q), lds_piece(slot, c, 16 + 4 * q)), w1 = mk8(lds_piece(slot, c, 32 + 4 * q), lds_piece(slot, c, 48 + 4 * q));
        f32x4 acc = {0.f, 0.f, 0.f, 0.f};
        acc = MFMA16(w0, Sb[0], acc); acc = MFMA16(w1, Sb[1], acc);
        const u32x2 uu = lds_piece(ut, fr, 16 * m + 4 * q);
        const f32x4 gcv = *(const LAS f32x4*)(slot + 24576 + (16 * m + 4 * q) * 4);
        vg[m][0] = (bflo(uu.x) - acc[0]) * fexp(gcl - gcv[0]); vg[m][1] = (bfhi(uu.x) - acc[1]) * fexp(gcl - gcv[1]);
        vg[m][2] = (bflo(uu.y) - acc[2]) * fexp(gcl - gcv[2]); vg[m][3] = (bfhi(uu.y) - acc[3]) * fexp(gcl - gcv[3]);
    }
    bf16x8 Vg[2];
    Vg[0] = pack8(vg[0], vg[1]); Vg[1] = pack8(vg[2], vg[3]);
#pragma unroll
    for (int kt = 0; kt < 4; ++kt) {
        const int k = 16 * kt + fr;
        bf16x8 k0, k1;
        if (dir == 0) { k0 = mk8(lds_piece(slot + 8192, k, 4 * q), lds_piece(slot + 8192, k, 16 + 4 * q)); k1 = mk8(lds_piece(slot + 8192, k, 32 + 4 * q), lds_piece(slot + 8192, k, 48 + 4 * q)); }
        else { k0 = mk8rev(lds_piece(slot + 8192, k, 60 - 4 * q), lds_piece(slot + 8192, k, 44 - 4 * q)); k1 = mk8rev(lds_piece(slot + 8192, k, 28 - 4 * q), lds_piece(slot + 8192, k, 12 - 4 * q)); }
        f32x4 acc = S[kt] * gl;
        acc = MFMA16(k0, Vg[0], acc); acc = MFMA16(k1, Vg[1], acc);
        S[kt] = acc;
    }
}
DI void phase_scan(const Params& p, int lane, int wid, unsigned char* shm) {
    unsigned char* ws = p.ws;
    const bf16_t* KTC = (const bf16_t*)(ws + OFF_KTC);
    const bf16_t* U = (const bf16_t*)(ws + OFF_U); const bf16_t* WB = (const bf16_t*)(ws + OFF_WB);
    const float* GC = (const float*)(ws + OFF_GC); bf16_t* SST = (bf16_t*)(ws + OFF_SST);
    const int seq = blockIdx.x, dir = seq & 1, bh = seq >> 1;
    const int fr = lane & 15, q = lane >> 4;
    LAS unsigned char* ring = (LAS unsigned char*)shm;
    if (wid >= 4) {
        const int lw = wid - 4;
        scan_issue(ring, WB, U, KTC, GC, seq, bh, dir, lw, 0, lane);
        scan_issue(ring + SCAN_SLOT, WB, U, KTC, GC, seq, bh, dir, lw, 1, lane);
        scan_issue(ring + 2 * SCAN_SLOT, WB, U, KTC, GC, seq, bh, dir, lw, 2, lane);
        int slot_n = 3;
        for (int i = 0; i < 128; ++i) {
            scan_issue(ring + slot_n * SCAN_SLOT, WB, U, KTC, GC, seq, bh, dir, lw, i + 3 < 128 ? i + 3 : 127, lane);
            asm volatile("s_waitcnt vmcnt(21)" ::: "memory");
            __builtin_amdgcn_s_barrier();
            slot_n = slot_n == 4 ? 0 : slot_n + 1;
        }
        asm volatile("s_waitcnt vmcnt(0)" ::: "memory");
    } else {
        const int vs = wid;
        f32x4 S[4];
#pragma unroll
        for (int i = 0; i < 4; ++i) S[i] = (f32x4){0.f, 0.f, 0.f, 0.f};
        bf16_t* sst = SST + (size_t)seq * 128 * 4096 + (16 * vs + fr) * 64 + 4 * q;
        int slot_c = 0;
        for (int i = 0; i < 128; ++i) {
            __builtin_amdgcn_s_barrier();
            asm volatile("" ::: "memory");
            scan_step(ring + slot_c * SCAN_SLOT, vs, dir, fr, q, S, sst + (size_t)i * 4096);
            slot_c = slot_c == 4 ? 0 : slot_c + 1;
        }
    }
}
DI void phase_outp(const Params& p, int gw, int nw, int lane0) {
    unsigned char* ws = p.ws;
    const bf16_t* QC = (const bf16_t*)(ws + OFF_QC);
    const bf16_t* U = (const bf16_t*)(ws + OFF_U); const bf16_t* WB = (const bf16_t*)(ws + OFF_WB); const bf16_t* QK = (const bf16_t*)(ws + OFF_QK);
    const float* GC = (const float*)(ws + OFF_GC); const bf16_t* SST = (const bf16_t*)(ws + OFF_SST);
    for (int it = gw; it < 6144; it += nw) {
        int lane = lane0; asm volatile("" : "+v"(lane));
        const int fr = lane & 15, q = lane >> 4;
        const int chunk = it & 127, seq = it >> 7, dir = seq & 1, bh = seq >> 1, b = bh / 6, h = bh % 6;
        const int pch = dir ? 127 - chunk : chunk;
        const size_t tb = ((size_t)bh * 128 + pch) * 4096;
        const bf16_t* Wp = WB + (size_t)it * 4096; const bf16_t* Up = U + (size_t)it * 4096; const bf16_t* QKp = QK + (size_t)it * 4096;
        const bf16_t* Sp = SST + (size_t)it * 4096; const float* gcp = GC + (size_t)it * 64;
        bf16_t* OT = (bf16_t*)(ws + OFF_WB) + (size_t)it * 4096;
        bf16x8 wf[4][2], qf[4][2], kf[4][2]; f32x4 eg[4];
#pragma unroll
        for (int m = 0; m < 4; ++m) {
            const int c = 16 * m + fr; const int tr = dir ? 63 - c : c;
            wf[m][0] = *(const bf16x8*)(Wp + c * 64 + 8 * q); wf[m][1] = *(const bf16x8*)(Wp + c * 64 + 32 + 8 * q);
            qf[m][0] = *(const bf16x8*)(QC + tb + tr * 64 + 8 * q); qf[m][1] = *(const bf16x8*)(QC + tb + tr * 64 + 32 + 8 * q);
            const bf16_t* kp = QKp + c * 64 + 4 * q;
            kf[m][0] = ld2x8(kp, kp + 16); kf[m][1] = ld2x8(kp + 32, kp + 48);
            const f32x4 gcv = *(const f32x4*)(gcp + 16 * m + 4 * q);
#pragma unroll
            for (int r = 0; r < 4; ++r) eg[m][r] = fexp(gcv[r]);
        }
#pragma unroll 1
        for (int vs = 0; vs < 4; ++vs) {
            const bf16x8 Sb0 = *(const bf16x8*)(Sp + (16 * vs + fr) * 64 + 8 * q), Sb1 = *(const bf16x8*)(Sp + (16 * vs + fr) * 64 + 32 + 8 * q);
            f32x4 vn[4], o[4];
#pragma unroll
            for (int m = 0; m < 4; ++m) {
                f32x4 acc = {0.f, 0.f, 0.f, 0.f};
                acc = MFMA16(wf[m][0], Sb0, acc); acc = MFMA16(wf[m][1], Sb1, acc);
                const u32x2 uu = *(const u32x2*)(Up + (16 * vs + fr) * 64 + 16 * m + 4 * q);
                vn[m][0] = bflo(uu.x) - acc[0]; vn[m][1] = bfhi(uu.x) - acc[1]; vn[m][2] = bflo(uu.y) - acc[2]; vn[m][3] = bfhi(uu.y) - acc[3];
                f32x4 a2 = {0.f, 0.f, 0.f, 0.f};
                a2 = MFMA16(qf[m][0], Sb0, a2); a2 = MFMA16(qf[m][1], Sb1, a2);
                o[m] = a2 * eg[m];
            }
            const bf16x8 Vb0 = pack8(vn[0], vn[1]), Vb1 = pack8(vn[2], vn[3]);
#pragma unroll
            for (int m = 0; m < 4; ++m) {
                f32x4 acc = o[m];
                acc = MFMA16(kf[m][0], Vb0, acc); acc = MFMA16(kf[m][1], Vb1, acc);
#pragma unroll
                for (int r = 0; r < 4; ++r) { const int c = 16 * m + 4 * q + r; OT[c * 64 + 16 * vs + fr] = f2bf(acc[r]); }
            }
        }
    }
}

DI bf16x8 packp(const float (&pv)[16], int s) {
    u32x4 r = {pk2(pv[8 * s], pv[8 * s + 1]), pk2(pv[8 * s + 2], pv[8 * s + 3]), pk2(pv[8 * s + 4], pv[8 * s + 5]), pk2(pv[8 * s + 6], pv[8 * s + 7])};
    return __builtin_bit_cast(bf16x8, r);
}
#define CRW(reg) ((float)(((reg) & 3) + 8 * ((reg) >> 2)))

DI void phase_win(const Params& p, int l, int gw, int nw, int lane) {
    unsigned char* ws = p.ws;
    const bf16_t* PAB = (const bf16_t*)(ws + OFF_PAB); const bf16_t* VT = (const bf16_t*)(ws + OFF_VT); bf16_t* OB = (bf16_t*)(ws + OFF_OB);
    const int r32 = lane & 31, hh = lane >> 5;
    for (int item = gw; item < 6144; item += nw) {
        const int qt = item & 255, qh = (item >> 8) % 6, b = item / 1536, kvh = qh / 3;
        const int q0 = qt * 32, qi = q0 + r32;
        const bf16_t* qrow = PAB + ((size_t)b * SEQ + qi) * LDAB + qh * 64;
        bf16x8 qf[4];
#pragma unroll
        for (int st = 0; st < 4; ++st) qf[st] = *(const bf16x8*)(qrow + 16 * st + 8 * hh);
        const float slope2 = exp2f(-8.f * (float)(qh + 1) / 6.f) * LOG2E, scale2 = 0.125f * LOG2E;
        float m = p.in[7][l * 6 + qh] * LOG2E, lsum = hh == 0 ? 1.f : 0.f;
        f32x16 O[2];
#pragma unroll
        for (int i = 0; i < 16; ++i) { O[0][i] = 0.f; O[1][i] = 0.f; }
        const int kb0 = q0 - 128 < 0 ? 0 : q0 - 128, kb1 = q0 + 160 > SEQ ? SEQ : q0 + 160;
        for (int kb = kb0; kb < kb1; kb += 32) {
            const bf16_t* krow = PAB + ((size_t)b * SEQ + kb + r32) * LDAB + 384 + kvh * 64;
            f32x16 s;
#pragma unroll
            for (int i = 0; i < 16; ++i) s[i] = 0.f;
#pragma unroll
            for (int st = 0; st < 4; ++st) { const bf16x8 kf = *(const bf16x8*)(krow + 16 * st + 8 * hh); s = MFMA32(kf, qf[st], s); }
            bf16x8 vf[2][2];
#pragma unroll
            for (int dt = 0; dt < 2; ++dt) { const bf16_t* vrow = VT + ((size_t)(b * 6 + kvh) * 64 + 32 * dt + r32) * SEQ + kb + 4 * hh;
                vf[dt][0] = ld2x8(vrow, vrow + 8); vf[dt][1] = ld2x8(vrow + 16, vrow + 24); }
            const float qoff = (float)(kb + 4 * hh - qi);
            float t[16]; float mx = m;
#pragma unroll
            for (int reg = 0; reg < 16; ++reg) { const float ad = fabsf(qoff + CRW(reg)); float tv = s[reg] * scale2 - slope2 * ad; tv = (ad <= 128.f) ? tv : -1e30f; t[reg] = tv; mx = fmaxf(mx, tv); }
            mx = fmaxf(mx, __shfl_xor(mx, 32));
            const float alpha = fexp2(m - mx); m = mx;
            float ps = 0.f;
#pragma unroll
            for (int reg = 0; reg < 16; ++reg) { t[reg] = fexp2(t[reg] - m); ps += t[reg]; }
            lsum = lsum * alpha + ps;
#pragma unroll
            for (int i = 0; i < 16; ++i) { O[0][i] *= alpha; O[1][i] *= alpha; }
            const bf16x8 pf0 = packp(t, 0), pf1 = packp(t, 1);
#pragma unroll
            for (int dt = 0; dt < 2; ++dt) { O[dt] = MFMA32(vf[dt][0], pf0, O[dt]); O[dt] = MFMA32(vf[dt][1], pf1, O[dt]); }
        }
        lsum += __shfl_xor(lsum, 32);
        const float inv = 1.f / lsum;
        bf16_t* orow = OB + ((size_t)b * SEQ + qi) * DM + qh * 64;
#pragma unroll
        for (int dt = 0; dt < 2; ++dt)
#pragma unroll
            for (int g4 = 0; g4 < 4; ++g4) {
                u32x2 w = {pk2(O[dt][4 * g4] * inv, O[dt][4 * g4 + 1] * inv), pk2(O[dt][4 * g4 + 2] * inv, O[dt][4 * g4 + 3] * inv)};
                *(u32x2*)(orow + 32 * dt + 8 * g4 + 4 * hh) = w;
            }
    }
}

DI bf16x8 scale_frag(bf16x8 v, float sc) {
    u32x4 u = __builtin_bit_cast(u32x4, v), r;
#pragma unroll
    for (int i = 0; i < 4; ++i) r[i] = pk2(bflo(u[i]) * sc, bfhi(u[i]) * sc);
    return __builtin_bit_cast(bf16x8, r);
}
DI void phase_diff(const Params& p, int l, int tid0, unsigned char* shm) {
    unsigned char* ws = p.ws;
    const bf16_t* PAB = (const bf16_t*)(ws + OFF_PAB); const bf16_t* VT = (const bf16_t*)(ws + OFF_VT); bf16_t* OB = (bf16_t*)(ws + OFF_OB);
    const float lam_init = l == 0 ? 0.2f : (0.8f - 0.6f * 0.7408182206817179f);
    float lam;
    {
        const int lane = tid0 & 63;
        const float* dl = p.in[8] + l * 128;
        float a = 0.f, c = 0.f;
        if (lane < 32) { a = dl[lane] * dl[32 + lane]; c = dl[64 + lane] * dl[96 + lane]; }
        a = wave_sum(a); c = wave_sum(c);
        lam = expf(a) - expf(c) + lam_init;
    }
    const float* dg = p.in[9] + l * 64;
    unsigned* qctr = (unsigned*)(ws + OFF_MISC) + 64 + l;
    const unsigned* kmx = (const unsigned*)(ws + OFF_MISC) + l * 32;
    volatile unsigned* sq = (volatile unsigned*)(shm + 32768);
    for (;;) {
        int tid = tid0; asm volatile("" : "+v"(tid));
        __syncthreads();
        if (tid == 0) sq[0] = atomicAdd(qctr, 1u);
        __syncthreads();
        const int idx_item = (int)sq[0];
        if (idx_item >= 1280) break;
        const int lane = tid & 63, wid = tid >> 6, r32 = lane & 31, hh = lane >> 5;
        if (idx_item >= 512) { phase_win(p, l, (idx_item - 512) * 8 + wid, 6144, lane); continue; }
        const int qb = idx_item & 31, b = (idx_item >> 5) & 3, h = 3 - (idx_item >> 7);
        const int q0 = qb * 256 + wid * 32, qi = q0 + r32;
        const bf16_t* qrow = PAB + ((size_t)b * SEQ + qi) * LDAB + 640 + h * 64;
        const float scale2 = 0.17677669529663687f * LOG2E;
        bf16x8 qf[2][2];
#pragma unroll
        for (int mp = 0; mp < 2; ++mp)
#pragma unroll
            for (int st = 0; st < 2; ++st) qf[mp][st] = scale_frag(*(const bf16x8*)(qrow + mp * 32 + 16 * st + 8 * hh), scale2);
        const float slope2 = exp2f(-2.f * (float)(h + 1)) * LOG2E;
        float mA = -1e30f, mB = -1e30f, lA = 0.f, lB = 0.f;
        f32x16 OA[2], OBb[2];
#pragma unroll
        for (int i = 0; i < 16; ++i) { OA[0][i] = 0.f; OA[1][i] = 0.f; OBb[0][i] = 0.f; OBb[1][i] = 0.f; }
        const int srow = tid >> 3, sch = tid & 7;
        const bf16_t* kg = PAB + ((size_t)b * SEQ + srow) * LDAB + 896 + h * 64 + sch * 8;
        const bf16_t* vg = VT + ((size_t)(b * 6 + 2 + h) * 64 + srow) * SEQ + sch * 8;
        const int kwoff = srow * 128 + ((sch ^ (srow & 7)) * 16);
        const int vblk = sch >> 1, vhalf = sch & 1;
        const int vwoff0 = 16384 + srow * 128 + (((2 * vblk) ^ (srow & 7)) * 16) + 8 * vhalf;
        const int vwoff1 = 16384 + srow * 128 + (((2 * vblk + 1) ^ (srow & 7)) * 16) + 8 * vhalf;
        int lo, hi;
        {
            float qa = 0.f, qbm = 0.f;
#pragma unroll
            for (int st = 0; st < 2; ++st) { const u32x4 va = __builtin_bit_cast(u32x4, qf[0][st]), vb = __builtin_bit_cast(u32x4, qf[1][st]);
#pragma unroll
                for (int e = 0; e < 4; ++e) { qa += bflo(va[e]) * bflo(va[e]) + bfhi(va[e]) * bfhi(va[e]); qbm += bflo(vb[e]) * bflo(vb[e]) + bfhi(vb[e]) * bfhi(vb[e]); } }
            qa += __shfl_xor(qa, 32); qbm += __shfl_xor(qbm, 32);
#pragma unroll
            for (int o = 16; o > 0; o >>= 1) { qa = fmaxf(qa, __shfl_xor(qa, o)); qbm = fmaxf(qbm, __shfl_xor(qbm, o)); }
            if (lane == 0) { sq[8 + 2 * wid] = __float_as_uint(qa); sq[9 + 2 * wid] = __float_as_uint(qbm); }
            __syncthreads();
            float qA = 0.f, qB = 0.f;
#pragma unroll
            for (int w8 = 0; w8 < 8; ++w8) { qA = fmaxf(qA, __uint_as_float(sq[8 + 2 * w8])); qB = fmaxf(qB, __uint_as_float(sq[9 + 2 * w8])); }
            const float kA = __uint_as_float(kmx[b * 8 + h * 2]), kB = __uint_as_float(kmx[b * 8 + h * 2 + 1]);
            const float bnd = 2.02f * fmaxf(sqrtf(qA * kA), sqrtf(qB * kB)) + 1.f;
            const float dsk = (168.f + bnd) / slope2;
            const int Dsk = dsk > 16384.f ? 16384 : (int)dsk + 1;
            const int Q0 = qb * 256;
            const int x = Q0 - 63 - Dsk; lo = x <= 0 ? 0 : (x + 63) >> 6;
            const int y = (Q0 + 255 + Dsk) >> 6; hi = y > 127 ? 127 : y;
        }
        const int d0 = qb * 4, nright = hi - d0 + 1, nstage = hi - lo + 1;
        u32x4 kreg, vreg;
        { const int kb = d0 * 64; kreg = *(const u32x4*)(kg + (size_t)kb * LDAB); vreg = *(const u32x4*)(vg + kb); }
        __syncthreads();
        *(u32x4*)(shm + kwoff) = kreg;
        *(u32x2*)(shm + vwoff0) = (u32x2){vreg.x, vreg.y}; *(u32x2*)(shm + vwoff1) = (u32x2){vreg.z, vreg.w};
        __syncthreads();
        for (int idx = 0; idx < nstage; ++idx) {
            const int kt = idx < nright ? d0 + idx : d0 - 1 - (idx - nright);
            const int buf = idx & 1;
            if (idx + 1 < nstage) {
                const int idn = idx + 1; const int ktn = idn < nright ? d0 + idn : d0 - 1 - (idn - nright);
                const int kbn = ktn * 64;
                kreg = *(const u32x4*)(kg + (size_t)kbn * LDAB); vreg = *(const u32x4*)(vg + kbn);
            }
            const unsigned char* Ks = shm + buf * 8192; const unsigned char* Vs = shm + 16384 + buf * 8192;
#pragma unroll
            for (int j = 0; j < 2; ++j) {
                const int kb = kt * 64 + 32 * j;
                bf16x8 kf[2][2], vf[2][2];
#pragma unroll
                for (int mp = 0; mp < 2; ++mp)
#pragma unroll
                    for (int st = 0; st < 2; ++st) kf[mp][st] = *(const bf16x8*)(Ks + (32 * j + r32) * 128 + (((mp * 4 + 2 * st + hh) ^ (r32 & 7)) * 16));
#pragma unroll
                for (int dt = 0; dt < 2; ++dt)
#pragma unroll
                    for (int s_ = 0; s_ < 2; ++s_) vf[dt][s_] = *(const bf16x8*)(Vs + (32 * dt + r32) * 128 + (((4 * j + 2 * s_ + hh) ^ (r32 & 7)) * 16));
                f32x16 sA, sB;
#pragma unroll
                for (int i = 0; i < 16; ++i) { sA[i] = 0.f; sB[i] = 0.f; }
                sA = MFMA32(kf[0][0], qf[0][0], sA); sA = MFMA32(kf[0][1], qf[0][1], sA);
                sB = MFMA32(kf[1][0], qf[1][0], sB); sB = MFMA32(kf[1][1], qf[1][1], sB);
                float qoff = (float)(kb + 4 * hh - qi); asm volatile("" : "+v"(qoff));
                float tA[16], tB[16]; float mxA = mA, mxB = mB;
#pragma unroll
                for (int reg = 0; reg < 16; ++reg) { const float ad = fabsf(qoff + CRW(reg));
                    tA[reg] = __builtin_fmaf(-slope2, ad, sA[reg]); tB[reg] = __builtin_fmaf(-slope2, ad, sB[reg]); mxA = fmaxf(mxA, tA[reg]); mxB = fmaxf(mxB, tB[reg]); }
                mxA = fmaxf(mxA, __shfl_xor(mxA, 32)); mxB = fmaxf(mxB, __shfl_xor(mxB, 32));
                if (__builtin_amdgcn_ballot_w64(mxA > mA) != 0ull) {
                    const float alpha = fexp2(mA - mxA); mA = mxA; lA *= alpha;
#pragma unroll
                    for (int i = 0; i < 16; ++i) { OA[0][i] *= alpha; OA[1][i] *= alpha; }
                }
                if (__builtin_amdgcn_ballot_w64(mxB > mB) != 0ull) {
                    const float alpha = fexp2(mB - mxB); mB = mxB; lB *= alpha;
#pragma unroll
                    for (int i = 0; i < 16; ++i) { OBb[0][i] *= alpha; OBb[1][i] *= alpha; }
                }
                float psA = 0.f, psB = 0.f;
#pragma unroll
                for (int reg = 0; reg < 16; ++reg) { tA[reg] = fexp2(tA[reg] - mA); psA += tA[reg]; tB[reg] = fexp2(tB[reg] - mB); psB += tB[reg]; }
                lA += psA; lB += psB;
                const bf16x8 pA0 = packp(tA, 0), pA1 = packp(tA, 1), pB0 = packp(tB, 0), pB1 = packp(tB, 1);
#pragma unroll
                for (int dt = 0; dt < 2; ++dt) {
                    OA[dt] = MFMA32(vf[dt][0], pA0, OA[dt]); OA[dt] = MFMA32(vf[dt][1], pA1, OA[dt]);
                    OBb[dt] = MFMA32(vf[dt][0], pB0, OBb[dt]); OBb[dt] = MFMA32(vf[dt][1], pB1, OBb[dt]);
                }
            }
            if (idx + 1 < nstage) {
                unsigned char* wb = shm + (buf ^ 1) * 8192;
                *(u32x4*)(wb + kwoff) = kreg;
                *(u32x2*)(wb + vwoff0) = (u32x2){vreg.x, vreg.y}; *(u32x2*)(wb + vwoff1) = (u32x2){vreg.z, vreg.w};
            }
            __syncthreads();
        }
        lA += __shfl_xor(lA, 32); lB += __shfl_xor(lB, 32);
        const float iA = 1.f / lA, iB = lam / lB;
        float ss = 0.f;
#pragma unroll
        for (int dt = 0; dt < 2; ++dt)
#pragma unroll
            for (int i = 0; i < 16; ++i) { const float v = OA[dt][i] * iA - OBb[dt][i] * iB; OA[dt][i] = v; ss += v * v; }
        ss += __shfl_xor(ss, 32);
        const float rstd = __builtin_amdgcn_rsqf(ss * (1.f / 64.f) + EPS) * (1.f - lam_init);
        bf16_t* orow = OB + ((size_t)b * SEQ + qi) * DM + 384 + h * 64;
#pragma unroll
        for (int dt = 0; dt < 2; ++dt)
#pragma unroll
            for (int g4 = 0; g4 < 4; ++g4) {
                const int d = 32 * dt + 8 * g4 + 4 * hh;
                const f32x4 gv = *(const f32x4*)(dg + d);
                u32x2 w = {pk2(OA[dt][4 * g4] * rstd * gv[0], OA[dt][4 * g4 + 1] * rstd * gv[1]), pk2(OA[dt][4 * g4 + 2] * rstd * gv[2], OA[dt][4 * g4 + 3] * rstd * gv[3])};
                *(u32x2*)(orow + d) = w;
            }
    }
}

DI void phase_post(const Params& p, int l, int gw, int nw, int lane) {
    unsigned char* ws = p.ws;
    const bf16_t* OT = (const bf16_t*)(ws + OFF_WB); const bf16_t* PAB = (const bf16_t*)(ws + OFF_PAB); bf16_t* OB = (bf16_t*)(ws + OFF_OB);
    const float gl = p.in[12][l * 64 + lane];
    for (int u = gw; u < 6144; u += nw) {
        const int half = u & 1, h = (u % 12) >> 1, ck = u / 12, b = ck >> 7, chunk = ck & 127;
        const size_t itf = ((size_t)((b * 6 + h) * 2) * 128 + chunk), itb = ((size_t)((b * 6 + h) * 2 + 1) * 128 + (127 - chunk));
        const size_t tok0 = (size_t)b * SEQ + chunk * 64 + half * 32;
#pragma unroll 1
        for (int g = 0; g < 2; ++g) {
            float av[16], zv[16];
#pragma unroll
            for (int j = 0; j < 16; ++j) {
                const int t = half * 32 + g * 16 + j;
                av[j] = bf2f(OT[itf * 4096 + t * 64 + lane]) + bf2f(OT[itb * 4096 + (63 - t) * 64 + lane]);
                zv[j] = bf2f(PAB[(tok0 + g * 16 + j) * LDAB + 1408 + h * 64 + lane]);
            }
#pragma unroll
            for (int j = 0; j < 16; ++j) {
                const float ss = wave_sum(av[j] * av[j]);
                const float y = av[j] * __builtin_amdgcn_rsqf(ss * (1.f / 64.f) + EPS) * gl;
                OB[(tok0 + g * 16 + j) * DM + 640 + h * 64 + lane] = f2bf(y * silu(zv[j]));
            }
        }
    }
}

constexpr int NPHASE = 30;
DI void run_phase(const Params& p, int ph, unsigned char* shm, int tid) {
    const int wid = tid >> 6, lane = tid & 63;
    const int gw = blockIdx.x * 8 + wid, nw = gridDim.x * 8;
    unsigned char* ws = p.ws;
    if (ph == 0) { if (EN(0)) { phase_init(p, gw, nw, lane); phase_convw(p, 0, shm, tid); } return; }
    if (ph == NPHASE - 1) { if (EN(27)) phase_final(p, gw, nw, lane); return; }
    const int l = (ph - 1) / 14, sub = (ph - 1) % 14;
    float* rss = (float*)(ws + OFF_RSS);
    bf16_t* XB = (bf16_t*)(ws + OFF_XB);
    LAS unsigned char* lds = (LAS unsigned char*)shm;
    pg8::StaticOrder S;
    if (sub == 0) { if (EN(0)) if (l > 0) phase_convw(p, l, shm, tid); return; }
    if (EN(1)) if (sub == 1 || sub == 12) {
        const int f = sub == 1 ? 0 : 1;
        pg8::Gemm g{XB, (const bf16_t*)(ws + (f ? OFF_W_FFN2IN : OFF_W_FFN1IN)), MTOK, NFF, DM};
        EpiSwiglu E{(bf16_t*)(ws + OFF_BIG), rss + (size_t)((3 * l + (f ? 2 : 0)) & 1) * MTOK * 16};
        S.init(MTOK, NFF, gridDim.x, blockIdx.x);
        pg8::gemm_phase(tid, lds, g, S, E);
        if ((REPMASK >> 1) & 1) { __syncthreads(); pg8::gemm_phase(tid, lds, g, S, E); }
        return;
    }
    if (EN(2)) if (sub == 2 || sub == 13 || sub == 11) {
        const bf16_t* A; const bf16_t* Bt; int K; float scale; int nn;
        if (sub == 2) { A = (const bf16_t*)(ws + OFF_BIG); Bt = (const bf16_t*)(ws + OFF_W_FFN1OUT); K = DFFP; scale = 0.5f; nn = 3 * l + 1; }
        else if (sub == 13) { A = (const bf16_t*)(ws + OFF_BIG); Bt = (const bf16_t*)(ws + OFF_W_FFN2OUT); K = DFFP; scale = 0.5f; nn = 3 * l + 3; }
        else { A = (const bf16_t*)(ws + OFF_OB); Bt = (const bf16_t*)(ws + OFF_W_MIXOUT); K = DM; scale = 1.f; nn = 3 * l + 2; }
        pg8::Gemm g{A, Bt, MTOK, DM, K};
        EpiResid E{p.out, XB, rss + (size_t)(nn & 1) * MTOK * 16, scale};
        S.init(MTOK, DM, gridDim.x, blockIdx.x);
        pg8::gemm_phase(tid, lds, g, S, E); return;
    }
    if (EN(3)) if (sub == 3) {
        pg8::Gemm g{XB, (const bf16_t*)(ws + OFF_W_MIXIN), MTOK, NMIX, DM};
        EpiMixIn E{(bf16_t*)(ws + OFF_PAB), (bf16_t*)(ws + OFF_PC), (float*)(ws + OFF_BG), rss + (size_t)((3 * l + 1) & 1) * MTOK * 16};
        S.init(MTOK, NMIX, gridDim.x, blockIdx.x);
        pg8::gemm_phase(tid, lds, g, S, E);
        return;
    }
    if (EN(4)) if (sub == 4) { REP(4) phase_prep(p, l, gw, nw, lane); return; }
    if (EN(5)) if (sub == 5) { REP(5) phase_chunk(p, l, gw, nw, lane, wid, shm); return; }
    if (EN(6)) if (sub == 6) {
        if (blockIdx.x < 48) phase_scan(p, lane, wid, shm);
        phase_diff(p, l, tid, shm);
        return;
    }
    if (EN(10)) if (sub == 7) { phase_outp(p, gw, nw, lane); return; }


    if (EN(9)) if (sub == 10) { REP(9) phase_post(p, l, gw, nw, lane); return; }
}

__global__ __launch_bounds__(512, 2) void mega(Params p) {
    extern __shared__ __attribute__((aligned(16))) unsigned char shm[];
#ifndef PROBE_DUP
    for (int ph = p.p0; ph < p.p1; ++ph) {
        if (ph == 1 || ph == 9 || ph == 10 || ph == 23 || ph == 24) continue;
        int tid = threadIdx.x; asm volatile("" : "+v"(tid));
        Params q = p;
#if defined(__HIP_DEVICE_COMPILE__)
        {
            typedef __attribute__((address_space(1))) unsigned char GUC; typedef __attribute__((address_space(1))) float GF; typedef __attribute__((address_space(1))) const float GCF;
            unsigned long long wsi = (unsigned long long)p.ws, oi = (unsigned long long)p.out; asm volatile("" : "+s"(wsi), "+s"(oi));
            q.ws = (unsigned char*)(GUC*)wsi; q.out = (float*)(GF*)oi;
#pragma unroll
            for (int ii = 0; ii < 18; ++ii) q.in[ii] = (const float*)(GCF*)(unsigned long long)p.in[ii];
        }
#endif
        run_phase(q, ph, shm, tid);
        if (ph + 1 < p.p1) { cg::this_grid().sync(); }
    }
#else
    for (int st = 0; st < 2 * NPHASE; ++st) {
        const int ph = st >> 1;
        if (ph == 1 || ph == 9 || ph == 10 || ph == 23 || ph == 24) continue;
        const int subp = (ph >= 1 && ph <= 28) ? (ph - 1) % 14 : (ph == 0 ? 14 : 15);
        if ((st & 1) && !((PROBE_DUP >> subp) & 1)) continue;
        int tid = threadIdx.x; asm volatile("" : "+v"(tid));
        Params q = p; asm volatile("" : "+s"(q.ws), "+s"(q.out));
        run_phase(q, ph, shm, tid);
        cg::this_grid().sync();
    }
#endif
}

extern "C" void kernel_launch(void* const* d_in, const int* in_sizes, int n_in, void* d_out, int out_size, void* d_ws, size_t ws_size, hipStream_t stream) {
    static int grid = 0;
    if (!grid) {
        hipFuncSetAttribute((const void*)mega, hipFuncAttributeMaxDynamicSharedMemorySize, LDS_BYTES);
        int dev = 0, cus = 0, per = 0;
        hipGetDevice(&dev);
        hipDeviceGetAttribute(&cus, hipDeviceAttributeMultiprocessorCount, dev);
        hipOccupancyMaxActiveBlocksPerMultiprocessor(&per, mega, 512, LDS_BYTES);
        if (per < 1) per = 1;
        grid = cus * per;
        if (grid > 256) grid = 256;
    }
    Params p{};
    for (int i = 0; i < 18; ++i) p.in[i] = (const float*)d_in[i];
    p.out = (float*)d_out; p.ws = (unsigned char*)d_ws;
#if MULTI
    for (int ph = 0; ph < NPHASE; ++ph) {
        if (ph == 1 || ph == 9 || ph == 10 || ph == 23 || ph == 24) continue;
        p.p0 = ph; p.p1 = ph + 1;
        hipLaunchKernelGGL(mega, dim3(grid), dim3(512), LDS_BYTES, stream, p);
    }
#else
    p.p0 = 0; p.p1 = NPHASE;
    void* args[] = {&p};
    hipError_t e = hipLaunchCooperativeKernel((const void*)mega, dim3(grid), dim3(512), args, LDS_BYTES, stream);
    if (e != hipSuccess) fprintf(stderr, "cooperative launch failed: %s (grid %d)\n", hipGetErrorString(e), grid);
#endif
}
```

```cpp
#include <hip/hip_runtime.h>
#include <hip/hip_cooperative_groups.h>
#include <cstdio>
namespace cg = cooperative_groups;


#ifndef REPMASK
#define REPMASK 0
#endif
#define REP(k) for (int rep_ = 0; rep_ < (((REPMASK >> (k)) & 1) ? 2 : 1); ++rep_)
#ifndef MULTI
#define MULTI 0
#endif

#ifdef ONLY
#define EN(k) (ONLY==(k))
#else
#define EN(k) 1
#endif
#define DI __device__ __forceinline__
#define LAS __attribute__((address_space(3)))
typedef unsigned short bf16_t;
typedef short bf16x8 __attribute__((ext_vector_type(8)));
typedef short s16x4 __attribute__((ext_vector_type(4)));
typedef float f32x4 __attribute__((ext_vector_type(4)));
typedef float f32x16 __attribute__((ext_vector_type(16)));
typedef float f32x2 __attribute__((ext_vector_type(2)));
typedef unsigned u32x4 __attribute__((ext_vector_type(4)));
typedef unsigned u32x2 __attribute__((ext_vector_type(2)));
typedef __bf16 bf16v2 __attribute__((ext_vector_type(2)));

constexpr int DM = 1024, NBATCH = 4, SEQ = 8192, MTOK = NBATCH * SEQ, DFF = 2752, DFFP = 2816, NFF = 2 * DFFP, NMIX = 3072;
constexpr int LDAB = 1792, LDC = 1280;
constexpr float EPS = 1e-6f, LOG2E = 1.4426950408889634f;
constexpr int LDS_BYTES = 131072;

constexpr size_t SZ_W_FFNIN = (size_t)NFF * DM * 2, SZ_W_FFNOUT = (size_t)DM * DFFP * 2, SZ_W_MIXIN = (size_t)NMIX * DM * 2, SZ_W_MIXOUT = (size_t)DM * DM * 2;
constexpr size_t OFF_W_FFN1IN = 0;
constexpr size_t OFF_W_FFN1OUT = OFF_W_FFN1IN + SZ_W_FFNIN;
constexpr size_t OFF_W_MIXIN = OFF_W_FFN1OUT + SZ_W_FFNOUT;
constexpr size_t OFF_W_MIXOUT = OFF_W_MIXIN + SZ_W_MIXIN;
constexpr size_t OFF_W_FFN2IN = OFF_W_MIXOUT + SZ_W_MIXOUT;
constexpr size_t OFF_W_FFN2OUT = OFF_W_FFN2IN + SZ_W_FFNIN;
constexpr size_t OFF_XB = OFF_W_FFN2OUT + SZ_W_FFNOUT;
constexpr size_t SZ_TILE = (size_t)3072 * 4096 * 2;
constexpr size_t OFF_QC = OFF_XB, OFF_KTC = OFF_XB + SZ_TILE;
constexpr size_t OFF_OB = OFF_XB + (size_t)MTOK * DM * 2;
constexpr size_t OFF_BIG = OFF_OB + (size_t)MTOK * DM * 2;
constexpr size_t OFF_PAB = OFF_BIG, OFF_PC = OFF_BIG + (size_t)MTOK * LDAB * 2;
constexpr size_t OFF_U = OFF_PC, OFF_WB = OFF_PC + (size_t)6144 * 8192;
constexpr size_t OFF_BG = OFF_WB + (size_t)6144 * 8192;
constexpr size_t OFF_RSS = OFF_BG + (size_t)MTOK * 24 * 4;
constexpr size_t OFF_VT = OFF_RSS + (size_t)2 * MTOK * 16 * 4;
constexpr size_t OFF_KC = OFF_VT + (size_t)NBATCH * 6 * 64 * SEQ * 2;
constexpr size_t OFF_VTC = OFF_KC + SZ_TILE;
constexpr size_t OFF_SST = OFF_KC;
constexpr size_t OFF_QK = OFF_VTC + SZ_TILE;
constexpr size_t OFF_GC = OFF_QK + (size_t)6144 * 8192;
constexpr size_t OFF_MISC = OFF_GC + (size_t)6144 * 64 * 4;
constexpr size_t OFF_BAR = OFF_MISC + 512;
constexpr size_t WS_TOTAL = OFF_BAR + 3456 * 4;
static_assert(WS_TOTAL <= (size_t)536870912, "workspace too large");
static_assert((size_t)MTOK * DFFP * 2 <= OFF_BG - OFF_BIG, "hidden does not fit");

struct Params {
    const float* in[18];
    float* out;
    unsigned char* ws;
    int p0, p1;
};

DI unsigned pk2(float a, float b) { f32x2 v = {a, b}; bf16v2 r = __builtin_convertvector(v, bf16v2); return __builtin_bit_cast(unsigned, r); }
DI bf16_t f2bf(float a) { return (bf16_t)(pk2(a, 0.f) & 0xffffu); }
DI float bf2f(bf16_t v) { return __uint_as_float(((unsigned)v) << 16); }
DI float bflo(unsigned v) { return __uint_as_float(v << 16); }
DI float bfhi(unsigned v) { return __uint_as_float(v & 0xffff0000u); }
DI float wave_sum(float v) {
    v += __builtin_bit_cast(float, __builtin_amdgcn_update_dpp(0, __builtin_bit_cast(int, v), 0xB1, 0xf, 0xf, true));
    v += __builtin_bit_cast(float, __builtin_amdgcn_update_dpp(0, __builtin_bit_cast(int, v), 0x4E, 0xf, 0xf, true));
    v += __builtin_bit_cast(float, __builtin_amdgcn_update_dpp(0, __builtin_bit_cast(int, v), 0x141, 0xf, 0xf, true));
    v += __builtin_bit_cast(float, __builtin_amdgcn_update_dpp(0, __builtin_bit_cast(int, v), 0x140, 0xf, 0xf, true));
    const int iv = __builtin_bit_cast(int, v);
    const float a = __builtin_bit_cast(float, __builtin_amdgcn_readlane(iv, 0)), b = __builtin_bit_cast(float, __builtin_amdgcn_readlane(iv, 16));
    const float c = __builtin_bit_cast(float, __builtin_amdgcn_readlane(iv, 32)), d = __builtin_bit_cast(float, __builtin_amdgcn_readlane(iv, 48));
    return (a + b) + (c + d);
}
DI bf16x8 ld2x8(const bf16_t* a, const bf16_t* b) { u32x2 x = *(const u32x2*)a, y = *(const u32x2*)b; u32x4 r = {x.x, x.y, y.x, y.y}; return __builtin_bit_cast(bf16x8, r); }
DI unsigned rot16(unsigned x) { return (x >> 16) | (x << 16); }
DI bf16x8 ld2x8rev(const bf16_t* a, const bf16_t* b) {
    u32x2 x = *(const u32x2*)a, y = *(const u32x2*)b; u32x4 r = {rot16(x.y), rot16(x.x), rot16(y.y), rot16(y.x)}; return __builtin_bit_cast(bf16x8, r);
}
DI bf16x8 pack8(f32x4 a, f32x4 b) { u32x4 r = {pk2(a[0], a[1]), pk2(a[2], a[3]), pk2(b[0], b[1]), pk2(b[2], b[3])}; return __builtin_bit_cast(bf16x8, r); }
DI float fexp2(float x) { return __builtin_amdgcn_exp2f(x); }
DI float fexp(float x) { return __builtin_amdgcn_exp2f(x * LOG2E); }
DI float silu(float x) { return x * __builtin_amdgcn_rcpf(1.f + fexp(-x)); }
DI float row_rstd(const float* rp, int row) {
    const f32x4 a = *(const f32x4*)(rp + (size_t)row * 16), b = *(const f32x4*)(rp + (size_t)row * 16 + 4), c = *(const f32x4*)(rp + (size_t)row * 16 + 8), d = *(const f32x4*)(rp + (size_t)row * 16 + 12);
    const float s = ((a[0] + a[1]) + (a[2] + a[3])) + ((b[0] + b[1]) + (b[2] + b[3])) + ((c[0] + c[1]) + (c[2] + c[3])) + ((d[0] + d[1]) + (d[2] + d[3]));
    return __builtin_amdgcn_rsqf(s * (1.f / DM) + EPS);
}
#define MFMA16(a, b, c) __builtin_amdgcn_mfma_f32_16x16x32_bf16((a), (b), (c), 0, 0, 0)
#define MFMA32(a, b, c) __builtin_amdgcn_mfma_f32_32x32x16_bf16((a), (b), (c), 0, 0, 0)

namespace pg8 {
constexpr int BM = 256, BK = 64, HALF = 128, HTB = HALF * BK * 2, STAGE_BYTES = 8 * HTB, NXCD = 8, WGM = 8;
DI int lds_byte(int r, int c) { const int st = (r >> 4) * 2 + (c >> 5), rr = r & 15, cc = c & 31, ob = rr * 64 + cc * 2; return st * 1024 + (ob ^ (((ob >> 9) & 1) << 5)); }
DI void stage_rc(int b, int& R, int& C) { const int st = b / 1024, sb = b % 1024, swz = sb ^ (((sb >> 9) & 1) << 5); R = (st >> 1) * 16 + swz / 64; C = (st & 1) * 32 + (swz % 64) / 2; }
DI int perm32(int rho) { const int n = rho >> 4, i = rho & 15; return 8 * (i >> 2) + 4 * n + (i & 3); }
struct Unit { int pm, pn; };
struct Gemm { const bf16_t* A; const bf16_t* Bt; int M, N, K; };
struct StaticOrder {
    int nM, nN, nwg, G, c;
    DI void init(int M, int N, int G_, int c_) { nM = M / BM; nN = N / BM; nwg = nM * nN; G = G_; c = c_; }
    DI bool next(int i, Unit& u) const {
        const long L = (long)i * G + c; if (L >= nwg) return false;
        int wgid = (int)L; { const int q = nwg / NXCD, r = nwg % NXCD, xcd = wgid % NXCD, off = wgid / NXCD; wgid = (xcd < r ? xcd * (q + 1) : r * (q + 1) + (xcd - r) * q) + off; }
        const int nig = WGM * nN, gid = wgid / nig, fm = gid * WGM, gsz = (nM - fm) < WGM ? (nM - fm) : WGM;
        u.pm = fm + ((wgid % nig) % gsz); u.pn = (wgid % nig) / gsz; return true;
    }
};
template <class Epi>
DI void gemm_phase(int tid, LAS unsigned char* lds, const Gemm g, const StaticOrder& S, const Epi& E) {
    const int wid = __builtin_amdgcn_readfirstlane(tid >> 6), lane = tid & 63, wr = wid >> 2, wc = wid & 3, fr = lane & 15, fq = lane >> 4;
    const int K = g.K, nt = K / BK;
    unsigned voffA[2], voffB[2];
#pragma unroll
    for (int i = 0; i < 2; ++i) { int R, C; stage_rc(tid * 16 + i * 8192, R, C); const int Rb = (R & ~31) + perm32(R & 31);
        voffA[i] = (unsigned)(R * K + C) * 2u; voffB[i] = (unsigned)(Rb * K + C) * 2u; }
    const size_t kstep = (size_t)(BK * 2);
    const size_t hstep = (size_t)HALF * K * 2;
    const size_t tstep = 2 * hstep;
    const unsigned ldsw = (unsigned)wid * 1024u;
    const int aoff = lds_byte(wr * 64 + fr, fq * 8), boff = lds_byte(wc * 32 + fr, fq * 8);
#define PG8_SA(b, h) (((b) * 2 + (h)) * HTB)
#define PG8_SB(b, h) ((4 + (b) * 2 + (h)) * HTB)
#define PG8_STAGE(bufoff, gbase, voff) do { _Pragma("unroll") for (int _i = 0; _i < 2; ++_i) \
        __builtin_amdgcn_global_load_lds((const unsigned*)((const char*)(gbase) + (voff)[_i]), (LAS unsigned*)(lds + (bufoff) + ldsw + _i * 8192), 16, 0, 0); } while (0)
#define PG8_LDA(dst, b, h) do { _Pragma("unroll") for (int m = 0; m < 4; ++m) _Pragma("unroll") for (int k = 0; k < 2; ++k) dst[m][k] = *(const LAS bf16x8*)(lds + PG8_SA(b, h) + aoff + m * 2048 + k * 1024); } while (0)
#define PG8_LDB(dst, b, h) do { _Pragma("unroll") for (int n = 0; n < 2; ++n) _Pragma("unroll") for (int k = 0; k < 2; ++k) dst[n][k] = *(const LAS bf16x8*)(lds + PG8_SB(b, h) + boff + n * 2048 + k * 1024); } while (0)
#define PG8_MMA(ai, bj, At, Bt) do { __builtin_amdgcn_s_setprio(1); _Pragma("unroll") for (int m = 0; m < 4; ++m) _Pragma("unroll") for (int n = 0; n < 2; ++n) _Pragma("unroll") for (int k = 0; k < 2; ++k) \
        acc[ai][bj][m][n] = __builtin_amdgcn_mfma_f32_16x16x32_bf16(Bt[n][k], At[m][k], acc[ai][bj][m][n], 0, 0, 0); __builtin_amdgcn_s_setprio(0); } while (0)
#define PG8_WAIT_V(n) asm volatile("s_waitcnt vmcnt(" #n ")" ::: "memory")
#define PG8_WAIT_L(n) asm volatile("s_waitcnt lgkmcnt(" #n ")" ::: "memory")
#define PG8_BAR __builtin_amdgcn_s_barrier()
#define PG8_SCHED __builtin_amdgcn_sched_barrier(0)
    Unit cur, nxt; int ui = 0;
    if (!S.next(0, cur)) return;
    f32x4 acc[2][2][4][2];
#pragma unroll
    for (int a = 0; a < 2; ++a)
#pragma unroll
        for (int b = 0; b < 2; ++b)
#pragma unroll
            for (int m = 0; m < 4; ++m)
#pragma unroll
                for (int n = 0; n < 2; ++n) acc[a][b][m][n] = (f32x4){0.f, 0.f, 0.f, 0.f};
    bf16x8 At[4][2], B0[2][2], B1[2][2];
    const char* cA = (const char*)g.A + (size_t)cur.pm * tstep; const char* cB = (const char*)g.Bt + (size_t)cur.pn * tstep;
    PG8_STAGE(PG8_SB(0, 0), cB, voffB); PG8_STAGE(PG8_SA(0, 0), cA, voffA); PG8_STAGE(PG8_SB(0, 1), cB + hstep, voffB); PG8_STAGE(PG8_SA(0, 1), cA + hstep, voffA);
    if (wr == 1) PG8_BAR;
    PG8_WAIT_V(4); PG8_BAR;
    PG8_STAGE(PG8_SB(1, 0), cB + kstep, voffB); PG8_STAGE(PG8_SA(1, 0), cA + kstep, voffA); PG8_STAGE(PG8_SB(1, 1), cB + hstep + kstep, voffB);
    PG8_WAIT_V(6); PG8_BAR;
    for (;;) {
        const bool has_next = S.next(ui + 1, nxt);
        const char* nA = has_next ? (const char*)g.A + (size_t)nxt.pm * tstep : cA; const char* nB = has_next ? (const char*)g.Bt + (size_t)nxt.pn * tstep : cB;
        for (int t = 0; t < nt; t += 2) {
            const bool last = (t == nt - 2);
            const char* a1 = cA + (size_t)(t + 1) * kstep;
            const char* a2 = last ? nA : cA + (size_t)(t + 2) * kstep; const char* b2 = last ? nB : cB + (size_t)(t + 2) * kstep;
            const char* a3 = a2 + kstep; const char* b3 = b2 + kstep;
            PG8_LDB(B0, 0, 0); PG8_SCHED; PG8_LDA(At, 0, 0); PG8_STAGE(PG8_SA(1, 1), a1 + hstep, voffA);
            PG8_WAIT_L(8); PG8_BAR; PG8_WAIT_L(0); PG8_MMA(0, 0, At, B0); PG8_BAR; PG8_SCHED;
            PG8_LDB(B1, 0, 1); PG8_STAGE(PG8_SB(0, 0), b2, voffB);
            PG8_BAR; PG8_WAIT_L(0); PG8_MMA(0, 1, At, B1); PG8_BAR;
            PG8_LDA(At, 0, 1); PG8_STAGE(PG8_SA(0, 0), a2, voffA);
            PG8_BAR; PG8_WAIT_L(0); PG8_MMA(1, 0, At, B0); PG8_BAR; PG8_SCHED;
            PG8_STAGE(PG8_SB(0, 1), b2 + hstep, voffB);
            PG8_WAIT_V(6); PG8_BAR; PG8_MMA(1, 1, At, B1); PG8_BAR;
            PG8_LDB(B0, 1, 0); PG8_SCHED; PG8_LDA(At, 1, 0); PG8_STAGE(PG8_SA(0, 1), a2 + hstep, voffA);
            PG8_WAIT_L(8); PG8_BAR; PG8_WAIT_L(0); PG8_MMA(0, 0, At, B0); PG8_BAR; PG8_SCHED;
            PG8_LDB(B1, 1, 1); PG8_STAGE(PG8_SB(1, 0), b3, voffB);
            PG8_BAR; PG8_WAIT_L(0); PG8_MMA(0, 1, At, B1); PG8_BAR;
            PG8_LDA(At, 1, 1); PG8_STAGE(PG8_SA(1, 0), a3, voffA);
            PG8_BAR; PG8_WAIT_L(0); PG8_MMA(1, 0, At, B0); PG8_BAR; PG8_SCHED;
            PG8_STAGE(PG8_SB(1, 1), b3 + hstep, voffB);
            PG8_WAIT_V(6); PG8_BAR; PG8_MMA(1, 1, At, B1); PG8_BAR;
        }
        E(acc, cur, wr, wc, fr, fq);
        if (!has_next) break;
#pragma unroll
        for (int a = 0; a < 2; ++a)
#pragma unroll
            for (int b = 0; b < 2; ++b)
#pragma unroll
                for (int m = 0; m < 4; ++m)
#pragma unroll
                    for (int n = 0; n < 2; ++n) acc[a][b][m][n] = (f32x4){0.f, 0.f, 0.f, 0.f};
        cur = nxt; cA = nA; cB = nB; ++ui;
    }
    PG8_WAIT_V(0);
    if (wr == 0) PG8_BAR;
    PG8_BAR;
#undef PG8_SA
#undef PG8_SB
#undef PG8_STAGE
#undef PG8_LDA
#undef PG8_LDB
#undef PG8_MMA
#undef PG8_WAIT_V
#undef PG8_WAIT_L
#undef PG8_BAR
#undef PG8_SCHED
}
}
using pg8::Unit;
typedef f32x4 AccT[2][2][4][2];

struct EpiSwiglu {
    bf16_t* H; const float* rss;
    DI void operator()(const AccT& acc, const Unit& u, int wr, int wc, int fr, int fq) const {
        const int row0 = u.pm * 256 + wr * 64 + fr, col0 = u.pn * 128 + wc * 32 + 8 * fq;
#pragma unroll
        for (int ai = 0; ai < 2; ++ai)
#pragma unroll
            for (int m = 0; m < 4; ++m) {
                const int row = row0 + ai * 128 + m * 16;
                const float rstd = row_rstd(rss, row);
                float hv[8];
#pragma unroll
                for (int n = 0; n < 2; ++n)
#pragma unroll
                    for (int j = 0; j < 4; ++j) { const float gg = acc[ai][0][m][n][j] * rstd, uu = acc[ai][1][m][n][j] * rstd; hv[4 * n + j] = silu(gg) * uu; }
                u32x4 w = {pk2(hv[0], hv[1]), pk2(hv[2], hv[3]), pk2(hv[4], hv[5]), pk2(hv[6], hv[7])};
                *(u32x4*)(H + (size_t)row * DFFP + col0) = w;
            }
    }
};
struct EpiResid {
    float* X; bf16_t* XB; float* rssn; float scale;
    DI void operator()(const AccT& acc, const Unit& u, int wr, int wc, int fr, int fq) const {
        const int row0 = u.pm * 256 + wr * 64 + fr, col0 = u.pn * 256 + wc * 32 + 8 * fq;
#pragma unroll
        for (int ai = 0; ai < 2; ++ai)
#pragma unroll
            for (int m = 0; m < 4; ++m) {
                const int row = row0 + ai * 128 + m * 16; float ss = 0.f;
#pragma unroll
                for (int bj = 0; bj < 2; ++bj) {
                    float* xp = X + (size_t)row * DM + col0 + bj * 128;
                    f32x4 x0 = *(const f32x4*)xp, x1 = *(const f32x4*)(xp + 4);
                    x0 += acc[ai][bj][m][0] * scale; x1 += acc[ai][bj][m][1] * scale;
                    *(f32x4*)xp = x0; *(f32x4*)(xp + 4) = x1;
                    u32x4 w = {pk2(x0[0], x0[1]), pk2(x0[2], x0[3]), pk2(x1[0], x1[1]), pk2(x1[2], x1[3])};
                    *(u32x4*)(XB + (size_t)row * DM + col0 + bj * 128) = w;
#pragma unroll
                    for (int j = 0; j < 4; ++j) ss += x0[j] * x0[j] + x1[j] * x1[j];
                }
                ss += __shfl_xor(ss, 16); ss += __shfl_xor(ss, 32);
                if (fq == 0) rssn[(size_t)row * 16 + u.pn * 4 + wc] = ss;
            }
    }
};
struct EpiMixIn {
    bf16_t* PAB; bf16_t* PC; float* BG; const float* rss;
    DI void operator()(const AccT& acc, const Unit& u, int wr, int wc, int fr, int fq) const {
        const int row0 = u.pm * 256 + wr * 64 + fr;
        bf16_t* base; int ld, ct;
        if (u.pn < 7) { base = PAB; ld = LDAB; ct = u.pn * 256; } else { base = PC; ld = LDC; ct = (u.pn - 7) * 256; }
        const int col0 = ct + wc * 32 + 8 * fq;
        const bool isbg = (u.pn == 11) && (wc == 0) && (fq < 3);
#pragma unroll
        for (int ai = 0; ai < 2; ++ai)
#pragma unroll
            for (int m = 0; m < 4; ++m) {
                const int row = row0 + ai * 128 + m * 16;
                const float rstd = row_rstd(rss, row);
#pragma unroll
                for (int bj = 0; bj < 2; ++bj) {
                    const f32x4 v0 = acc[ai][bj][m][0] * rstd, v1 = acc[ai][bj][m][1] * rstd;
                    u32x4 w = {pk2(v0[0], v0[1]), pk2(v0[2], v0[3]), pk2(v1[0], v1[1]), pk2(v1[2], v1[3])};
                    *(u32x4*)(base + (size_t)row * ld + col0 + bj * 128) = w;
                    if (bj == 1 && isbg) { float* bp = BG + (size_t)row * 24 + 8 * fq; *(f32x4*)bp = v0; *(f32x4*)(bp + 4) = v1; }
                }
            }
    }
};

DI int map_src(int kind, int n) {
    if (kind == 0) return n;
    if (kind == 1) { const int pn = n >> 8, bj = (n >> 7) & 1, i = n & 127; const int hid = pn * 128 + i; return hid < DFF ? hid + bj * DFF : -1; }
    if (n < 1408) return n;
    if (n < 1792) return 2560 + (n - 1408);
    if (n < 2944) return 1408 + (n - 1792);
    if (n < 2968) return n;
    return -1;
}
DI void conv_w(const float* __restrict__ W, int ldw, int Kreal, bf16_t* __restrict__ Bt, int Np, int Kp, const float* __restrict__ gain, int kind, float* tile, int tid) {
    const int tnn = Np >> 6, ntile = tnn * (Kp >> 6);
    for (int t = blockIdx.x; t < ntile; t += gridDim.x) {
        const int n0 = (t % tnn) << 6, k0 = (t / tnn) << 6;
        {
            const int tn = tid & 63, tk = tid >> 6; const int src = map_src(kind, n0 + tn);
#pragma unroll
            for (int r = 0; r < 8; ++r) { const int kk = tk + 8 * r, k = k0 + kk; float v = 0.f;
                if (src >= 0 && k < Kreal) { v = W[(size_t)k * ldw + src]; if (gain) v *= gain[k]; }
                tile[kk * 65 + tn] = v; }
        }
        __syncthreads();
        {
            const int rn = tid >> 3, kk = (tid & 7) * 8; float a[8];
#pragma unroll
            for (int j = 0; j < 8; ++j) a[j] = tile[(kk + j) * 65 + rn];
            u32x4 w = {pk2(a[0], a[1]), pk2(a[2], a[3]), pk2(a[4], a[5]), pk2(a[6], a[7])};
            *(u32x4*)(Bt + (size_t)(n0 + rn) * Kp + k0 + kk) = w;
        }
        __syncthreads();
    }
}
DI void phase_convw(const Params& p, int l, unsigned char* shm, int tid) {
    float* tile = (float*)shm; unsigned char* ws = p.ws;
    conv_w(p.in[2] + (size_t)l * DM * 2 * DFF, 2 * DFF, DM, (bf16_t*)(ws + OFF_W_FFN1IN), NFF, DM, p.in[1] + l * DM, 1, tile, tid);
    conv_w(p.in[3] + (size_t)l * DFF * DM, DM, DFF, (bf16_t*)(ws + OFF_W_FFN1OUT), DM, DFFP, nullptr, 0, tile, tid);
    conv_w(p.in[5] + (size_t)l * DM * 2968, 2968, DM, (bf16_t*)(ws + OFF_W_MIXIN), NMIX, DM, p.in[4] + l * DM, 2, tile, tid);
    conv_w(p.in[13] + (size_t)l * DM * DM, DM, DM, (bf16_t*)(ws + OFF_W_MIXOUT), DM, DM, nullptr, 0, tile, tid);
    conv_w(p.in[15] + (size_t)l * DM * 2 * DFF, 2 * DFF, DM, (bf16_t*)(ws + OFF_W_FFN2IN), NFF, DM, p.in[14] + l * DM, 1, tile, tid);
    conv_w(p.in[16] + (size_t)l * DFF * DM, DM, DFF, (bf16_t*)(ws + OFF_W_FFN2OUT), DM, DFFP, nullptr, 0, tile, tid);
}

DI void phase_init(const Params& p, int gw, int nw, int lane) {
    const float* x = p.in[0]; float* X = p.out; bf16_t* XB = (bf16_t*)(p.ws + OFF_XB); float* rss = (float*)(p.ws + OFF_RSS);
    for (int row0 = gw * 4; row0 < MTOK; row0 += nw * 4) {
        f32x4 v[4][4];
#pragma unroll
        for (int r = 0; r < 4; ++r)
#pragma unroll
            for (int i = 0; i < 4; ++i) v[r][i] = *(const f32x4*)(x + (size_t)(row0 + r) * DM + i * 256 + lane * 4);
#pragma unroll
        for (int r = 0; r < 4; ++r) {
            float ss = 0.f;
#pragma unroll
            for (int i = 0; i < 4; ++i) {
                const size_t o = (size_t)(row0 + r) * DM + i * 256 + lane * 4;
                *(f32x4*)(X + o) = v[r][i];
                u32x2 w = {pk2(v[r][i][0], v[r][i][1]), pk2(v[r][i][2], v[r][i][3])}; *(u32x2*)(XB + o) = w;
                ss += v[r][i][0] * v[r][i][0] + v[r][i][1] * v[r][i][1] + v[r][i][2] * v[r][i][2] + v[r][i][3] * v[r][i][3];
            }
            ss = wave_sum(ss); if (lane < 16) rss[(size_t)(row0 + r) * 16 + lane] = lane == 0 ? ss : 0.f;
        }
    }
    if (gw == 0) { unsigned* misc = (unsigned*)(p.ws + OFF_MISC); misc[lane] = 0u; misc[64 + lane] = 0u; }
}
DI void phase_final(const Params& p, int gw, int nw, int lane) {
    float* X = p.out; const float* rss = (const float*)(p.ws + OFF_RSS); const float* g = p.in[17];
    for (int row0 = gw * 4; row0 < MTOK; row0 += nw * 4) {
        f32x4 v[4][4]; float rstd[4];
#pragma unroll
        for (int r = 0; r < 4; ++r) {
            rstd[r] = row_rstd(rss, row0 + r);
#pragma unroll
            for (int i = 0; i < 4; ++i) v[r][i] = *(const f32x4*)(X + (size_t)(row0 + r) * DM + i * 256 + lane * 4);
        }
#pragma unroll
        for (int r = 0; r < 4; ++r)
#pragma unroll
            for (int i = 0; i < 4; ++i) {
                const int c = i * 256 + lane * 4; const f32x4 gv = *(const f32x4*)(g + c);
                *(f32x4*)(X + (size_t)(row0 + r) * DM + c) = v[r][i] * rstd[r] * gv;
            }
    }
}

DI void store_row64(bf16_t* dst, const float (&val)[64]) {
#pragma unroll
    for (int i = 0; i < 8; ++i) { u32x4 w = {pk2(val[8 * i], val[8 * i + 1]), pk2(val[8 * i + 2], val[8 * i + 3]), pk2(val[8 * i + 4], val[8 * i + 5]), pk2(val[8 * i + 6], val[8 * i + 7])};
        *(u32x4*)(dst + 8 * i) = w; }
}
DI void phase_prep(const Params& p, int l, int gw, int nw, int lane0) {
    unsigned char* ws = p.ws;
    const bf16_t* PAB = (const bf16_t*)(ws + OFF_PAB); const bf16_t* PC = (const bf16_t*)(ws + OFF_PC);
    bf16_t* QC = (bf16_t*)(ws + OFF_QC); bf16_t* KC = (bf16_t*)(ws + OFF_KC); bf16_t* KTC = (bf16_t*)(ws + OFF_KTC); bf16_t* VTC = (bf16_t*)(ws + OFF_VTC);
    bf16_t* VT = (bf16_t*)(ws + OFF_VT);
    const float* cw = p.in[6] + (size_t)l * 5 * 1152;
    for (int u = gw; u < 512 * 25; u += nw) {
        int lane = lane0; asm volatile("" : "+v"(lane));
        const int grp = u % 25, ck = u / 25, b = ck >> 7, chunk = ck & 127;
        if (grp == 24) {
            const bf16_t* kr = PAB + ((size_t)b * SEQ + chunk * 64 + lane) * LDAB + 896;
            unsigned* kmx = (unsigned*)(ws + OFF_MISC) + l * 32 + b * 8;
#pragma unroll
            for (int hm = 0; hm < 8; ++hm) {
                float ss = 0.f;
#pragma unroll
                for (int c4 = 0; c4 < 4; ++c4) { const u32x4 v = *(const u32x4*)(kr + hm * 32 + c4 * 8);
#pragma unroll
                    for (int e = 0; e < 4; ++e) { const float a = bflo(v[e]), bb = bfhi(v[e]); ss += a * a + bb * bb; } }
#pragma unroll
                for (int o = 32; o > 0; o >>= 1) ss = fmaxf(ss, __shfl_xor(ss, o));
                if (lane == 0) atomicMax(kmx + hm, __float_as_uint(ss));
            }
            continue;
        }
        float val[64];
        if (grp < 18) {
            const int type = grp / 6, h = grp % 6, col = type * 384 + h * 64 + lane;
            const float w0 = cw[col], w1 = cw[1152 + col], w2 = cw[2 * 1152 + col], w3 = cw[3 * 1152 + col], w4 = cw[4 * 1152 + col];
            float xv[68];
#pragma unroll
            for (int i = 0; i < 68; ++i) { const int pos = chunk * 64 - 2 + i;
                xv[i] = (pos >= 0 && pos < SEQ) ? bf2f(PC[((size_t)b * SEQ + pos) * LDC + col]) : 0.f; }
#pragma unroll
            for (int t = 0; t < 64; ++t) { const float v = w0 * xv[t] + w1 * xv[t + 1] + w2 * xv[t + 2] + w3 * xv[t + 3] + w4 * xv[t + 4]; val[t] = silu(v); }
            if (type < 2) {
                const float sc = type == 0 ? 0.125f : 1.f;
#pragma unroll
                for (int t = 0; t < 64; ++t) { const float ss = wave_sum(val[t] * val[t]); val[t] *= __builtin_amdgcn_rsqf(ss + EPS) * sc; }
            }
            const size_t tb = ((size_t)(b * 6 + h) * 128 + chunk) * 4096;
            if (type == 0) {
#pragma unroll
                for (int t = 0; t < 64; ++t) QC[tb + t * 64 + lane] = f2bf(val[t]);
            } else if (type == 1) {
#pragma unroll
                for (int t = 0; t < 64; ++t) KC[tb + t * 64 + lane] = f2bf(val[t]);
                store_row64(KTC + tb + lane * 64, val);
            } else {
                store_row64(VTC + tb + lane * 64, val);
            }
        } else {
            const int vh = grp - 18; const int col = (vh < 2 ? 512 + vh * 64 : 1152 + (vh - 2) * 64) + lane;
            const size_t tok0 = (size_t)b * SEQ + chunk * 64;
#pragma unroll
            for (int t = 0; t < 64; ++t) val[t] = bf2f(PAB[(tok0 + t) * LDAB + col]);
            store_row64(VT + ((size_t)(b * 6 + vh) * 64 + lane) * SEQ + chunk * 64, val);
        }
    }
}

DI void phase_chunk(const Params& p, int l, int gw, int nw, int lane0, int wid, unsigned char* shm) {
    unsigned char* ws = p.ws;
    float* Mf = (float*)(shm + wid * 16384); bf16_t* AB = (bf16_t*)Mf; bf16_t* ABG = AB + 4096;
    const bf16_t* QC = (const bf16_t*)(ws + OFF_QC); const bf16_t* KC = (const bf16_t*)(ws + OFF_KC);
    const bf16_t* KTC = (const bf16_t*)(ws + OFF_KTC); const bf16_t* VTC = (const bf16_t*)(ws + OFF_VTC);
    const float* BG = (const float*)(ws + OFF_BG);
    bf16_t* U = (bf16_t*)(ws + OFF_U); bf16_t* WB = (bf16_t*)(ws + OFF_WB); bf16_t* QK = (bf16_t*)(ws + OFF_QK); float* GC = (float*)(ws + OFF_GC);
    for (int it = gw; it < 6144; it += nw) {
        int lane = lane0; asm volatile("" : "+v"(lane));
        const int fr = lane & 15, q = lane >> 4;
        const int chunk = it & 127, seq = it >> 7, dir = seq & 1, bh = seq >> 1, b = bh / 6, h = bh % 6;
        const int pch = dir ? 127 - chunk : chunk;
        const size_t tb = ((size_t)bh * 128 + pch) * 4096;
        const int tkl = dir ? 63 - lane : lane;
        const size_t tok = (size_t)b * SEQ + pch * 64 + tkl;
        const float braw = BG[tok * 24 + dir * 6 + h], araw = BG[tok * 24 + 12 + dir * 6 + h];
        const float beta = 1.f / (1.f + expf(-braw));
        const float Aa = expf(p.in[10][l * 12 + dir * 6 + h]); const float xx = araw + p.in[11][l * 12 + dir * 6 + h];
        const float sp = fmaxf(xx, 0.f) + log1pf(expf(-fabsf(xx)));
        const float g = -Aa * sp;
        float gc = g;
#pragma unroll
        for (int o = 1; o < 64; o <<= 1) { const float t = __shfl_up(gc, o); if (lane >= o) gc += t; }
        GC[(size_t)it * 64 + lane] = gc;
        bf16x8 kf[4][2], qf[4][2];
#pragma unroll
        for (int m = 0; m < 4; ++m)
#pragma unroll
            for (int s = 0; s < 2; ++s) { const int row = 16 * m + fr; const int tr = dir ? 63 - row : row;
                kf[m][s] = *(const bf16x8*)(KC + tb + tr * 64 + 32 * s + 8 * q); qf[m][s] = *(const bf16x8*)(QC + tb + tr * 64 + 32 * s + 8 * q); }
#pragma unroll
        for (int m = 0; m < 4; ++m)
#pragma unroll
            for (int n = 0; n <= m; ++n) {
                f32x4 acc = {0.f, 0.f, 0.f, 0.f};
                acc = MFMA16(kf[m][0], kf[n][0], acc); acc = MFMA16(kf[m][1], kf[n][1], acc);
                const int s_ = 16 * n + fr; const float gcs = __shfl(gc, s_);
#pragma unroll
                for (int r = 0; r < 4; ++r) { const int c = 16 * m + 4 * q + r; const float gcc = __shfl(gc, c), bc = __shfl(beta, c);
                    Mf[c * 64 + s_] = (s_ < c) ? bc * acc[r] * fexp(gcc - gcs) : 0.f; }
                __builtin_amdgcn_sched_barrier(0);
            }
#pragma unroll
        for (int n = 0; n < 4; ++n)
#pragma unroll
            for (int m = 0; m < 4; ++m) {
                f32x4 v = {0.f, 0.f, 0.f, 0.f};
                const int c = 16 * n + fr;
                if (m <= n) {
                    f32x4 acc = {0.f, 0.f, 0.f, 0.f};
                    acc = MFMA16(kf[m][0], qf[n][0], acc); acc = MFMA16(kf[m][1], qf[n][1], acc);
                    const float gcc = __shfl(gc, c);
#pragma unroll
                    for (int r = 0; r < 4; ++r) { const int s_ = 16 * m + 4 * q + r; const float gcs = __shfl(gc, s_); v[r] = (s_ <= c) ? acc[r] * fexp(gcc - gcs) : 0.f; }
                }
                u32x2 w = {pk2(v[0], v[1]), pk2(v[2], v[3])};
                *(u32x2*)(QK + (size_t)it * 4096 + c * 64 + 16 * m + 4 * q) = w;
                __builtin_amdgcn_sched_barrier(0);
            }
        __builtin_amdgcn_sched_barrier(0);
        bf16x8 vfr[4][2], ktf[4][2];
#pragma unroll
        for (int n = 0; n < 4; ++n) {
            const bf16_t* vp = VTC + tb + (16 * n + fr) * 64 + 8 * q; vfr[n][0] = *(const bf16x8*)vp; vfr[n][1] = *(const bf16x8*)(vp + 32);
            const bf16_t* kp = KTC + tb + (16 * n + fr) * 64 + 8 * q; ktf[n][0] = *(const bf16x8*)kp; ktf[n][1] = *(const bf16x8*)(kp + 32);
        }
        float x[64];
#pragma unroll
        for (int i = 0; i < 64; ++i) {
            float a = (i == lane) ? 1.f : 0.f;
#pragma unroll
            for (int m = 0; m < i; ++m) a -= Mf[i * 64 + m] * x[m];
            x[i] = a;
            __builtin_amdgcn_sched_barrier(0);
        }
        {
            const float bj = beta, bgj = beta * fexp(gc);
#pragma unroll
            for (int i = 0; i < 64; ++i) { AB[i * 64 + tkl] = f2bf(x[i] * bj); ABG[i * 64 + tkl] = f2bf(x[i] * bgj); }
        }
        __builtin_amdgcn_sched_barrier(0);
#pragma unroll
        for (int m = 0; m < 4; ++m) {
            const bf16x8 a0 = *(const bf16x8*)(AB + (16 * m + fr) * 64 + 8 * q), a1 = *(const bf16x8*)(AB + (16 * m + fr) * 64 + 32 + 8 * q);
#pragma unroll
            for (int n = 0; n < 4; ++n) {
                const bf16x8 b0 = vfr[n][0], b1 = vfr[n][1];
                f32x4 acc = {0.f, 0.f, 0.f, 0.f};
                acc = MFMA16(a0, b0, acc); acc = MFMA16(a1, b1, acc);
                u32x2 w = {pk2(acc[0], acc[1]), pk2(acc[2], acc[3])};
                *(u32x2*)(U + (size_t)it * 4096 + (16 * n + fr) * 64 + 16 * m + 4 * q) = w;
            }
        }
        __builtin_amdgcn_sched_barrier(0);
#pragma unroll
        for (int n = 0; n < 4; ++n) {
            const bf16x8 b0 = *(const bf16x8*)(ABG + (16 * n + fr) * 64 + 8 * q), b1 = *(const bf16x8*)(ABG + (16 * n + fr) * 64 + 32 + 8 * q);
#pragma unroll
            for (int m = 0; m < 4; ++m) {
                const bf16x8 a0 = ktf[m][0], a1 = ktf[m][1];
                f32x4 acc = {0.f, 0.f, 0.f, 0.f};
                acc = MFMA16(a0, b0, acc); acc = MFMA16(a1, b1, acc);
                u32x2 w = {pk2(acc[0], acc[1]), pk2(acc[2], acc[3])};
                *(u32x2*)(WB + (size_t)it * 4096 + (16 * n + fr) * 64 + 16 * m + 4 * q) = w;
            }
        }
    }
}

constexpr int SCAN_SLOT = 25600;
DI void scan_issue(LAS unsigned char* slot, const bf16_t* WB, const bf16_t* U, const bf16_t* KTC, const float* GC, int seq, int bh, int dir, int lw, int i, int lane) {
    const int it = seq * 128 + i; const int pch = dir ? 127 - i : i;
    const bf16_t* Wp = WB + (size_t)it * 4096; const bf16_t* Kp = KTC + ((size_t)bh * 128 + pch) * 4096;
    const bf16_t* Up = U + (size_t)it * 4096 + (16 * lw) * 64; const float* gcp = GC + (size_t)it * 64;
    const int r8 = lane >> 3, c8 = lane & 7;
#pragma unroll
    for (int jj = 0; jj < 2; ++jj) {
        const int j = 2 * lw + jj;
        const int row = 8 * j + r8; const int cid = c8 ^ (row & 7);
        __builtin_amdgcn_global_load_lds((const unsigned*)(Wp + row * 64 + cid * 8), (LAS unsigned*)(slot + j * 1024), 16, 0, 0);
        __builtin_amdgcn_global_load_lds((const unsigned*)(Kp + row * 64 + cid * 8), (LAS unsigned*)(slot + 8192 + j * 1024), 16, 0, 0);
    }
#pragma unroll
    for (int j = 0; j < 2; ++j) {
        const int row = 8 * j + r8; const int cid = c8 ^ (row & 7);
        __builtin_amdgcn_global_load_lds((const unsigned*)(Up + row * 64 + cid * 8), (LAS unsigned*)(slot + 16384 + lw * 2048 + j * 1024), 16, 0, 0);
    }
    __builtin_amdgcn_global_load_lds((const unsigned*)(gcp + (lane & 15) * 4), (LAS unsigned*)(slot + 24576), 16, 0, 0);
}
DI u32x2 lds_piece(const LAS unsigned char* tile, int row, int e) {
    return *(const LAS u32x2*)(tile + row * 128 + ((((e >> 3) ^ (row & 7))) << 4) + ((e & 4) << 1));
}
DI bf16x8 mk8(u32x2 x, u32x2 y) { u32x4 r = {x.x, x.y, y.x, y.y}; return __builtin_bit_cast(bf16x8, r); }
DI bf16x8 mk8rev(u32x2 x, u32x2 y) { u32x4 r = {rot16(x.y), rot16(x.x), rot16(y.y), rot16(y.x)}; return __builtin_bit_cast(bf16x8, r); }
DI void scan_step(const LAS unsigned char* slot, int vs, int dir, int fr, int q, f32x4 (&S)[4], bf16_t* sst) {
    bf16x8 Sb[2];
    Sb[0] = pack8(S[0], S[1]); Sb[1] = pack8(S[2], S[3]);
    {
        const u32x4 s0 = __builtin_bit_cast(u32x4, Sb[0]), s1 = __builtin_bit_cast(u32x4, Sb[1]);
        *(u32x2*)(sst + 0) = (u32x2){s0.x, s0.y}; *(u32x2*)(sst + 16) = (u32x2){s0.z, s0.w};
        *(u32x2*)(sst + 32) = (u32x2){s1.x, s1.y}; *(u32x2*)(sst + 48) = (u32x2){s1.z, s1.w};
    }
    const LAS unsigned char* ut = slot + 16384 + vs * 2048;
    const LAS float* gcl_p = (const LAS float*)(slot + 24576);
    const float gcl = gcl_p[63]; const float gl = fexp(gcl);
    f32x4 vg[4];
#pragma unroll
    for (int m = 0; m < 4; ++m) {
        const int c = 16 * m + fr;
        const bf16x8 w0 = mk8(lds_piece(slot, c, 4 * q), lds_piece(slot, c, 16 + 4 * q)), w1 = mk8(lds_piece(slot, c, 32 + 4 * q), lds_piece(slot, c, 48 + 4 * q));
        f32x4 acc = {0.f, 0.f, 0.f, 0.f};
        acc = MFMA16(w0, Sb[0], acc); acc = MFMA16(w1, Sb[1], acc);
        const u32x2 uu = lds_piece(ut, fr, 16 * m + 4 * q);
        const f32x4 gcv = *(const LAS f32x4*)(slot + 24576 + (16 * m + 4 * q) * 4);
        vg[m][0] = (bflo(uu.x) - acc[0]) * fexp(gcl - gcv[0]); vg[m][1] = (bfhi(uu.x) - acc[1]) * fexp(gcl - gcv[1]);
        vg[m][2] = (bflo(uu.y) - acc[2]) * fexp(gcl - gcv[2]); vg[m][3] = (bfhi(uu.y) - acc[3]) * fexp(gcl - gcv[3]);
    }
    bf16x8 Vg[2];
    Vg[0] = pack8(vg[0], vg[1]); Vg[1] = pack8(vg[2], vg[3]);
#pragma unroll
    for (int kt = 0; kt < 4; ++kt) {
        const int k = 16 * kt + fr;
        bf16x8 k0, k1;
        if (dir == 0) { k0 = mk8(lds_piece(slot + 8192, k, 4 * q), lds_piece(slot + 8192, k, 16 + 4 * q)); k1 = mk8(lds_piece(slot + 8192, k, 32 + 4 * q), lds_piece(slot + 8192, k, 48 + 4 * q)); }
        else { k0 = mk8rev(lds_piece(slot + 8192, k, 60 - 4 * q), lds_piece(slot + 8192, k, 44 - 4 * q)); k1 = mk8rev(lds_piece(slot + 8192, k, 28 - 4 * q), lds_piece(slot + 8192, k, 12 - 4 * q)); }
        f32x4 acc = S[kt] * gl;
        acc = MFMA16(k0, Vg[0], acc); acc = MFMA16(k1, Vg[1], acc);
        S[kt] = acc;
    }
}
DI void phase_scan(const Params& p, int lane, int wid, unsigned char* shm) {
    unsigned char* ws = p.ws;
    const bf16_t* KTC = (const bf16_t*)(ws + OFF_KTC);
    const bf16_t* U = (const bf16_t*)(ws + OFF_U); const bf16_t* WB = (const bf16_t*)(ws + OFF_WB);
    const float* GC = (const float*)(ws + OFF_GC); bf16_t* SST = (bf16_t*)(ws + OFF_SST);
    const int seq = blockIdx.x, dir = seq & 1, bh = seq >> 1;
    const int fr = lane & 15, q = lane >> 4;
    LAS unsigned char* ring = (LAS unsigned char*)shm;
    if (wid >= 4) {
        const int lw = wid - 4;
        scan_issue(ring, WB, U, KTC, GC, seq, bh, dir, lw, 0, lane);
        scan_issue(ring + SCAN_SLOT, WB, U, KTC, GC, seq, bh, dir, lw, 1, lane);
        scan_issue(ring + 2 * SCAN_SLOT, WB, U, KTC, GC, seq, bh, dir, lw, 2, lane);
        int slot_n = 3;
        for (int i = 0; i < 128; ++i) {
            scan_issue(ring + slot_n * SCAN_SLOT, WB, U, KTC, GC, seq, bh, dir, lw, i + 3 < 128 ? i + 3 : 127, lane);
            asm volatile("s_waitcnt vmcnt(21)" ::: "memory");
            __builtin_amdgcn_s_barrier();
            slot_n = slot_n == 4 ? 0 : slot_n + 1;
        }
        asm volatile("s_waitcnt vmcnt(0)" ::: "memory");
    } else {
        const int vs = wid;
        f32x4 S[4];
#pragma unroll
        for (int i = 0; i < 4; ++i) S[i] = (f32x4){0.f, 0.f, 0.f, 0.f};
        bf16_t* sst = SST + (size_t)seq * 128 * 4096 + (16 * vs + fr) * 64 + 4 * q;
        int slot_c = 0;
        for (int i = 0; i < 128; ++i) {
            __builtin_amdgcn_s_barrier();
            asm volatile("" ::: "memory");
            scan_step(ring + slot_c * SCAN_SLOT, vs, dir, fr, q, S, sst + (size_t)i * 4096);
            slot_c = slot_c == 4 ? 0 : slot_c + 1;
        }
    }
}
DI void phase_outp(const Params& p, int gw, int nw, int lane0) {
    unsigned char* ws = p.ws;
    const bf16_t* QC = (const bf16_t*)(ws + OFF_QC);
    const bf16_t* U = (const bf16_t*)(ws + OFF_U); const bf16_t* WB = (const bf16_t*)(ws + OFF_WB); const bf16_t* QK = (const bf16_t*)(ws + OFF_QK);
    const float* GC = (const float*)(ws + OFF_GC); const bf16_t* SST = (const bf16_t*)(ws + OFF_SST);
    for (int it = gw; it < 6144; it += nw) {
        int lane = lane0; asm volatile("" : "+v"(lane));
        const int fr = lane & 15, q = lane >> 4;
        const int chunk = it & 127, seq = it >> 7, dir = seq & 1, bh = seq >> 1, b = bh / 6, h = bh % 6;
        const int pch = dir ? 127 - chunk : chunk;
        const size_t tb = ((size_t)bh * 128 + pch) * 4096;
        const bf16_t* Wp = WB + (size_t)it * 4096; const bf16_t* Up = U + (size_t)it * 4096; const bf16_t* QKp = QK + (size_t)it * 4096;
        const bf16_t* Sp = SST + (size_t)it * 4096; const float* gcp = GC + (size_t)it * 64;
        bf16_t* OT = (bf16_t*)(ws + OFF_WB) + (size_t)it * 4096;
        bf16x8 wf[4][2], qf[4][2], kf[4][2]; f32x4 eg[4];
#pragma unroll
        for (int m = 0; m < 4; ++m) {
            const int c = 16 * m + fr; const int tr = dir ? 63 - c : c;
            wf[m][0] = *(const bf16x8*)(Wp + c * 64 + 8 * q); wf[m][1] = *(const bf16x8*)(Wp + c * 64 + 32 + 8 * q);
            qf[m][0] = *(const bf16x8*)(QC + tb + tr * 64 + 8 * q); qf[m][1] = *(const bf16x8*)(QC + tb + tr * 64 + 32 + 8 * q);
            const bf16_t* kp = QKp + c * 64 + 4 * q;
            kf[m][0] = ld2x8(kp, kp + 16); kf[m][1] = ld2x8(kp + 32, kp + 48);
            const f32x4 gcv = *(const f32x4*)(gcp + 16 * m + 4 * q);
#pragma unroll
            for (int r = 0; r < 4; ++r) eg[m][r] = fexp(gcv[r]);
        }
#pragma unroll 1
        for (int vs = 0; vs < 4; ++vs) {
            const bf16x8 Sb0 = *(const bf16x8*)(Sp + (16 * vs + fr) * 64 + 8 * q), Sb1 = *(const bf16x8*)(Sp + (16 * vs + fr) * 64 + 32 + 8 * q);
            f32x4 vn[4], o[4];
#pragma unroll
            for (int m = 0; m < 4; ++m) {
                f32x4 acc = {0.f, 0.f, 0.f, 0.f};
                acc = MFMA16(wf[m][0], Sb0, acc); acc = MFMA16(wf[m][1], Sb1, acc);
                const u32x2 uu = *(const u32x2*)(Up + (16 * vs + fr) * 64 + 16 * m + 4 * q);
                vn[m][0] = bflo(uu.x) - acc[0]; vn[m][1] = bfhi(uu.x) - acc[1]; vn[m][2] = bflo(uu.y) - acc[2]; vn[m][3] = bfhi(uu.y) - acc[3];
                f32x4 a2 = {0.f, 0.f, 0.f, 0.f};
                a2 = MFMA16(qf[m][0], Sb0, a2); a2 = MFMA16(qf[m][1], Sb1, a2);
                o[m] = a2 * eg[m];
            }
            const bf16x8 Vb0 = pack8(vn[0], vn[1]), Vb1 = pack8(vn[2], vn[3]);
#pragma unroll
            for (int m = 0; m < 4; ++m) {
                f32x4 acc = o[m];
                acc = MFMA16(kf[m][0], Vb0, acc); acc = MFMA16(kf[m][1], Vb1, acc);
#pragma unroll
                for (int r = 0; r < 4; ++r) { const int c = 16 * m + 4 * q + r; OT[c * 64 + 16 * vs + fr] = f2bf(acc[r]); }
            }
        }
    }
}

DI bf16x8 packp(const float (&pv)[16], int s) {
    u32x4 r = {pk2(pv[8 * s], pv[8 * s + 1]), pk2(pv[8 * s + 2], pv[8 * s + 3]), pk2(pv[8 * s + 4], pv[8 * s + 5]), pk2(pv[8 * s + 6], pv[8 * s + 7])};
    return __builtin_bit_cast(bf16x8, r);
}
#define CRW(reg) ((float)(((reg) & 3) + 8 * ((reg) >> 2)))

DI void phase_win(const Params& p, int l, int gw, int nw, int lane) {
    unsigned char* ws = p.ws;
    const bf16_t* PAB = (const bf16_t*)(ws + OFF_PAB); const bf16_t* VT = (const bf16_t*)(ws + OFF_VT); bf16_t* OB = (bf16_t*)(ws + OFF_OB);
    const int r32 = lane & 31, hh = lane >> 5;
    for (int item = gw; item < 6144; item += nw) {
        const int qt = item & 255, qh = (item >> 8) % 6, b = item / 1536, kvh = qh / 3;
        const int q0 = qt * 32, qi = q0 + r32;
        const bf16_t* qrow = PAB + ((size_t)b * SEQ + qi) * LDAB + qh * 64;
        bf16x8 qf[4];
#pragma unroll
        for (int st = 0; st < 4; ++st) qf[st] = *(const bf16x8*)(qrow + 16 * st + 8 * hh);
        const float slope2 = exp2f(-8.f * (float)(qh + 1) / 6.f) * LOG2E, scale2 = 0.125f * LOG2E;
        float m = p.in[7][l * 6 + qh] * LOG2E, lsum = hh == 0 ? 1.f : 0.f;
        f32x16 O[2];
#pragma unroll
        for (int i = 0; i < 16; ++i) { O[0][i] = 0.f; O[1][i] = 0.f; }
        const int kb0 = q0 - 128 < 0 ? 0 : q0 - 128, kb1 = q0 + 160 > SEQ ? SEQ : q0 + 160;
        for (int kb = kb0; kb < kb1; kb += 32) {
            const bf16_t* krow = PAB + ((size_t)b * SEQ + kb + r32) * LDAB + 384 + kvh * 64;
            f32x16 s;
#pragma unroll
            for (int i = 0; i < 16; ++i) s[i] = 0.f;
#pragma unroll
            for (int st = 0; st < 4; ++st) { const bf16x8 kf = *(const bf16x8*)(krow + 16 * st + 8 * hh); s = MFMA32(kf, qf[st], s); }
            bf16x8 vf[2][2];
#pragma unroll
            for (int dt = 0; dt < 2; ++dt) { const bf16_t* vrow = VT + ((size_t)(b * 6 + kvh) * 64 + 32 * dt + r32) * SEQ + kb + 4 * hh;
                vf[dt][0] = ld2x8(vrow, vrow + 8); vf[dt][1] = ld2x8(vrow + 16, vrow + 24); }
            const float qoff = (float)(kb + 4 * hh - qi);
            float t[16]; float mx = m;
#pragma unroll
            for (int reg = 0; reg < 16; ++reg) { const float ad = fabsf(qoff + CRW(reg)); float tv = s[reg] * scale2 - slope2 * ad; tv = (ad <= 128.f) ? tv : -1e30f; t[reg] = tv; mx = fmaxf(mx, tv); }
            mx = fmaxf(mx, __shfl_xor(mx, 32));
            const float alpha = fexp2(m - mx); m = mx;
            float ps = 0.f;
#pragma unroll
            for (int reg = 0; reg < 16; ++reg) { t[reg] = fexp2(t[reg] - m); ps += t[reg]; }
            lsum = lsum * alpha + ps;
#pragma unroll
            for (int i = 0; i < 16; ++i) { O[0][i] *= alpha; O[1][i] *= alpha; }
            const bf16x8 pf0 = packp(t, 0), pf1 = packp(t, 1);
#pragma unroll
            for (int dt = 0; dt < 2; ++dt) { O[dt] = MFMA32(vf[dt][0], pf0, O[dt]); O[dt] = MFMA32(vf[dt][1], pf1, O[dt]); }
        }
        lsum += __shfl_xor(lsum, 32);
        const float inv = 1.f / lsum;
        bf16_t* orow = OB + ((size_t)b * SEQ + qi) * DM + qh * 64;
#pragma unroll
        for (int dt = 0; dt < 2; ++dt)
#pragma unroll
            for (int g4 = 0; g4 < 4; ++g4) {
                u32x2 w = {pk2(O[dt][4 * g4] * inv, O[dt][4 * g4 + 1] * inv), pk2(O[dt][4 * g4 + 2] * inv, O[dt][4 * g4 + 3] * inv)};
                *(u32x2*)(orow + 32 * dt + 8 * g4 + 4 * hh) = w;
            }
    }
}

DI bf16x8 scale_frag(bf16x8 v, float sc) {
    u32x4 u = __builtin_bit_cast(u32x4, v), r;
#pragma unroll
    for (int i = 0; i < 4; ++i) r[i] = pk2(bflo(u[i]) * sc, bfhi(u[i]) * sc);
    return __builtin_bit_cast(bf16x8, r);
}
DI void phase_diff(const Params& p, int l, int tid0, unsigned char* shm) {
    unsigned char* ws = p.ws;
    const bf16_t* PAB = (const bf16_t*)(ws + OFF_PAB); const bf16_t* VT = (const bf16_t*)(ws + OFF_VT); bf16_t* OB = (bf16_t*)(ws + OFF_OB);
    const float lam_init = l == 0 ? 0.2f : (0.8f - 0.6f * 0.7408182206817179f);
    float lam;
    {
        const int lane = tid0 & 63;
        const float* dl = p.in[8] + l * 128;
        float a = 0.f, c = 0.f;
        if (lane < 32) { a = dl[lane] * dl[32 + lane]; c = dl[64 + lane] * dl[96 + lane]; }
        a = wave_sum(a); c = wave_sum(c);
        lam = expf(a) - expf(c) + lam_init;
    }
    const float* dg = p.in[9] + l * 64;
    unsigned* qctr = (unsigned*)(ws + OFF_MISC) + 64 + l;
    const unsigned* kmx = (const unsigned*)(ws + OFF_MISC) + l * 32;
    volatile unsigned* sq = (volatile unsigned*)(shm + 32768);
    for (;;) {
        int tid = tid0; asm volatile("" : "+v"(tid));
        __syncthreads();
        if (tid == 0) sq[0] = atomicAdd(qctr, 1u);
        __syncthreads();
        const int idx_item = (int)sq[0];
        if (idx_item >= 1280) break;
        const int lane = tid & 63, wid = tid >> 6, r32 = lane & 31, hh = lane >> 5;
        if (idx_item >= 512) { phase_win(p, l, (idx_item - 512) * 8 + wid, 6144, lane); continue; }
        const int qb = idx_item & 31, b = (idx_item >> 5) & 3, h = 3 - (idx_item >> 7);
        const int q0 = qb * 256 + wid * 32, qi = q0 + r32;
        const bf16_t* qrow = PAB + ((size_t)b * SEQ + qi) * LDAB + 640 + h * 64;
        const float scale2 = 0.17677669529663687f * LOG2E;
        bf16x8 qf[2][2];
#pragma unroll
        for (int mp = 0; mp < 2; ++mp)
#pragma unroll
            for (int st = 0; st < 2; ++st) qf[mp][st] = scale_frag(*(const bf16x8*)(qrow + mp * 32 + 16 * st + 8 * hh), scale2);
        const float slope2 = exp2f(-2.f * (float)(h + 1)) * LOG2E;
        float mA = -1e30f, mB = -1e30f, lA = 0.f, lB = 0.f;
        f32x16 OA[2], OBb[2];
#pragma unroll
        for (int i = 0; i < 16; ++i) { OA[0][i] = 0.f; OA[1][i] = 0.f; OBb[0][i] = 0.f; OBb[1][i] = 0.f; }
        const int srow = tid >> 3, sch = tid & 7;
        const bf16_t* kg = PAB + ((size_t)b * SEQ + srow) * LDAB + 896 + h * 64 + sch * 8;
        const bf16_t* vg = VT + ((size_t)(b * 6 + 2 + h) * 64 + srow) * SEQ + sch * 8;
        const int kwoff = srow * 128 + ((sch ^ (srow & 7)) * 16);
        const int vblk = sch >> 1, vhalf = sch & 1;
        const int vwoff0 = 16384 + srow * 128 + (((2 * vblk) ^ (srow & 7)) * 16) + 8 * vhalf;
        const int vwoff1 = 16384 + srow * 128 + (((2 * vblk + 1) ^ (srow & 7)) * 16) + 8 * vhalf;
        int lo, hi;
        {
            float qa = 0.f, qbm = 0.f;
#pragma unroll
            for (int st = 0; st < 2; ++st) { const u32x4 va = __builtin_bit_cast(u32x4, qf[0][st]), vb = __builtin_bit_cast(u32x4, qf[1][st]);
#pragma unroll
                for (int e = 0; e < 4; ++e) { qa += bflo(va[e]) * bflo(va[e]) + bfhi(va[e]) * bfhi(va[e]); qbm += bflo(vb[e]) * bflo(vb[e]) + bfhi(vb[e]) * bfhi(vb[e]); } }
            qa += __shfl_xor(qa, 32); qbm += __shfl_xor(qbm, 32);
#pragma unroll
            for (int o = 16; o > 0; o >>= 1) { qa = fmaxf(qa, __shfl_xor(qa, o)); qbm = fmaxf(qbm, __shfl_xor(qbm, o)); }
            if (lane == 0) { sq[8 + 2 * wid] = __float_as_uint(qa); sq[9 + 2 * wid] = __float_as_uint(qbm); }
            __syncthreads();
            float qA = 0.f, qB = 0.f;
#pragma unroll
            for (int w8 = 0; w8 < 8; ++w8) { qA = fmaxf(qA, __uint_as_float(sq[8 + 2 * w8])); qB = fmaxf(qB, __uint_as_float(sq[9 + 2 * w8])); }
            const float kA = __uint_as_float(kmx[b * 8 + h * 2]), kB = __uint_as_float(kmx[b * 8 + h * 2 + 1]);
            const float bnd = 2.02f * fmaxf(sqrtf(qA * kA), sqrtf(qB * kB)) + 1.f;
            const float dsk = (168.f + bnd) / slope2;
            const int Dsk = dsk > 16384.f ? 16384 : (int)dsk + 1;
            const int Q0 = qb * 256;
            const int x = Q0 - 63 - Dsk; lo = x <= 0 ? 0 : (x + 63) >> 6;
            const int y = (Q0 + 255 + Dsk) >> 6; hi = y > 127 ? 127 : y;
        }
        const int d0 = qb * 4, nright = hi - d0 + 1, nstage = hi - lo + 1;
        u32x4 kreg, vreg;
        { const int kb = d0 * 64; kreg = *(const u32x4*)(kg + (size_t)kb * LDAB); vreg = *(const u32x4*)(vg + kb); }
        __syncthreads();
        *(u32x4*)(shm + kwoff) = kreg;
        *(u32x2*)(shm + vwoff0) = (u32x2){vreg.x, vreg.y}; *(u32x2*)(shm + vwoff1) = (u32x2){vreg.z, vreg.w};
        __syncthreads();
        for (int idx = 0; idx < nstage; ++idx) {
            const int kt = idx < nright ? d0 + idx : d0 - 1 - (idx - nright);
            const int buf = idx & 1;
            if (idx + 1 < nstage) {
                const int idn = idx + 1; const int ktn = idn < nright ? d0 + idn : d0 - 1 - (idn - nright);
                const int kbn = ktn * 64;
                kreg = *(const u32x4*)(kg + (size_t)kbn * LDAB); vreg = *(const u32x4*)(vg + kbn);
            }
            const unsigned char* Ks = shm + buf * 8192; const unsigned char* Vs = shm + 16384 + buf * 8192;
#pragma unroll
            for (int j = 0; j < 2; ++j) {
                const int kb = kt * 64 + 32 * j;
                bf16x8 kf[2][2], vf[2][2];
#pragma unroll
                for (int mp = 0; mp < 2; ++mp)
#pragma unroll
                    for (int st = 0; st < 2; ++st) kf[mp][st] = *(const bf16x8*)(Ks + (32 * j + r32) * 128 + (((mp * 4 + 2 * st + hh) ^ (r32 & 7)) * 16));
#pragma unroll
                for (int dt = 0; dt < 2; ++dt)
#pragma unroll
                    for (int s_ = 0; s_ < 2; ++s_) vf[dt][s_] = *(const bf16x8*)(Vs + (32 * dt + r32) * 128 + (((4 * j + 2 * s_ + hh) ^ (r32 & 7)) * 16));
                f32x16 sA, sB;
#pragma unroll
                for (int i = 0; i < 16; ++i) { sA[i] = 0.f; sB[i] = 0.f; }
                sA = MFMA32(kf[0][0], qf[0][0], sA); sA = MFMA32(kf[0][1], qf[0][1], sA);
                sB = MFMA32(kf[1][0], qf[1][0], sB); sB = MFMA32(kf[1][1], qf[1][1], sB);
                float qoff = (float)(kb + 4 * hh - qi); asm volatile("" : "+v"(qoff));
                float tA[16], tB[16]; float mxA = mA, mxB = mB;
#pragma unroll
                for (int reg = 0; reg < 16; ++reg) { const float ad = fabsf(qoff + CRW(reg));
                    tA[reg] = __builtin_fmaf(-slope2, ad, sA[reg]); tB[reg] = __builtin_fmaf(-slope2, ad, sB[reg]); mxA = fmaxf(mxA, tA[reg]); mxB = fmaxf(mxB, tB[reg]); }
                mxA = fmaxf(mxA, __shfl_xor(mxA, 32)); mxB = fmaxf(mxB, __shfl_xor(mxB, 32));
                if (__builtin_amdgcn_ballot_w64(mxA > mA) != 0ull) {
                    const float alpha = fexp2(mA - mxA); mA = mxA; lA *= alpha;
#pragma unroll
                    for (int i = 0; i < 16; ++i) { OA[0][i] *= alpha; OA[1][i] *= alpha; }
                }
                if (__builtin_amdgcn_ballot_w64(mxB > mB) != 0ull) {
                    const float alpha = fexp2(mB - mxB); mB = mxB; lB *= alpha;
#pragma unroll
                    for (int i = 0; i < 16; ++i) { OBb[0][i] *= alpha; OBb[1][i] *= alpha; }
                }
                float psA = 0.f, psB = 0.f;
#pragma unroll
                for (int reg = 0; reg < 16; ++reg) { tA[reg] = fexp2(tA[reg] - mA); psA += tA[reg]; tB[reg] = fexp2(tB[reg] - mB); psB += tB[reg]; }
                lA += psA; lB += psB;
                const bf16x8 pA0 = packp(tA, 0), pA1 = packp(tA, 1), pB0 = packp(tB, 0), pB1 = packp(tB, 1);
#pragma unroll
                for (int dt = 0; dt < 2; ++dt) {
                    OA[dt] = MFMA32(vf[dt][0], pA0, OA[dt]); OA[dt] = MFMA32(vf[dt][1], pA1, OA[dt]);
                    OBb[dt] = MFMA32(vf[dt][0], pB0, OBb[dt]); OBb[dt] = MFMA32(vf[dt][1], pB1, OBb[dt]);
                }
            }
            if (idx + 1 < nstage) {
                unsigned char* wb = shm + (buf ^ 1) * 8192;
                *(u32x4*)(wb + kwoff) = kreg;
                *(u32x2*)(wb + vwoff0) = (u32x2){vreg.x, vreg.y}; *(u32x2*)(wb + vwoff1) = (u32x2){vreg.z, vreg.w};
            }
            __syncthreads();
        }
        lA += __shfl_xor(lA, 32); lB += __shfl_xor(lB, 32);
        const float iA = 1.f / lA, iB = lam / lB;
        float ss = 0.f;
#pragma unroll
        for (int dt = 0; dt < 2; ++dt)
#pragma unroll
            for (int i = 0; i < 16; ++i) { const float v = OA[dt][i] * iA - OBb[dt][i] * iB; OA[dt][i] = v; ss += v * v; }
        ss += __shfl_xor(ss, 32);
        const float rstd = __builtin_amdgcn_rsqf(ss * (1.f / 64.f) + EPS) * (1.f - lam_init);
        bf16_t* orow = OB + ((size_t)b * SEQ + qi) * DM + 384 + h * 64;
#pragma unroll
        for (int dt = 0; dt < 2; ++dt)
#pragma unroll
            for (int g4 = 0; g4 < 4; ++g4) {
                const int d = 32 * dt + 8 * g4 + 4 * hh;
                const f32x4 gv = *(const f32x4*)(dg + d);
                u32x2 w = {pk2(OA[dt][4 * g4] * rstd * gv[0], OA[dt][4 * g4 + 1] * rstd * gv[1]), pk2(OA[dt][4 * g4 + 2] * rstd * gv[2], OA[dt][4 * g4 + 3] * rstd * gv[3])};
                *(u32x2*)(orow + d) = w;
            }
    }
}

DI void phase_post(const Params& p, int l, int gw, int nw, int lane) {
    unsigned char* ws = p.ws;
    const bf16_t* OT = (const bf16_t*)(ws + OFF_WB); const bf16_t* PAB = (const bf16_t*)(ws + OFF_PAB); bf16_t* OB = (bf16_t*)(ws + OFF_OB);
    const float gl = p.in[12][l * 64 + lane];
    for (int u = gw; u < 6144; u += nw) {
        const int half = u & 1, h = (u % 12) >> 1, ck = u / 12, b = ck >> 7, chunk = ck & 127;
        const size_t itf = ((size_t)((b * 6 + h) * 2) * 128 + chunk), itb = ((size_t)((b * 6 + h) * 2 + 1) * 128 + (127 - chunk));
        const size_t tok0 = (size_t)b * SEQ + chunk * 64 + half * 32;
#pragma unroll 1
        for (int g = 0; g < 2; ++g) {
            float av[16], zv[16];
#pragma unroll
            for (int j = 0; j < 16; ++j) {
                const int t = half * 32 + g * 16 + j;
                av[j] = bf2f(OT[itf * 4096 + t * 64 + lane]) + bf2f(OT[itb * 4096 + (63 - t) * 64 + lane]);
                zv[j] = bf2f(PAB[(tok0 + g * 16 + j) * LDAB + 1408 + h * 64 + lane]);
            }
#pragma unroll
            for (int j = 0; j < 16; ++j) {
                const float ss = wave_sum(av[j] * av[j]);
                const float y = av[j] * __builtin_amdgcn_rsqf(ss * (1.f / 64.f) + EPS) * gl;
                OB[(tok0 + g * 16 + j) * DM + 640 + h * 64 + lane] = f2bf(y * silu(zv[j]));
            }
        }
    }
}

#define XB_TMO      128
#define XB_XCNT(j)  (256  + 64 * (j))
#define XB_XSUB(j)  (1280 + 64 * (j))
#define XB_XGEN(j)  (2304 + 64 * (j))
#define XB_TOP      3328
#define XB_TOPGEN   3392
#define XCD_BAR_WORDS 3456
#define XB_SPIN_CAP (1u << 18)
DI unsigned xb_ld(unsigned* p)              { return __hip_atomic_load(p, __ATOMIC_RELAXED, __HIP_MEMORY_SCOPE_AGENT); }
DI unsigned xb_add(unsigned* p, unsigned v) { return __hip_atomic_fetch_add(p, v, __ATOMIC_RELAXED, __HIP_MEMORY_SCOPE_AGENT); }
DI unsigned xb_xcc_id() { return (unsigned)__builtin_amdgcn_s_getreg((3 << 11) | 20) & 0xFu; }
#define XB_SPIN(cond, bar) do { unsigned _sp = 0; while (cond) { __builtin_amdgcn_s_sleep(1); \
    if ((++_sp & 255u) == 0u) { if (xb_ld(&(bar)[XB_TMO])) break; if (_sp > XB_SPIN_CAP) { atomicAdd(&(bar)[XB_TMO], 1u); break; } } } } while (0)
struct XcdBarrier { unsigned* bar; unsigned x; volatile LAS unsigned* st; };
DI XcdBarrier xcd_barrier_post(unsigned* bar, volatile LAS unsigned* st) {
    XcdBarrier b; b.bar = bar; b.x = xb_xcc_id(); b.st = st;
    if (threadIdx.x == 0) (void)xb_add(&bar[XB_XCNT(b.x)], 1u);
    return b;
}
DI void xcd_barrier_complete(unsigned* bar, unsigned x, unsigned& nloc, unsigned& nx) {
    const unsigned G = gridDim.x * gridDim.y * gridDim.z;
    unsigned sum, cnt, mine, sp = 0u;
    for (;;) {
        sum = 0u; cnt = 0u; mine = 0u;
#pragma unroll
        for (unsigned j = 0; j < 16; ++j) { const unsigned c = xb_ld(&bar[XB_XCNT(j)]); sum += c; cnt += (c > 0u) ? 1u : 0u; mine = (j == x) ? c : mine; }
        if (sum == G) break;
        __builtin_amdgcn_s_sleep(1);
        if ((++sp & 255u) == 0u) { if (xb_ld(&bar[XB_TMO])) break; if (sp > XB_SPIN_CAP) { atomicAdd(&bar[XB_TMO], 1u); break; } }
    }
    nloc = mine > 0u ? mine : 1u; nx = cnt > 0u ? cnt : 1u;
}
DI void xcd_barrier(const XcdBarrier& b) {
    asm volatile("s_waitcnt vmcnt(0)" ::: "memory");
    __syncthreads();
    if (threadIdx.x == 0) {
        unsigned* bar = b.bar;
        __builtin_amdgcn_s_waitcnt(0);
        unsigned nloc = b.st[0], nx = b.st[1];
        if (nloc == 0u) { xcd_barrier_complete(bar, b.x, nloc, nx); b.st[0] = nloc; b.st[1] = nx; }
        const unsigned old = xb_add(&bar[XB_XSUB(b.x)], 1u);
        const unsigned gen = old / nloc;
        if (old + 1u == (gen + 1u) * nloc) {
            __builtin_amdgcn_fence(__ATOMIC_RELEASE, "agent");
            asm volatile("s_waitcnt vmcnt(0)" ::: "memory");
            const unsigned og = xb_add(&bar[XB_TOP], 1u);
            const unsigned tg = og / nx;
            if (og + 1u == (tg + 1u) * nx) xb_add(&bar[XB_TOPGEN], 1u);
            else XB_SPIN(xb_ld(&bar[XB_TOPGEN]) == tg, bar);
            __builtin_amdgcn_fence(__ATOMIC_ACQUIRE, "agent");
            xb_add(&bar[XB_XGEN(b.x)], 1u);
            asm volatile("s_waitcnt vmcnt(0)" ::: "memory");
        } else {
            XB_SPIN(xb_ld(&bar[XB_XGEN(b.x)]) == gen, bar);
            __builtin_amdgcn_fence(__ATOMIC_ACQUIRE, "agent");
            asm volatile("s_waitcnt vmcnt(0)" ::: "memory");
        }
    }
    __syncthreads();
}

constexpr int NPHASE = 30;
DI void run_phase(const Params& p, int ph, unsigned char* shm, int tid) {
    const int wid = tid >> 6, lane = tid & 63;
    const int gw = blockIdx.x * 8 + wid, nw = gridDim.x * 8;
    unsigned char* ws = p.ws;
    if (ph == 0) { if (EN(0)) { phase_init(p, gw, nw, lane); phase_convw(p, 0, shm, tid); } return; }
    if (ph == NPHASE - 1) { if (EN(27)) phase_final(p, gw, nw, lane); return; }
    const int l = (ph - 1) / 14, sub = (ph - 1) % 14;
    float* rss = (float*)(ws + OFF_RSS);
    bf16_t* XB = (bf16_t*)(ws + OFF_XB);
    LAS unsigned char* lds = (LAS unsigned char*)shm;
    pg8::StaticOrder S;
    if (sub == 0) { if (EN(0)) if (l > 0) phase_convw(p, l, shm, tid); return; }
    if (EN(1)) if (sub == 1 || sub == 12) {
        const int f = sub == 1 ? 0 : 1;
        pg8::Gemm g{XB, (const bf16_t*)(ws + (f ? OFF_W_FFN2IN : OFF_W_FFN1IN)), MTOK, NFF, DM};
        EpiSwiglu E{(bf16_t*)(ws + OFF_BIG), rss + (size_t)((3 * l + (f ? 2 : 0)) & 1) * MTOK * 16};
        S.init(MTOK, NFF, gridDim.x, blockIdx.x);
        pg8::gemm_phase(tid, lds, g, S, E);
        if ((REPMASK >> 1) & 1) { __syncthreads(); pg8::gemm_phase(tid, lds, g, S, E); }
        return;
    }
    if (EN(2)) if (sub == 2 || sub == 13 || sub == 11) {
        const bf16_t* A; const bf16_t* Bt; int K; float scale; int nn;
        if (sub == 2) { A = (const bf16_t*)(ws + OFF_BIG); Bt = (const bf16_t*)(ws + OFF_W_FFN1OUT); K = DFFP; scale = 0.5f; nn = 3 * l + 1; }
        else if (sub == 13) { A = (const bf16_t*)(ws + OFF_BIG); Bt = (const bf16_t*)(ws + OFF_W_FFN2OUT); K = DFFP; scale = 0.5f; nn = 3 * l + 3; }
        else { A = (const bf16_t*)(ws + OFF_OB); Bt = (const bf16_t*)(ws + OFF_W_MIXOUT); K = DM; scale = 1.f; nn = 3 * l + 2; }
        pg8::Gemm g{A, Bt, MTOK, DM, K};
        EpiResid E{p.out, XB, rss + (size_t)(nn & 1) * MTOK * 16, scale};
        S.init(MTOK, DM, gridDim.x, blockIdx.x);
        pg8::gemm_phase(tid, lds, g, S, E); return;
    }
    if (EN(3)) if (sub == 3) {
        pg8::Gemm g{XB, (const bf16_t*)(ws + OFF_W_MIXIN), MTOK, NMIX, DM};
        EpiMixIn E{(bf16_t*)(ws + OFF_PAB), (bf16_t*)(ws + OFF_PC), (float*)(ws + OFF_BG), rss + (size_t)((3 * l + 1) & 1) * MTOK * 16};
        S.init(MTOK, NMIX, gridDim.x, blockIdx.x);
        pg8::gemm_phase(tid, lds, g, S, E);
        return;
    }
    if (EN(4)) if (sub == 4) { REP(4) phase_prep(p, l, gw, nw, lane); return; }
    if (EN(5)) if (sub == 5) { REP(5) phase_chunk(p, l, gw, nw, lane, wid, shm); return; }
    if (EN(6)) if (sub == 6) {
        if (blockIdx.x < 48) phase_scan(p, lane, wid, shm);
        phase_diff(p, l, tid, shm);
        return;
    }
    if (EN(10)) if (sub == 7) { phase_outp(p, gw, nw, lane); return; }


    if (EN(9)) if (sub == 10) { REP(9) phase_post(p, l, gw, nw, lane); return; }
}

__global__ __launch_bounds__(512, 2) void mega(Params p) {
    extern __shared__ __attribute__((aligned(16))) unsigned char shm[];
    __shared__ uint4 xb_words;
    if (threadIdx.x == 0) xb_words = make_uint4(0u, 0u, 0u, 0u);
    __syncthreads();
    const XcdBarrier xb = xcd_barrier_post((unsigned*)(p.ws + OFF_BAR), (volatile LAS unsigned*)&xb_words);
#ifndef PROBE_DUP
    for (int ph = p.p0; ph < p.p1; ++ph) {
        if (ph == 1 || ph == 9 || ph == 10 || ph == 23 || ph == 24) continue;
        int tid = threadIdx.x; asm volatile("" : "+v"(tid));
        Params q = p;
#if defined(__HIP_DEVICE_COMPILE__)
        {
            typedef __attribute__((address_space(1))) unsigned char GUC; typedef __attribute__((address_space(1))) float GF; typedef __attribute__((address_space(1))) const float GCF;
            unsigned long long wsi = (unsigned long long)p.ws, oi = (unsigned long long)p.out; asm volatile("" : "+s"(wsi), "+s"(oi));
            q.ws = (unsigned char*)(GUC*)wsi; q.out = (float*)(GF*)oi;
#pragma unroll
            for (int ii = 0; ii < 18; ++ii) q.in[ii] = (const float*)(GCF*)(unsigned long long)p.in[ii];
        }
#endif
        run_phase(q, ph, shm, tid);
        if (ph + 1 < p.p1) {
            if (ph == 0) cg::this_grid().sync();
            else xcd_barrier(xb);
        }
    }
#else
    for (int st = 0; st < 2 * NPHASE; ++st) {
        const int ph = st >> 1;
        if (ph == 1 || ph == 9 || ph == 10 || ph == 23 || ph == 24) continue;
        const int subp = (ph >= 1 && ph <= 28) ? (ph - 1) % 14 : (ph == 0 ? 14 : 15);
        if ((st & 1) && !((PROBE_DUP >> subp) & 1)) continue;
        int tid = threadIdx.x; asm volatile("" : "+v"(tid));
        Params q = p; asm volatile("" : "+s"(q.ws), "+s"(q.out));
        run_phase(q, ph, shm, tid);
        cg::this_grid().sync();
    }
#endif
}

extern "C" void kernel_launch(void* const* d_in, const int* in_sizes, int n_in, void* d_out, int out_size, void* d_ws, size_t ws_size, hipStream_t stream) {
    static int grid = 0;
    if (!grid) {
        hipFuncSetAttribute((const void*)mega, hipFuncAttributeMaxDynamicSharedMemorySize, LDS_BYTES);
        int dev = 0, cus = 0, per = 0;
        hipGetDevice(&dev);
        hipDeviceGetAttribute(&cus, hipDeviceAttributeMultiprocessorCount, dev);
        hipOccupancyMaxActiveBlocksPerMultiprocessor(&per, mega, 512, LDS_BYTES);
        if (per < 1) per = 1;
        grid = cus * per;
        if (grid > 256) grid = 256;
    }
    (void)hipMemsetAsync((unsigned char*)d_ws + OFF_BAR, 0, 3456 * 4, stream);
    Params p{};
    for (int i = 0; i < 18; ++i) p.in[i] = (const float*)d_in[i];
    p.out = (float*)d_out; p.ws = (unsigned char*)d_ws;
#if MULTI
    for (int ph = 0; ph < NPHASE; ++ph) {
        if (ph == 1 || ph == 9 || ph == 10 || ph == 23 || ph == 24) continue;
        p.p0 = ph; p.p1 = ph + 1;
        hipLaunchKernelGGL(mega, dim3(grid), dim3(512), LDS_BYTES, stream, p);
    }
#else
    p.p0 = 0; p.p1 = NPHASE;
    void* args[] = {&p};
    hipError_t e = hipLaunchCooperativeKernel((const void*)mega, dim3(grid), dim3(512), args, LDS_BYTES, stream);
    if (e != hipSuccess) fprintf(stderr, "cooperative launch failed: %s (grid %d)\n", hipGetErrorString(e), grid);
#endif
}
```

```cpp
#include <hip/hip_runtime.h>
#include <hip/hip_cooperative_groups.h>
#include <cstdio>
namespace cg = cooperative_groups;


#ifndef REPMASK
#define REPMASK 0
#endif
#define REP(k) for (int rep_ = 0; rep_ < (((REPMASK >> (k)) & 1) ? 2 : 1); ++rep_)
#ifndef MULTI
#define MULTI 0
#endif

#ifdef ONLY
#define EN(k) (ONLY==(k))
#else
#define EN(k) 1
#endif
#define DI __device__ __forceinline__
#define LAS __attribute__((address_space(3)))
typedef unsigned short bf16_t;
typedef short bf16x8 __attribute__((ext_vector_type(8)));
typedef short s16x4 __attribute__((ext_vector_type(4)));
typedef float f32x4 __attribute__((ext_vector_type(4)));
typedef float f32x16 __attribute__((ext_vector_type(16)));
typedef float f32x2 __attribute__((ext_vector_type(2)));
typedef unsigned u32x4 __attribute__((ext_vector_type(4)));
typedef unsigned u32x2 __attribute__((ext_vector_type(2)));
typedef __bf16 bf16v2 __attribute__((ext_vector_type(2)));

constexpr int DM = 1024, NBATCH = 4, SEQ = 8192, MTOK = NBATCH * SEQ, DFF = 2752, DFFP = 2816, NFF = 2 * DFFP, NMIX = 3072;
constexpr int LDAB = 1792, LDC = 1280;
constexpr float EPS = 1e-6f, LOG2E = 1.4426950408889634f;
constexpr int LDS_BYTES = 131072;

constexpr size_t SZ_W_FFNIN = (size_t)NFF * DM * 2, SZ_W_FFNOUT = (size_t)DM * DFFP * 2, SZ_W_MIXIN = (size_t)NMIX * DM * 2, SZ_W_MIXOUT = (size_t)DM * DM * 2;
constexpr size_t OFF_W_FFN1IN = 0;
constexpr size_t OFF_W_FFN1OUT = OFF_W_FFN1IN + SZ_W_FFNIN;
constexpr size_t OFF_W_MIXIN = OFF_W_FFN1OUT + SZ_W_FFNOUT;
constexpr size_t OFF_W_MIXOUT = OFF_W_MIXIN + SZ_W_MIXIN;
constexpr size_t OFF_W_FFN2IN = OFF_W_MIXOUT + SZ_W_MIXOUT;
constexpr size_t OFF_W_FFN2OUT = OFF_W_FFN2IN + SZ_W_FFNIN;
constexpr size_t OFF_XB = OFF_W_FFN2OUT + SZ_W_FFNOUT;
constexpr size_t SZ_TILE = (size_t)3072 * 4096 * 2;
constexpr size_t OFF_QC = OFF_XB, OFF_KTC = OFF_XB + SZ_TILE;
constexpr size_t OFF_OB = OFF_XB + (size_t)MTOK * DM * 2;
constexpr size_t OFF_BIG = OFF_OB + (size_t)MTOK * DM * 2;
constexpr size_t OFF_PAB = OFF_BIG, OFF_PC = OFF_BIG + (size_t)MTOK * LDAB * 2;
constexpr size_t OFF_U = OFF_PC, OFF_WB = OFF_PC + (size_t)6144 * 8192;
constexpr size_t OFF_BG = OFF_WB + (size_t)6144 * 8192;
constexpr size_t OFF_RSS = OFF_BG + (size_t)MTOK * 24 * 4;
constexpr size_t OFF_VT = OFF_RSS + (size_t)2 * MTOK * 16 * 4;
constexpr size_t OFF_KC = OFF_VT + (size_t)NBATCH * 6 * 64 * SEQ * 2;
constexpr size_t OFF_VTC = OFF_KC + SZ_TILE;
constexpr size_t OFF_SST = OFF_KC;
constexpr size_t OFF_QK = OFF_VTC + SZ_TILE;
constexpr size_t OFF_GC = OFF_QK + (size_t)6144 * 8192;
constexpr size_t OFF_MISC = OFF_GC + (size_t)6144 * 64 * 4;
constexpr size_t OFF_BAR = OFF_MISC + 512;
constexpr size_t WS_TOTAL = OFF_BAR + 3456 * 4;
static_assert(WS_TOTAL <= (size_t)536870912, "workspace too large");
static_assert((size_t)MTOK * DFFP * 2 <= OFF_BG - OFF_BIG, "hidden does not fit");

struct Params {
    const float* in[18];
    float* out;
    unsigned char* ws;
    int p0, p1;
};

DI unsigned pk2(float a, float b) { f32x2 v = {a, b}; bf16v2 r = __builtin_convertvector(v, bf16v2); return __builtin_bit_cast(unsigned, r); }
DI bf16_t f2bf(float a) { return (bf16_t)(pk2(a, 0.f) & 0xffffu); }
DI float bf2f(bf16_t v) { return __uint_as_float(((unsigned)v) << 16); }
DI float bflo(unsigned v) { return __uint_as_float(v << 16); }
DI float bfhi(unsigned v) { return __uint_as_float(v & 0xffff0000u); }
DI float wave_sum(float v) {
    v += __builtin_bit_cast(float, __builtin_amdgcn_update_dpp(0, __builtin_bit_cast(int, v), 0xB1, 0xf, 0xf, true));
    v += __builtin_bit_cast(float, __builtin_amdgcn_update_dpp(0, __builtin_bit_cast(int, v), 0x4E, 0xf, 0xf, true));
    v += __builtin_bit_cast(float, __builtin_amdgcn_update_dpp(0, __builtin_bit_cast(int, v), 0x141, 0xf, 0xf, true));
    v += __builtin_bit_cast(float, __builtin_amdgcn_update_dpp(0, __builtin_bit_cast(int, v), 0x140, 0xf, 0xf, true));
    const int iv = __builtin_bit_cast(int, v);
    const float a = __builtin_bit_cast(float, __builtin_amdgcn_readlane(iv, 0)), b = __builtin_bit_cast(float, __builtin_amdgcn_readlane(iv, 16));
    const float c = __builtin_bit_cast(float, __builtin_amdgcn_readlane(iv, 32)), d = __builtin_bit_cast(float, __builtin_amdgcn_readlane(iv, 48));
    return (a + b) + (c + d);
}
DI bf16x8 ld2x8(const bf16_t* a, const bf16_t* b) { u32x2 x = *(const u32x2*)a, y = *(const u32x2*)b; u32x4 r = {x.x, x.y, y.x, y.y}; return __builtin_bit_cast(bf16x8, r); }
DI unsigned rot16(unsigned x) { return (x >> 16) | (x << 16); }
DI bf16x8 ld2x8rev(const bf16_t* a, const bf16_t* b) {
    u32x2 x = *(const u32x2*)a, y = *(const u32x2*)b; u32x4 r = {rot16(x.y), rot16(x.x), rot16(y.y), rot16(y.x)}; return __builtin_bit_cast(bf16x8, r);
}
DI bf16x8 pack8(f32x4 a, f32x4 b) { u32x4 r = {pk2(a[0], a[1]), pk2(a[2], a[3]), pk2(b[0], b[1]), pk2(b[2], b[3])}; return __builtin_bit_cast(bf16x8, r); }
DI float fexp2(float x) { return __builtin_amdgcn_exp2f(x); }
DI float fexp(float x) { return __builtin_amdgcn_exp2f(x * LOG2E); }
DI float silu(float x) { return x * __builtin_amdgcn_rcpf(1.f + fexp(-x)); }
DI float row_rstd(const float* rp, int row) {
    const f32x4 a = *(const f32x4*)(rp + (size_t)row * 16), b = *(const f32x4*)(rp + (size_t)row * 16 + 4), c = *(const f32x4*)(rp + (size_t)row * 16 + 8), d = *(const f32x4*)(rp + (size_t)row * 16 + 12);
    const float s = ((a[0] + a[1]) + (a[2] + a[3])) + ((b[0] + b[1]) + (b[2] + b[3])) + ((c[0] + c[1]) + (c[2] + c[3])) + ((d[0] + d[1]) + (d[2] + d[3]));
    return __builtin_amdgcn_rsqf(s * (1.f / DM) + EPS);
}
#define MFMA16(a, b, c) __builtin_amdgcn_mfma_f32_16x16x32_bf16((a), (b), (c), 0, 0, 0)
#define MFMA32(a, b, c) __builtin_amdgcn_mfma_f32_32x32x16_bf16((a), (b), (c), 0, 0, 0)

namespace pg8 {
constexpr int BM = 256, BK = 64, HALF = 128, HTB = HALF * BK * 2, STAGE_BYTES = 8 * HTB, NXCD = 8, WGM = 8;
DI int lds_byte(int r, int c) { const int st = (r >> 4) * 2 + (c >> 5), rr = r & 15, cc = c & 31, ob = rr * 64 + cc * 2; return st * 1024 + (ob ^ (((ob >> 9) & 1) << 5)); }
DI void stage_rc(int b, int& R, int& C) { const int st = b / 1024, sb = b % 1024, swz = sb ^ (((sb >> 9) & 1) << 5); R = (st >> 1) * 16 + swz / 64; C = (st & 1) * 32 + (swz % 64) / 2; }
DI int perm32(int rho) { const int n = rho >> 4, i = rho & 15; return 8 * (i >> 2) + 4 * n + (i & 3); }
struct Unit { int pm, pn; };
struct Gemm { const bf16_t* A; const bf16_t* Bt; int M, N, K; };
struct StaticOrder {
    int nM, nN, nwg, G, c;
    DI void init(int M, int N, int G_, int c_) { nM = M / BM; nN = N / BM; nwg = nM * nN; G = G_; c = c_; }
    DI bool next(int i, Unit& u) const {
        const long L = (long)i * G + c; if (L >= nwg) return false;
        int wgid = (int)L; { const int q = nwg / NXCD, r = nwg % NXCD, xcd = wgid % NXCD, off = wgid / NXCD; wgid = (xcd < r ? xcd * (q + 1) : r * (q + 1) + (xcd - r) * q) + off; }
        const int nig = WGM * nN, gid = wgid / nig, fm = gid * WGM, gsz = (nM - fm) < WGM ? (nM - fm) : WGM;
        u.pm = fm + ((wgid % nig) % gsz); u.pn = (wgid % nig) / gsz; return true;
    }
};
template <class Epi>
DI void gemm_phase(int tid, LAS unsigned char* lds, const Gemm g, const StaticOrder& S, const Epi& E) {
    const int wid = __builtin_amdgcn_readfirstlane(tid >> 6), lane = tid & 63, wr = wid >> 2, wc = wid & 3, fr = lane & 15, fq = lane >> 4;
    const int K = g.K, nt = K / BK;
    unsigned voffA[2], voffB[2];
#pragma unroll
    for (int i = 0; i < 2; ++i) { int R, C; stage_rc(tid * 16 + i * 8192, R, C); const int Rb = (R & ~31) + perm32(R & 31);
        voffA[i] = (unsigned)(R * K + C) * 2u; voffB[i] = (unsigned)(Rb * K + C) * 2u; }
    const size_t kstep = (size_t)(BK * 2);
    const size_t hstep = (size_t)HALF * K * 2;
    const size_t tstep = 2 * hstep;
    const unsigned ldsw = (unsigned)wid * 1024u;
    const int aoff = lds_byte(wr * 64 + fr, fq * 8), boff = lds_byte(wc * 32 + fr, fq * 8);
#define PG8_SA(b, h) (((b) * 2 + (h)) * HTB)
#define PG8_SB(b, h) ((4 + (b) * 2 + (h)) * HTB)
#define PG8_STAGE(bufoff, gbase, voff) do { _Pragma("unroll") for (int _i = 0; _i < 2; ++_i) \
        __builtin_amdgcn_global_load_lds((const unsigned*)((const char*)(gbase) + (voff)[_i]), (LAS unsigned*)(lds + (bufoff) + ldsw + _i * 8192), 16, 0, 0); } while (0)
#define PG8_LDA(dst, b, h) do { _Pragma("unroll") for (int m = 0; m < 4; ++m) _Pragma("unroll") for (int k = 0; k < 2; ++k) dst[m][k] = *(const LAS bf16x8*)(lds + PG8_SA(b, h) + aoff + m * 2048 + k * 1024); } while (0)
#define PG8_LDB(dst, b, h) do { _Pragma("unroll") for (int n = 0; n < 2; ++n) _Pragma("unroll") for (int k = 0; k < 2; ++k) dst[n][k] = *(const LAS bf16x8*)(lds + PG8_SB(b, h) + boff + n * 2048 + k * 1024); } while (0)
#define PG8_MMA(ai, bj, At, Bt) do { __builtin_amdgcn_s_setprio(1); _Pragma("unroll") for (int m = 0; m < 4; ++m) _Pragma("unroll") for (int n = 0; n < 2; ++n) _Pragma("unroll") for (int k = 0; k < 2; ++k) \
        acc[ai][bj][m][n] = __builtin_amdgcn_mfma_f32_16x16x32_bf16(Bt[n][k], At[m][k], acc[ai][bj][m][n], 0, 0, 0); __builtin_amdgcn_s_setprio(0); } while (0)
#define PG8_WAIT_V(n) asm volatile("s_waitcnt vmcnt(" #n ")" ::: "memory")
#define PG8_WAIT_L(n) asm volatile("s_waitcnt lgkmcnt(" #n ")" ::: "memory")
#define PG8_BAR __builtin_amdgcn_s_barrier()
#define PG8_SCHED __builtin_amdgcn_sched_barrier(0)
    Unit cur, nxt; int ui = 0;
    if (!S.next(0, cur)) return;
    f32x4 acc[2][2][4][2];
#pragma unroll
    for (int a = 0; a < 2; ++a)
#pragma unroll
        for (int b = 0; b < 2; ++b)
#pragma unroll
            for (int m = 0; m < 4; ++m)
#pragma unroll
                for (int n = 0; n < 2; ++n) acc[a][b][m][n] = (f32x4){0.f, 0.f, 0.f, 0.f};
    bf16x8 At[4][2], B0[2][2], B1[2][2];
    const char* cA = (const char*)g.A + (size_t)cur.pm * tstep; const char* cB = (const char*)g.Bt + (size_t)cur.pn * tstep;
    PG8_STAGE(PG8_SB(0, 0), cB, voffB); PG8_STAGE(PG8_SA(0, 0), cA, voffA); PG8_STAGE(PG8_SB(0, 1), cB + hstep, voffB); PG8_STAGE(PG8_SA(0, 1), cA + hstep, voffA);
    if (wr == 1) PG8_BAR;
    PG8_WAIT_V(4); PG8_BAR;
    PG8_STAGE(PG8_SB(1, 0), cB + kstep, voffB); PG8_STAGE(PG8_SA(1, 0), cA + kstep, voffA); PG8_STAGE(PG8_SB(1, 1), cB + hstep + kstep, voffB);
    PG8_WAIT_V(6); PG8_BAR;
    for (;;) {
        const bool has_next = S.next(ui + 1, nxt);
        const char* nA = has_next ? (const char*)g.A + (size_t)nxt.pm * tstep : cA; const char* nB = has_next ? (const char*)g.Bt + (size_t)nxt.pn * tstep : cB;
        for (int t = 0; t < nt; t += 2) {
            const bool last = (t == nt - 2);
            const char* a1 = cA + (size_t)(t + 1) * kstep;
            const char* a2 = last ? nA : cA + (size_t)(t + 2) * kstep; const char* b2 = last ? nB : cB + (size_t)(t + 2) * kstep;
            const char* a3 = a2 + kstep; const char* b3 = b2 + kstep;
            PG8_LDB(B0, 0, 0); PG8_SCHED; PG8_LDA(At, 0, 0); PG8_STAGE(PG8_SA(1, 1), a1 + hstep, voffA);
            PG8_WAIT_L(8); PG8_BAR; PG8_WAIT_L(0); PG8_MMA(0, 0, At, B0); PG8_BAR; PG8_SCHED;
            PG8_LDB(B1, 0, 1); PG8_STAGE(PG8_SB(0, 0), b2, voffB);
            PG8_BAR; PG8_WAIT_L(0); PG8_MMA(0, 1, At, B1); PG8_BAR;
            PG8_LDA(At, 0, 1); PG8_STAGE(PG8_SA(0, 0), a2, voffA);
            PG8_BAR; PG8_WAIT_L(0); PG8_MMA(1, 0, At, B0); PG8_BAR; PG8_SCHED;
            PG8_STAGE(PG8_SB(0, 1), b2 + hstep, voffB);
            PG8_WAIT_V(6); PG8_BAR; PG8_MMA(1, 1, At, B1); PG8_BAR;
            PG8_LDB(B0, 1, 0); PG8_SCHED; PG8_LDA(At, 1, 0); PG8_STAGE(PG8_SA(0, 1), a2 + hstep, voffA);
            PG8_WAIT_L(8); PG8_BAR; PG8_WAIT_L(0); PG8_MMA(0, 0, At, B0); PG8_BAR; PG8_SCHED;
            PG8_LDB(B1, 1, 1); PG8_STAGE(PG8_SB(1, 0), b3, voffB);
            PG8_BAR; PG8_WAIT_L(0); PG8_MMA(0, 1, At, B1); PG8_BAR;
            PG8_LDA(At, 1, 1); PG8_STAGE(PG8_SA(1, 0), a3, voffA);
            PG8_BAR; PG8_WAIT_L(0); PG8_MMA(1, 0, At, B0); PG8_BAR; PG8_SCHED;
            PG8_STAGE(PG8_SB(1, 1), b3 + hstep, voffB);
            PG8_WAIT_V(6); PG8_BAR; PG8_MMA(1, 1, At, B1); PG8_BAR;
        }
        E(acc, cur, wr, wc, fr, fq);
        if (!has_next) break;
#pragma unroll
        for (int a = 0; a < 2; ++a)
#pragma unroll
            for (int b = 0; b < 2; ++b)
#pragma unroll
                for (int m = 0; m < 4; ++m)
#pragma unroll
                    for (int n = 0; n < 2; ++n) acc[a][b][m][n] = (f32x4){0.f, 0.f, 0.f, 0.f};
        cur = nxt; cA = nA; cB = nB; ++ui;
    }
    PG8_WAIT_V(0);
    if (wr == 0) PG8_BAR;
    PG8_BAR;
#undef PG8_SA
#undef PG8_SB
#undef PG8_STAGE
#undef PG8_LDA
#undef PG8_LDB
#undef PG8_MMA
#undef PG8_WAIT_V
#undef PG8_WAIT_L
#undef PG8_BAR
#undef PG8_SCHED
}
}
using pg8::Unit;
typedef f32x4 AccT[2][2][4][2];

struct EpiSwiglu {
    bf16_t* H; const float* rss;
    DI void operator()(const AccT& acc, const Unit& u, int wr, int wc, int fr, int fq) const {
        const int row0 = u.pm * 256 + wr * 64 + fr, col0 = u.pn * 128 + wc * 32 + 8 * fq;
#pragma unroll
        for (int ai = 0; ai < 2; ++ai)
#pragma unroll
            for (int m = 0; m < 4; ++m) {
                const int row = row0 + ai * 128 + m * 16;
                const float rstd = row_rstd(rss, row);
                float hv[8];
#pragma unroll
                for (int n = 0; n < 2; ++n)
#pragma unroll
                    for (int j = 0; j < 4; ++j) { const float gg = acc[ai][0][m][n][j] * rstd, uu = acc[ai][1][m][n][j] * rstd; hv[4 * n + j] = silu(gg) * uu; }
                u32x4 w = {pk2(hv[0], hv[1]), pk2(hv[2], hv[3]), pk2(hv[4], hv[5]), pk2(hv[6], hv[7])};
                *(u32x4*)(H + (size_t)row * DFFP + col0) = w;
            }
    }
};
struct EpiResid {
    float* X; bf16_t* XB; float* rssn; float scale;
    DI void operator()(const AccT& acc, const Unit& u, int wr, int wc, int fr, int fq) const {
        const int row0 = u.pm * 256 + wr * 64 + fr, col0 = u.pn * 256 + wc * 32 + 8 * fq;
#pragma unroll
        for (int ai = 0; ai < 2; ++ai)
#pragma unroll
            for (int m = 0; m < 4; ++m) {
                const int row = row0 + ai * 128 + m * 16; float ss = 0.f;
#pragma unroll
                for (int bj = 0; bj < 2; ++bj) {
                    float* xp = X + (size_t)row * DM + col0 + bj * 128;
                    f32x4 x0 = *(const f32x4*)xp, x1 = *(const f32x4*)(xp + 4);
                    x0 += acc[ai][bj][m][0] * scale; x1 += acc[ai][bj][m][1] * scale;
                    *(f32x4*)xp = x0; *(f32x4*)(xp + 4) = x1;
                    u32x4 w = {pk2(x0[0], x0[1]), pk2(x0[2], x0[3]), pk2(x1[0], x1[1]), pk2(x1[2], x1[3])};
                    *(u32x4*)(XB + (size_t)row * DM + col0 + bj * 128) = w;
#pragma unroll
                    for (int j = 0; j < 4; ++j) ss += x0[j] * x0[j] + x1[j] * x1[j];
                }
                ss += __shfl_xor(ss, 16); ss += __shfl_xor(ss, 32);
                if (fq == 0) rssn[(size_t)row * 16 + u.pn * 4 + wc] = ss;
            }
    }
};
struct EpiMixIn {
    bf16_t* PAB; bf16_t* PC; float* BG; const float* rss;
    DI void operator()(const AccT& acc, const Unit& u, int wr, int wc, int fr, int fq) const {
        const int row0 = u.pm * 256 + wr * 64 + fr;
        bf16_t* base; int ld, ct;
        if (u.pn < 7) { base = PAB; ld = LDAB; ct = u.pn * 256; } else { base = PC; ld = LDC; ct = (u.pn - 7) * 256; }
        const int col0 = ct + wc * 32 + 8 * fq;
        const bool isbg = (u.pn == 11) && (wc == 0) && (fq < 3);
#pragma unroll
        for (int ai = 0; ai < 2; ++ai)
#pragma unroll
            for (int m = 0; m < 4; ++m) {
                const int row = row0 + ai * 128 + m * 16;
                const float rstd = row_rstd(rss, row);
#pragma unroll
                for (int bj = 0; bj < 2; ++bj) {
                    const f32x4 v0 = acc[ai][bj][m][0] * rstd, v1 = acc[ai][bj][m][1] * rstd;
                    u32x4 w = {pk2(v0[0], v0[1]), pk2(v0[2], v0[3]), pk2(v1[0], v1[1]), pk2(v1[2], v1[3])};
                    *(u32x4*)(base + (size_t)row * ld + col0 + bj * 128) = w;
                    if (bj == 1 && isbg) { float* bp = BG + (size_t)row * 24 + 8 * fq; *(f32x4*)bp = v0; *(f32x4*)(bp + 4) = v1; }
                }
            }
    }
};

DI int map_src(int kind, int n) {
    if (kind == 0) return n;
    if (kind == 1) { const int pn = n >> 8, bj = (n >> 7) & 1, i = n & 127; const int hid = pn * 128 + i; return hid < DFF ? hid + bj * DFF : -1; }
    if (n < 1408) return n;
    if (n < 1792) return 2560 + (n - 1408);
    if (n < 2944) return 1408 + (n - 1792);
    if (n < 2968) return n;
    return -1;
}
DI void conv_w(const float* __restrict__ W, int ldw, int Kreal, bf16_t* __restrict__ Bt, int Np, int Kp, const float* __restrict__ gain, int kind, float* tile, int tid) {
    const int tnn = Np >> 6, ntile = tnn * (Kp >> 6);
    for (int t = blockIdx.x; t < ntile; t += gridDim.x) {
        const int n0 = (t % tnn) << 6, k0 = (t / tnn) << 6;
        {
            const int tn = tid & 63, tk = tid >> 6; const int src = map_src(kind, n0 + tn);
#pragma unroll
            for (int r = 0; r < 8; ++r) { const int kk = tk + 8 * r, k = k0 + kk; float v = 0.f;
                if (src >= 0 && k < Kreal) { v = W[(size_t)k * ldw + src]; if (gain) v *= gain[k]; }
                tile[kk * 65 + tn] = v; }
        }
        __syncthreads();
        {
            const int rn = tid >> 3, kk = (tid & 7) * 8; float a[8];
#pragma unroll
            for (int j = 0; j < 8; ++j) a[j] = tile[(kk + j) * 65 + rn];
            u32x4 w = {pk2(a[0], a[1]), pk2(a[2], a[3]), pk2(a[4], a[5]), pk2(a[6], a[7])};
            *(u32x4*)(Bt + (size_t)(n0 + rn) * Kp + k0 + kk) = w;
        }
        __syncthreads();
    }
}
DI void phase_convw(const Params& p, int l, unsigned char* shm, int tid) {
    float* tile = (float*)shm; unsigned char* ws = p.ws;
    conv_w(p.in[2] + (size_t)l * DM * 2 * DFF, 2 * DFF, DM, (bf16_t*)(ws + OFF_W_FFN1IN), NFF, DM, p.in[1] + l * DM, 1, tile, tid);
    conv_w(p.in[3] + (size_t)l * DFF * DM, DM, DFF, (bf16_t*)(ws + OFF_W_FFN1OUT), DM, DFFP, nullptr, 0, tile, tid);
    conv_w(p.in[5] + (size_t)l * DM * 2968, 2968, DM, (bf16_t*)(ws + OFF_W_MIXIN), NMIX, DM, p.in[4] + l * DM, 2, tile, tid);
    conv_w(p.in[13] + (size_t)l * DM * DM, DM, DM, (bf16_t*)(ws + OFF_W_MIXOUT), DM, DM, nullptr, 0, tile, tid);
    conv_w(p.in[15] + (size_t)l * DM * 2 * DFF, 2 * DFF, DM, (bf16_t*)(ws + OFF_W_FFN2IN), NFF, DM, p.in[14] + l * DM, 1, tile, tid);
    conv_w(p.in[16] + (size_t)l * DFF * DM, DM, DFF, (bf16_t*)(ws + OFF_W_FFN2OUT), DM, DFFP, nullptr, 0, tile, tid);
}

DI void phase_init(const Params& p, int gw, int nw, int lane) {
    const float* x = p.in[0]; float* X = p.out; bf16_t* XB = (bf16_t*)(p.ws + OFF_XB); float* rss = (float*)(p.ws + OFF_RSS);
    for (int row0 = gw * 4; row0 < MTOK; row0 += nw * 4) {
        f32x4 v[4][4];
#pragma unroll
        for (int r = 0; r < 4; ++r)
#pragma unroll
            for (int i = 0; i < 4; ++i) v[r][i] = *(const f32x4*)(x + (size_t)(row0 + r) * DM + i * 256 + lane * 4);
#pragma unroll
        for (int r = 0; r < 4; ++r) {
            float ss = 0.f;
#pragma unroll
            for (int i = 0; i < 4; ++i) {
                const size_t o = (size_t)(row0 + r) * DM + i * 256 + lane * 4;
                *(f32x4*)(X + o) = v[r][i];
                u32x2 w = {pk2(v[r][i][0], v[r][i][1]), pk2(v[r][i][2], v[r][i][3])}; *(u32x2*)(XB + o) = w;
                ss += v[r][i][0] * v[r][i][0] + v[r][i][1] * v[r][i][1] + v[r][i][2] * v[r][i][2] + v[r][i][3] * v[r][i][3];
            }
            ss = wave_sum(ss); if (lane < 16) rss[(size_t)(row0 + r) * 16 + lane] = lane == 0 ? ss : 0.f;
        }
    }
    if (gw == 0) { unsigned* misc = (unsigned*)(p.ws + OFF_MISC); misc[lane] = 0u; misc[64 + lane] = 0u; }
}
DI void phase_final(const Params& p, int gw, int nw, int lane) {
    float* X = p.out; const float* rss = (const float*)(p.ws + OFF_RSS); const float* g = p.in[17];
    for (int row0 = gw * 4; row0 < MTOK; row0 += nw * 4) {
        f32x4 v[4][4]; float rstd[4];
#pragma unroll
        for (int r = 0; r < 4; ++r) {
            rstd[r] = row_rstd(rss, row0 + r);
#pragma unroll
            for (int i = 0; i < 4; ++i) v[r][i] = *(const f32x4*)(X + (size_t)(row0 + r) * DM + i * 256 + lane * 4);
        }
#pragma unroll
        for (int r = 0; r < 4; ++r)
#pragma unroll
            for (int i = 0; i < 4; ++i) {
                const int c = i * 256 + lane * 4; const f32x4 gv = *(const f32x4*)(g + c);
                *(f32x4*)(X + (size_t)(row0 + r) * DM + c) = v[r][i] * rstd[r] * gv;
            }
    }
}

DI void store_row64(bf16_t* dst, const float (&val)[64]) {
#pragma unroll
    for (int i = 0; i < 8; ++i) { u32x4 w = {pk2(val[8 * i], val[8 * i + 1]), pk2(val[8 * i + 2], val[8 * i + 3]), pk2(val[8 * i + 4], val[8 * i + 5]), pk2(val[8 * i + 6], val[8 * i + 7])};
        *(u32x4*)(dst + 8 * i) = w; }
}
DI void phase_prep(const Params& p, int l, int gw, int nw, int lane0) {
    unsigned char* ws = p.ws;
    const bf16_t* PAB = (const bf16_t*)(ws + OFF_PAB); const bf16_t* PC = (const bf16_t*)(ws + OFF_PC);
    bf16_t* QC = (bf16_t*)(ws + OFF_QC); bf16_t* KC = (bf16_t*)(ws + OFF_KC); bf16_t* KTC = (bf16_t*)(ws + OFF_KTC); bf16_t* VTC = (bf16_t*)(ws + OFF_VTC);
    bf16_t* VT = (bf16_t*)(ws + OFF_VT);
    const float* cw = p.in[6] + (size_t)l * 5 * 1152;
    for (int u = gw; u < 512 * 25; u += nw) {
        int lane = lane0; asm volatile("" : "+v"(lane));
        const int grp = u % 25, ck = u / 25, b = ck >> 7, chunk = ck & 127;
        if (grp == 24) {
            const bf16_t* kr = PAB + ((size_t)b * SEQ + chunk * 64 + lane) * LDAB + 896;
            unsigned* kmx = (unsigned*)(ws + OFF_MISC) + l * 32 + b * 8;
#pragma unroll
            for (int hm = 0; hm < 8; ++hm) {
                float ss = 0.f;
#pragma unroll
                for (int c4 = 0; c4 < 4; ++c4) { const u32x4 v = *(const u32x4*)(kr + hm * 32 + c4 * 8);
#pragma unroll
                    for (int e = 0; e < 4; ++e) { const float a = bflo(v[e]), bb = bfhi(v[e]); ss += a * a + bb * bb; } }
#pragma unroll
                for (int o = 32; o > 0; o >>= 1) ss = fmaxf(ss, __shfl_xor(ss, o));
                if (lane == 0) atomicMax(kmx + hm, __float_as_uint(ss));
            }
            continue;
        }
        float val[64];
        if (grp < 18) {
            const int type = grp / 6, h = grp % 6, col = type * 384 + h * 64 + lane;
            const float w0 = cw[col], w1 = cw[1152 + col], w2 = cw[2 * 1152 + col], w3 = cw[3 * 1152 + col], w4 = cw[4 * 1152 + col];
            float xv[68];
#pragma unroll
            for (int i = 0; i < 68; ++i) { const int pos = chunk * 64 - 2 + i;
                xv[i] = (pos >= 0 && pos < SEQ) ? bf2f(PC[((size_t)b * SEQ + pos) * LDC + col]) : 0.f; }
#pragma unroll
            for (int t = 0; t < 64; ++t) { const float v = w0 * xv[t] + w1 * xv[t + 1] + w2 * xv[t + 2] + w3 * xv[t + 3] + w4 * xv[t + 4]; val[t] = silu(v); }
            if (type < 2) {
                const float sc = type == 0 ? 0.125f : 1.f;
#pragma unroll
                for (int t = 0; t < 64; ++t) { const float ss = wave_sum(val[t] * val[t]); val[t] *= __builtin_amdgcn_rsqf(ss + EPS) * sc; }
            }
            const size_t tb = ((size_t)(b * 6 + h) * 128 + chunk) * 4096;
            if (type == 0) {
#pragma unroll
                for (int t = 0; t < 64; ++t) QC[tb + t * 64 + lane] = f2bf(val[t]);
            } else if (type == 1) {
#pragma unroll
                for (int t = 0; t < 64; ++t) KC[tb + t * 64 + lane] = f2bf(val[t]);
                store_row64(KTC + tb + lane * 64, val);
            } else {
                store_row64(VTC + tb + lane * 64, val);
            }
        } else {
            const int vh = grp - 18; const int col = (vh < 2 ? 512 + vh * 64 : 1152 + (vh - 2) * 64) + lane;
            const size_t tok0 = (size_t)b * SEQ + chunk * 64;
#pragma unroll
            for (int t = 0; t < 64; ++t) val[t] = bf2f(PAB[(tok0 + t) * LDAB + col]);
            store_row64(VT + ((size_t)(b * 6 + vh) * 64 + lane) * SEQ + chunk * 64, val);
        }
    }
}

DI void phase_chunk(const Params& p, int l, int gw, int nw, int lane0, int wid, unsigned char* shm) {
    unsigned char* ws = p.ws;
    float* Mf = (float*)(shm + wid * 16384); bf16_t* AB = (bf16_t*)Mf; bf16_t* ABG = AB + 4096;
    const bf16_t* QC = (const bf16_t*)(ws + OFF_QC); const bf16_t* KC = (const bf16_t*)(ws + OFF_KC);
    const bf16_t* KTC = (const bf16_t*)(ws + OFF_KTC); const bf16_t* VTC = (const bf16_t*)(ws + OFF_VTC);
    const float* BG = (const float*)(ws + OFF_BG);
    bf16_t* U = (bf16_t*)(ws + OFF_U); bf16_t* WB = (bf16_t*)(ws + OFF_WB); bf16_t* QK = (bf16_t*)(ws + OFF_QK); float* GC = (float*)(ws + OFF_GC);
    for (int it = gw; it < 6144; it += nw) {
        int lane = lane0; asm volatile("" : "+v"(lane));
        const int fr = lane & 15, q = lane >> 4;
        const int chunk = it & 127, seq = it >> 7, dir = seq & 1, bh = seq >> 1, b = bh / 6, h = bh % 6;
        const int pch = dir ? 127 - chunk : chunk;
        const size_t tb = ((size_t)bh * 128 + pch) * 4096;
        const int tkl = dir ? 63 - lane : lane;
        const size_t tok = (size_t)b * SEQ + pch * 64 + tkl;
        const float braw = BG[tok * 24 + dir * 6 + h], araw = BG[tok * 24 + 12 + dir * 6 + h];
        const float beta = 1.f / (1.f + expf(-braw));
        const float Aa = expf(p.in[10][l * 12 + dir * 6 + h]); const float xx = araw + p.in[11][l * 12 + dir * 6 + h];
        const float sp = fmaxf(xx, 0.f) + log1pf(expf(-fabsf(xx)));
        const float g = -Aa * sp;
        float gc = g;
#pragma unroll
        for (int o = 1; o < 64; o <<= 1) { const float t = __shfl_up(gc, o); if (lane >= o) gc += t; }
        GC[(size_t)it * 64 + lane] = gc;
        bf16x8 kf[4][2], qf[4][2];
#pragma unroll
        for (int m = 0; m < 4; ++m)
#pragma unroll
            for (int s = 0; s < 2; ++s) { const int row = 16 * m + fr; const int tr = dir ? 63 - row : row;
                kf[m][s] = *(const bf16x8*)(KC + tb + tr * 64 + 32 * s + 8 * q); qf[m][s] = *(const bf16x8*)(QC + tb + tr * 64 + 32 * s + 8 * q); }
#pragma unroll
        for (int m = 0; m < 4; ++m)
#pragma unroll
            for (int n = 0; n <= m; ++n) {
                f32x4 acc = {0.f, 0.f, 0.f, 0.f};
                acc = MFMA16(kf[m][0], kf[n][0], acc); acc = MFMA16(kf[m][1], kf[n][1], acc);
                const int s_ = 16 * n + fr; const float gcs = __shfl(gc, s_);
#pragma unroll
                for (int r = 0; r < 4; ++r) { const int c = 16 * m + 4 * q + r; const float gcc = __shfl(gc, c), bc = __shfl(beta, c);
                    Mf[c * 64 + s_] = (s_ < c) ? bc * acc[r] * fexp(gcc - gcs) : 0.f; }
                __builtin_amdgcn_sched_barrier(0);
            }
#pragma unroll
        for (int n = 0; n < 4; ++n)
#pragma unroll
            for (int m = 0; m < 4; ++m) {
                f32x4 v = {0.f, 0.f, 0.f, 0.f};
                const int c = 16 * n + fr;
                if (m <= n) {
                    f32x4 acc = {0.f, 0.f, 0.f, 0.f};
                    acc = MFMA16(kf[m][0], qf[n][0], acc); acc = MFMA16(kf[m][1], qf[n][1], acc);
                    const float gcc = __shfl(gc, c);
#pragma unroll
                    for (int r = 0; r < 4; ++r) { const int s_ = 16 * m + 4 * q + r; const float gcs = __shfl(gc, s_); v[r] = (s_ <= c) ? acc[r] * fexp(gcc - gcs) : 0.f; }
                }
                u32x2 w = {pk2(v[0], v[1]), pk2(v[2], v[3])};
                *(u32x2*)(QK + (size_t)it * 4096 + c * 64 + 16 * m + 4 * q) = w;
                __builtin_amdgcn_sched_barrier(0);
            }
        __builtin_amdgcn_sched_barrier(0);
        bf16x8 vfr[4][2], ktf[4][2];
#pragma unroll
        for (int n = 0; n < 4; ++n) {
            const bf16_t* vp = VTC + tb + (16 * n + fr) * 64 + 8 * q; vfr[n][0] = *(const bf16x8*)vp; vfr[n][1] = *(const bf16x8*)(vp + 32);
            const bf16_t* kp = KTC + tb + (16 * n + fr) * 64 + 8 * q; ktf[n][0] = *(const bf16x8*)kp; ktf[n][1] = *(const bf16x8*)(kp + 32);
        }
        float x[64];
#pragma unroll
        for (int i = 0; i < 64; ++i) {
            float a = (i == lane) ? 1.f : 0.f;
#pragma unroll
            for (int m = 0; m < i; ++m) a -= Mf[i * 64 + m] * x[m];
            x[i] = a;
            __builtin_amdgcn_sched_barrier(0);
        }
        {
            const float bj = beta, bgj = beta * fexp(gc);
#pragma unroll
            for (int i = 0; i < 64; ++i) { AB[i * 64 + tkl] = f2bf(x[i] * bj); ABG[i * 64 + tkl] = f2bf(x[i] * bgj); }
        }
        __builtin_amdgcn_sched_barrier(0);
#pragma unroll
        for (int m = 0; m < 4; ++m) {
            const bf16x8 a0 = *(const bf16x8*)(AB + (16 * m + fr) * 64 + 8 * q), a1 = *(const bf16x8*)(AB + (16 * m + fr) * 64 + 32 + 8 * q);
#pragma unroll
            for (int n = 0; n < 4; ++n) {
                const bf16x8 b0 = vfr[n][0], b1 = vfr[n][1];
                f32x4 acc = {0.f, 0.f, 0.f, 0.f};
                acc = MFMA16(a0, b0, acc); acc = MFMA16(a1, b1, acc);
                u32x2 w = {pk2(acc[0], acc[1]), pk2(acc[2], acc[3])};
                *(u32x2*)(U + (size_t)it * 4096 + (16 * n + fr) * 64 + 16 * m + 4 * q) = w;
            }
        }
        __builtin_amdgcn_sched_barrier(0);
#pragma unroll
        for (int n = 0; n < 4; ++n) {
            const bf16x8 b0 = *(const bf16x8*)(ABG + (16 * n + fr) * 64 + 8 * q), b1 = *(const bf16x8*)(ABG + (16 * n + fr) * 64 + 32 + 8 * q);
#pragma unroll
            for (int m = 0; m < 4; ++m) {
                const bf16x8 a0 = ktf[m][0], a1 = ktf[m][1];
                f32x4 acc = {0.f, 0.f, 0.f, 0.f};
                acc = MFMA16(a0, b0, acc); acc = MFMA16(a1, b1, acc);
                u32x2 w = {pk2(acc[0], acc[1]), pk2(acc[2], acc[3])};
                *(u32x2*)(WB + (size_t)it * 4096 + (16 * n + fr) * 64 + 16 * m + 4 * q) = w;
            }
        }
    }
}

constexpr int SCAN_SLOT = 25600;
DI void scan_issue(LAS unsigned char* slot, const bf16_t* WB, const bf16_t* U, const bf16_t* KTC, const float* GC, int seq, int bh, int dir, int lw, int i, int lane) {
    const int it = seq * 128 + i; const int pch = dir ? 127 - i : i;
    const bf16_t* Wp = WB + (size_t)it * 4096; const bf16_t* Kp = KTC + ((size_t)bh * 128 + pch) * 4096;
    const bf16_t* Up = U + (size_t)it * 4096 + (16 * lw) * 64; const float* gcp = GC + (size_t)it * 64;
    const int r8 = lane >> 3, c8 = lane & 7;
#pragma unroll
    for (int jj = 0; jj < 2; ++jj) {
        const int j = 2 * lw + jj;
        const int row = 8 * j + r8; const int cid = c8 ^ (row & 7);
        __builtin_amdgcn_global_load_lds((const unsigned*)(Wp + row * 64 + cid * 8), (LAS unsigned*)(slot + j * 1024), 16, 0, 0);
        __builtin_amdgcn_global_load_lds((const unsigned*)(Kp + row * 64 + cid * 8), (LAS unsigned*)(slot + 8192 + j * 1024), 16, 0, 0);
    }
#pragma unroll
    for (int j = 0; j < 2; ++j) {
        const int row = 8 * j + r8; const int cid = c8 ^ (row & 7);
        __builtin_amdgcn_global_load_lds((const unsigned*)(Up + row * 64 + cid * 8), (LAS unsigned*)(slot + 16384 + lw * 2048 + j * 1024), 16, 0, 0);
    }
    __builtin_amdgcn_global_load_lds((const unsigned*)(gcp + (lane & 15) * 4), (LAS unsigned*)(slot + 24576), 16, 0, 0);
}
DI u32x2 lds_piece(const LAS unsigned char* tile, int row, int e) {
    return *(const LAS u32x2*)(tile + row * 128 + ((((e >> 3) ^ (row & 7))) << 4) + ((e & 4) << 1));
}
DI bf16x8 mk8(u32x2 x, u32x2 y) { u32x4 r = {x.x, x.y, y.x, y.y}; return __builtin_bit_cast(bf16x8, r); }
DI bf16x8 mk8rev(u32x2 x, u32x2 y) { u32x4 r = {rot16(x.y), rot16(x.x), rot16(y.y), rot16(y.x)}; return __builtin_bit_cast(bf16x8, r); }
DI void scan_step(const LAS unsigned char* slot, int vs, int dir, int fr, int q, f32x4 (&S)[4], bf16_t* sst) {
    bf16x8 Sb[2];
    Sb[0] = pack8(S[0], S[1]); Sb[1] = pack8(S[2], S[3]);
    {
        const u32x4 s0 = __builtin_bit_cast(u32x4, Sb[0]), s1 = __builtin_bit_cast(u32x4, Sb[1]);
        *(u32x2*)(sst + 0) = (u32x2){s0.x, s0.y}; *(u32x2*)(sst + 16) = (u32x2){s0.z, s0.w};
        *(u32x2*)(sst + 32) = (u32x2){s1.x, s1.y}; *(u32x2*)(sst + 48) = (u32x2){s1.z, s1.w};
    }
    const LAS unsigned char* ut = slot + 16384 + vs * 2048;
    const LAS float* gcl_p = (const LAS float*)(slot + 24576);
    const float gcl = gcl_p[63]; const float gl = fexp(gcl);
    f32x4 vg[4];
#pragma unroll
    for (int m = 0; m < 4; ++m) {
        const int c = 16 * m + fr;
        const bf16x8 w0 = mk8(lds_piece(slot, c, 4 * q), lds_piece(slot, c, 16 + 4 * q)), w1 = mk8(lds_piece(slot, c, 32 + 4 * q), lds_piece(slot, c, 48 + 4 * q));
        f32x4 acc = {0.f, 0.f, 0.f, 0.f};
        acc = MFMA16(w0, Sb[0], acc); acc = MFMA16(w1, Sb[1], acc);
        const u32x2 uu = lds_piece(ut, fr, 16 * m + 4 * q);
        const f32x4 gcv = *(const LAS f32x4*)(slot + 24576 + (16 * m + 4 * q) * 4);
        vg[m][0] = (bflo(uu.x) - acc[0]) * fexp(gcl - gcv[0]); vg[m][1] = (bfhi(uu.x) - acc[1]) * fexp(gcl - gcv[1]);
        vg[m][2] = (bflo(uu.y) - acc[2]) * fexp(gcl - gcv[2]); vg[m][3] = (bfhi(uu.y) - acc[3]) * fexp(gcl - gcv[3]);
    }
    bf16x8 Vg[2];
    Vg[0] = pack8(vg[0], vg[1]); Vg[1] = pack8(vg[2], vg[3]);
#pragma unroll
    for (int kt = 0; kt < 4; ++kt) {
        const int k = 16 * kt + fr;
        bf16x8 k0, k1;
        if (dir == 0) { k0 = mk8(lds_piece(slot + 8192, k, 4 * q), lds_piece(slot + 8192, k, 16 + 4 * q)); k1 = mk8(lds_piece(slot + 8192, k, 32 + 4 * q), lds_piece(slot + 8192, k, 48 + 4 * q)); }
        else { k0 = mk8rev(lds_piece(slot + 8192, k, 60 - 4 * q), lds_piece(slot + 8192, k, 44 - 4 * q)); k1 = mk8rev(lds_piece(slot + 8192, k, 28 - 4 * q), lds_piece(slot + 8192, k, 12 - 4 * q)); }
        f32x4 acc = S[kt] * gl;
        acc = MFMA16(k0, Vg[0], acc); acc = MFMA16(k1, Vg[1], acc);
        S[kt] = acc;
    }
}
DI void phase_scan(const Params& p, int lane, int wid, unsigned char* shm) {
    unsigned char* ws = p.ws;
    const bf16_t* KTC = (const bf16_t*)(ws + OFF_KTC);
    const bf16_t* U = (const bf16_t*)(ws + OFF_U); const bf16_t* WB = (const bf16_t*)(ws + OFF_WB);
    const float* GC = (const float*)(ws + OFF_GC); bf16_t* SST = (bf16_t*)(ws + OFF_SST);
    const int seq = blockIdx.x, dir = seq & 1, bh = seq >> 1;
    const int fr = lane & 15, q = lane >> 4;
    LAS unsigned char* ring = (LAS unsigned char*)shm;
    if (wid >= 4) {
        const int lw = wid - 4;
        scan_issue(ring, WB, U, KTC, GC, seq, bh, dir, lw, 0, lane);
        scan_issue(ring + SCAN_SLOT, WB, U, KTC, GC, seq, bh, dir, lw, 1, lane);
        scan_issue(ring + 2 * SCAN_SLOT, WB, U, KTC, GC, seq, bh, dir, lw, 2, lane);
        int slot_n = 3;
        for (int i = 0; i < 128; ++i) {
            scan_issue(ring + slot_n * SCAN_SLOT, WB, U, KTC, GC, seq, bh, dir, lw, i + 3 < 128 ? i + 3 : 127, lane);
            asm volatile("s_waitcnt vmcnt(21)" ::: "memory");
            __builtin_amdgcn_s_barrier();
            slot_n = slot_n == 4 ? 0 : slot_n + 1;
        }
        asm volatile("s_waitcnt vmcnt(0)" ::: "memory");
    } else {
        const int vs = wid;
        f32x4 S[4];
#pragma unroll
        for (int i = 0; i < 4; ++i) S[i] = (f32x4){0.f, 0.f, 0.f, 0.f};
        bf16_t* sst = SST + (size_t)seq * 128 * 4096 + (16 * vs + fr) * 64 + 4 * q;
        int slot_c = 0;
        for (int i = 0; i < 128; ++i) {
            __builtin_amdgcn_s_barrier();
            asm volatile("" ::: "memory");
            scan_step(ring + slot_c * SCAN_SLOT, vs, dir, fr, q, S, sst + (size_t)i * 4096);
            slot_c = slot_c == 4 ? 0 : slot_c + 1;
        }
    }
}
DI void phase_outp(const Params& p, int gw, int nw, int lane0) {
    unsigned char* ws = p.ws;
    const bf16_t* QC = (const bf16_t*)(ws + OFF_QC);
    const bf16_t* U = (const bf16_t*)(ws + OFF_U); const bf16_t* WB = (const bf16_t*)(ws + OFF_WB); const bf16_t* QK = (const bf16_t*)(ws + OFF_QK);
    const float* GC = (const float*)(ws + OFF_GC); const bf16_t* SST = (const bf16_t*)(ws + OFF_SST);
    for (int it = gw; it < 6144; it += nw) {
        int lane = lane0; asm volatile("" : "+v"(lane));
        const int fr = lane & 15, q = lane >> 4;
        const int chunk = it & 127, seq = it >> 7, dir = seq & 1, bh = seq >> 1, b = bh / 6, h = bh % 6;
        const int pch = dir ? 127 - chunk : chunk;
        const size_t tb = ((size_t)bh * 128 + pch) * 4096;
        const bf16_t* Wp = WB + (size_t)it * 4096; const bf16_t* Up = U + (size_t)it * 4096; const bf16_t* QKp = QK + (size_t)it * 4096;
        const bf16_t* Sp = SST + (size_t)it * 4096; const float* gcp = GC + (size_t)it * 64;
        bf16_t* OT = (bf16_t*)(ws + OFF_WB) + (size_t)it * 4096;
        bf16x8 wf[4][2], qf[4][2], kf[4][2]; f32x4 eg[4];
#pragma unroll
        for (int m = 0; m < 4; ++m) {
            const int c = 16 * m + fr; const int tr = dir ? 63 - c : c;
            wf[m][0] = *(const bf16x8*)(Wp + c * 64 + 8 * q); wf[m][1] = *(const bf16x8*)(Wp + c * 64 + 32 + 8 * q);
            qf[m][0] = *(const bf16x8*)(QC + tb + tr * 64 + 8 * q); qf[m][1] = *(const bf16x8*)(QC + tb + tr * 64 + 32 + 8 * q);
            const bf16_t* kp = QKp + c * 64 + 4 * q;
            kf[m][0] = ld2x8(kp, kp + 16); kf[m][1] = ld2x8(kp + 32, kp + 48);
            const f32x4 gcv = *(const f32x4*)(gcp + 16 * m + 4 * q);
#pragma unroll
            for (int r = 0; r < 4; ++r) eg[m][r] = fexp(gcv[r]);
        }
#pragma unroll 1
        for (int vs = 0; vs < 4; ++vs) {
            const bf16x8 Sb0 = *(const bf16x8*)(Sp + (16 * vs + fr) * 64 + 8 * q), Sb1 = *(const bf16x8*)(Sp + (16 * vs + fr) * 64 + 32 + 8 * q);
            f32x4 vn[4], o[4];
#pragma unroll
            for (int m = 0; m < 4; ++m) {
                f32x4 acc = {0.f, 0.f, 0.f, 0.f};
                acc = MFMA16(wf[m][0], Sb0, acc); acc = MFMA16(wf[m][1], Sb1, acc);
                const u32x2 uu = *(const u32x2*)(Up + (16 * vs + fr) * 64 + 16 * m + 4 * q);
                vn[m][0] = bflo(uu.x) - acc[0]; vn[m][1] = bfhi(uu.x) - acc[1]; vn[m][2] = bflo(uu.y) - acc[2]; vn[m][3] = bfhi(uu.y) - acc[3];
                f32x4 a2 = {0.f, 0.f, 0.f, 0.f};
                a2 = MFMA16(qf[m][0], Sb0, a2); a2 = MFMA16(qf[m][1], Sb1, a2);
                o[m] = a2 * eg[m];
            }
            const bf16x8 Vb0 = pack8(vn[0], vn[1]), Vb1 = pack8(vn[2], vn[3]);
#pragma unroll
            for (int m = 0; m < 4; ++m) {
                f32x4 acc = o[m];
                acc = MFMA16(kf[m][0], Vb0, acc); acc = MFMA16(kf[m][1], Vb1, acc);
#pragma unroll
                for (int r = 0; r < 4; ++r) { const int c = 16 * m + 4 * q + r; OT[c * 64 + 16 * vs + fr] = f2bf(acc[r]); }
            }
        }
    }
}

DI bf16x8 packpv(const f32x16& pv, int s) {
    u32x4 r = {pk2(pv[8 * s], pv[8 * s + 1]), pk2(pv[8 * s + 2], pv[8 * s + 3]), pk2(pv[8 * s + 4], pv[8 * s + 5]), pk2(pv[8 * s + 6], pv[8 * s + 7])};
    return __builtin_bit_cast(bf16x8, r);
}
DI bf16x8 packp(const float (&pv)[16], int s) {
    u32x4 r = {pk2(pv[8 * s], pv[8 * s + 1]), pk2(pv[8 * s + 2], pv[8 * s + 3]), pk2(pv[8 * s + 4], pv[8 * s + 5]), pk2(pv[8 * s + 6], pv[8 * s + 7])};
    return __builtin_bit_cast(bf16x8, r);
}
#define CRW(reg) ((float)(((reg) & 3) + 8 * ((reg) >> 2)))

DI void phase_win(const Params& p, int l, int gw, int nw, int lane) {
    unsigned char* ws = p.ws;
    const bf16_t* PAB = (const bf16_t*)(ws + OFF_PAB); const bf16_t* VT = (const bf16_t*)(ws + OFF_VT); bf16_t* OB = (bf16_t*)(ws + OFF_OB);
    const int r32 = lane & 31, hh = lane >> 5;
    for (int item = gw; item < 6144; item += nw) {
        const int qt = item & 255, qh = (item >> 8) % 6, b = item / 1536, kvh = qh / 3;
        const int q0 = qt * 32, qi = q0 + r32;
        const bf16_t* qrow = PAB + ((size_t)b * SEQ + qi) * LDAB + qh * 64;
        bf16x8 qf[4];
#pragma unroll
        for (int st = 0; st < 4; ++st) qf[st] = *(const bf16x8*)(qrow + 16 * st + 8 * hh);
        const float slope2 = exp2f(-8.f * (float)(qh + 1) / 6.f) * LOG2E, scale2 = 0.125f * LOG2E;
        float m = p.in[7][l * 6 + qh] * LOG2E, lsum = hh == 0 ? 1.f : 0.f;
        f32x16 O[2];
#pragma unroll
        for (int i = 0; i < 16; ++i) { O[0][i] = 0.f; O[1][i] = 0.f; }
        const int kb0 = q0 - 128 < 0 ? 0 : q0 - 128, kb1 = q0 + 160 > SEQ ? SEQ : q0 + 160;
        for (int kb = kb0; kb < kb1; kb += 32) {
            const bf16_t* krow = PAB + ((size_t)b * SEQ + kb + r32) * LDAB + 384 + kvh * 64;
            f32x16 s;
#pragma unroll
            for (int i = 0; i < 16; ++i) s[i] = 0.f;
#pragma unroll
            for (int st = 0; st < 4; ++st) { const bf16x8 kf = *(const bf16x8*)(krow + 16 * st + 8 * hh); s = MFMA32(kf, qf[st], s); }
            bf16x8 vf[2][2];
#pragma unroll
            for (int dt = 0; dt < 2; ++dt) { const bf16_t* vrow = VT + ((size_t)(b * 6 + kvh) * 64 + 32 * dt + r32) * SEQ + kb + 4 * hh;
                vf[dt][0] = ld2x8(vrow, vrow + 8); vf[dt][1] = ld2x8(vrow + 16, vrow + 24); }
            const float qoff = (float)(kb + 4 * hh - qi);
            float t[16]; float mx = m;
#pragma unroll
            for (int reg = 0; reg < 16; ++reg) { const float ad = fabsf(qoff + CRW(reg)); float tv = s[reg] * scale2 - slope2 * ad; tv = (ad <= 128.f) ? tv : -1e30f; t[reg] = tv; mx = fmaxf(mx, tv); }
            mx = fmaxf(mx, __shfl_xor(mx, 32));
            const float alpha = fexp2(m - mx); m = mx;
            float ps = 0.f;
#pragma unroll
            for (int reg = 0; reg < 16; ++reg) { t[reg] = fexp2(t[reg] - m); ps += t[reg]; }
            lsum = lsum * alpha + ps;
#pragma unroll
            for (int i = 0; i < 16; ++i) { O[0][i] *= alpha; O[1][i] *= alpha; }
            const bf16x8 pf0 = packp(t, 0), pf1 = packp(t, 1);
#pragma unroll
            for (int dt = 0; dt < 2; ++dt) { O[dt] = MFMA32(vf[dt][0], pf0, O[dt]); O[dt] = MFMA32(vf[dt][1], pf1, O[dt]); }
        }
        lsum += __shfl_xor(lsum, 32);
        const float inv = 1.f / lsum;
        bf16_t* orow = OB + ((size_t)b * SEQ + qi) * DM + qh * 64;
#pragma unroll
        for (int dt = 0; dt < 2; ++dt)
#pragma unroll
            for (int g4 = 0; g4 < 4; ++g4) {
                u32x2 w = {pk2(O[dt][4 * g4] * inv, O[dt][4 * g4 + 1] * inv), pk2(O[dt][4 * g4 + 2] * inv, O[dt][4 * g4 + 3] * inv)};
                *(u32x2*)(orow + 32 * dt + 8 * g4 + 4 * hh) = w;
            }
    }
}

DI void win_block(const Params& p, int l, int item, int tid, unsigned char* shm) {
    unsigned char* ws = p.ws;
    const bf16_t* PAB = (const bf16_t*)(ws + OFF_PAB); const bf16_t* VT = (const bf16_t*)(ws + OFF_VT); bf16_t* OB = (bf16_t*)(ws + OFF_OB);
    const int lane = tid & 63, wid = tid >> 6, r32 = lane & 31, hh = lane >> 5;
    const int qblk = item & 31, kvh = (item >> 5) & 1, b = item >> 6;
    const int Q0 = qblk * 256, K0 = Q0 - 128;
    {
        const int srow = tid >> 3, sch = tid & 7;
        const int kwoff = srow * 128 + ((sch ^ (srow & 7)) * 16);
        const int vblk = sch >> 1, vhalf = sch & 1;
        const int vwoff0 = 65536 + srow * 128 + (((2 * vblk) ^ (srow & 7)) * 16) + 8 * vhalf;
        const int vwoff1 = 65536 + srow * 128 + (((2 * vblk + 1) ^ (srow & 7)) * 16) + 8 * vhalf;
        __syncthreads();
#pragma unroll 1
        for (int g0 = 0; g0 < 8; g0 += 4) {
            u32x4 kr[4], vr[4];
#pragma unroll
            for (int gg = 0; gg < 4; ++gg) {
                const int g = g0 + gg;
                int kpos = K0 + g * 64 + srow; kpos = kpos < 0 ? 0 : (kpos > SEQ - 1 ? SEQ - 1 : kpos);
                int key0 = K0 + g * 64; key0 = key0 < 0 ? 0 : (key0 > SEQ - 64 ? SEQ - 64 : key0);
                kr[gg] = *(const u32x4*)(PAB + ((size_t)b * SEQ + kpos) * LDAB + 384 + kvh * 64 + sch * 8);
                vr[gg] = *(const u32x4*)(VT + ((size_t)(b * 6 + kvh) * 64 + srow) * SEQ + key0 + sch * 8);
            }
#pragma unroll
            for (int gg = 0; gg < 4; ++gg) {
                const int g = g0 + gg;
                *(u32x4*)(shm + g * 8192 + kwoff) = kr[gg];
                *(u32x2*)(shm + g * 8192 + vwoff0) = (u32x2){vr[gg].x, vr[gg].y}; *(u32x2*)(shm + g * 8192 + vwoff1) = (u32x2){vr[gg].z, vr[gg].w};
            }
        }
        __syncthreads();
    }
    const int q0 = Q0 + wid * 32, qi = q0 + r32;
    const int kb0 = q0 - 128 < 0 ? 0 : q0 - 128, kb1 = q0 + 160 > SEQ ? SEQ : q0 + 160;
#pragma unroll 1
    for (int g3 = 0; g3 < 3; ++g3) {
        const int qh = kvh * 3 + g3;
        const bf16_t* qrow = PAB + ((size_t)b * SEQ + qi) * LDAB + qh * 64;
        bf16x8 qf[4];
#pragma unroll
        for (int st = 0; st < 4; ++st) qf[st] = *(const bf16x8*)(qrow + 16 * st + 8 * hh);
        const float slope2 = exp2f(-8.f * (float)(qh + 1) / 6.f) * LOG2E, scale2 = 0.125f * LOG2E;
        float m = p.in[7][l * 6 + qh] * LOG2E, lsum = hh == 0 ? 1.f : 0.f;
        f32x16 O[2];
#pragma unroll
        for (int i = 0; i < 16; ++i) { O[0][i] = 0.f; O[1][i] = 0.f; }
        for (int kb = kb0; kb < kb1; kb += 32) {
            const int kl = kb - K0, g = kl >> 6, j = (kl >> 5) & 1;
            const unsigned char* Ks = shm + g * 8192; const unsigned char* Vs = shm + 65536 + g * 8192;
            f32x16 s;
#pragma unroll
            for (int i = 0; i < 16; ++i) s[i] = 0.f;
#pragma unroll
            for (int st = 0; st < 4; ++st) { const bf16x8 kf = *(const bf16x8*)(Ks + (32 * j + r32) * 128 + (((2 * st + hh) ^ (r32 & 7)) * 16)); s = MFMA32(kf, qf[st], s); }
            bf16x8 vf[2][2];
#pragma unroll
            for (int dt = 0; dt < 2; ++dt)
#pragma unroll
                for (int s_ = 0; s_ < 2; ++s_) vf[dt][s_] = *(const bf16x8*)(Vs + (32 * dt + r32) * 128 + (((4 * j + 2 * s_ + hh) ^ (r32 & 7)) * 16));
            float qoff = (float)(kb + 4 * hh - qi); asm volatile("" : "+v"(qoff));
            float t[16]; float mx = m;
#pragma unroll
            for (int reg = 0; reg < 16; ++reg) { const float ad = fabsf(qoff + CRW(reg)); float tv = s[reg] * scale2 - slope2 * ad; tv = (ad <= 128.f) ? tv : -1e30f; t[reg] = tv; mx = fmaxf(mx, tv); }
            mx = fmaxf(mx, __shfl_xor(mx, 32));
            const float alpha = fexp2(m - mx); m = mx;
            float ps = 0.f;
#pragma unroll
            for (int reg = 0; reg < 16; ++reg) { t[reg] = fexp2(t[reg] - m); ps += t[reg]; }
            lsum = lsum * alpha + ps;
#pragma unroll
            for (int i = 0; i < 16; ++i) { O[0][i] *= alpha; O[1][i] *= alpha; }
            const bf16x8 pf0 = packp(t, 0), pf1 = packp(t, 1);
#pragma unroll
            for (int dt = 0; dt < 2; ++dt) { O[dt] = MFMA32(vf[dt][0], pf0, O[dt]); O[dt] = MFMA32(vf[dt][1], pf1, O[dt]); }
        }
        lsum += __shfl_xor(lsum, 32);
        const float inv = 1.f / lsum;
        bf16_t* orow = OB + ((size_t)b * SEQ + qi) * DM + qh * 64;
#pragma unroll
        for (int dt = 0; dt < 2; ++dt)
#pragma unroll
            for (int g4 = 0; g4 < 4; ++g4) {
                u32x2 w = {pk2(O[dt][4 * g4] * inv, O[dt][4 * g4 + 1] * inv), pk2(O[dt][4 * g4 + 2] * inv, O[dt][4 * g4 + 3] * inv)};
                *(u32x2*)(orow + 32 * dt + 8 * g4 + 4 * hh) = w;
            }
    }
}

DI bf16x8 scale_frag(bf16x8 v, float sc) {
    u32x4 u = __builtin_bit_cast(u32x4, v), r;
#pragma unroll
    for (int i = 0; i < 4; ++i) r[i] = pk2(bflo(u[i]) * sc, bfhi(u[i]) * sc);
    return __builtin_bit_cast(bf16x8, r);
}
DI void phase_diff(const Params& p, int l, int tid0, unsigned char* shm) {
    unsigned char* ws = p.ws;
    const bf16_t* PAB = (const bf16_t*)(ws + OFF_PAB); const bf16_t* VT = (const bf16_t*)(ws + OFF_VT); bf16_t* OB = (bf16_t*)(ws + OFF_OB);
    const float lam_init = l == 0 ? 0.2f : (0.8f - 0.6f * 0.7408182206817179f);
    float lam;
    {
        const int lane = tid0 & 63;
        const float* dl = p.in[8] + l * 128;
        float a = 0.f, c = 0.f;
        if (lane < 32) { a = dl[lane] * dl[32 + lane]; c = dl[64 + lane] * dl[96 + lane]; }
        a = wave_sum(a); c = wave_sum(c);
        lam = expf(a) - expf(c) + lam_init;
    }
    const float* dg = p.in[9] + l * 64;
    unsigned* qctr = (unsigned*)(ws + OFF_MISC) + 64 + l;
    const unsigned* kmx = (const unsigned*)(ws + OFF_MISC) + l * 32;
    __shared__ unsigned sq_words[32];
    volatile LAS unsigned* sq = (volatile LAS unsigned*)&sq_words[0];
    int first_win = 768;
    for (;;) {
        int tid = tid0; asm volatile("" : "+v"(tid));
        __syncthreads();
        if (tid == 0) sq[0] = atomicAdd(qctr, 1u);
        __syncthreads();
        const int idx_item = (int)sq[0];
        if (idx_item >= 512) { first_win = idx_item; break; }
        const int lane = tid & 63, wid = tid >> 6, r32 = lane & 31, hh = lane >> 5;
        const int qb = idx_item & 31, b = (idx_item >> 5) & 3, h = 3 - (idx_item >> 7);
        const int q0 = qb * 256 + wid * 32, qi = q0 + r32;
        const bf16_t* qrow = PAB + ((size_t)b * SEQ + qi) * LDAB + 640 + h * 64;
        const float scale2 = 0.17677669529663687f * LOG2E;
        bf16x8 qf[2][2];
#pragma unroll
        for (int mp = 0; mp < 2; ++mp)
#pragma unroll
            for (int st = 0; st < 2; ++st) qf[mp][st] = scale_frag(*(const bf16x8*)(qrow + mp * 32 + 16 * st + 8 * hh), scale2);
        const float slope2 = exp2f(-2.f * (float)(h + 1)) * LOG2E;
        float mA = -1e30f, mB = -1e30f, lA = 0.f, lB = 0.f;
        f32x16 OA[2], OBb[2];
#pragma unroll
        for (int i = 0; i < 16; ++i) { OA[0][i] = 0.f; OA[1][i] = 0.f; OBb[0][i] = 0.f; OBb[1][i] = 0.f; }
        const int srow = tid >> 3, sch = tid & 7;
        const bf16_t* kg = PAB + ((size_t)b * SEQ + srow) * LDAB + 896 + h * 64 + sch * 8;
        const bf16_t* vg = VT + ((size_t)(b * 6 + 2 + h) * 64 + srow) * SEQ + sch * 8;
        const int kwoff = srow * 128 + ((sch ^ (srow & 7)) * 16);
        const int vblk = sch >> 1, vhalf = sch & 1;
        const int vwoff0 = 16384 + srow * 128 + (((2 * vblk) ^ (srow & 7)) * 16) + 8 * vhalf;
        const int vwoff1 = 16384 + srow * 128 + (((2 * vblk + 1) ^ (srow & 7)) * 16) + 8 * vhalf;
        int lo, hi;
        {
            float qa = 0.f, qbm = 0.f;
#pragma unroll
            for (int st = 0; st < 2; ++st) { const u32x4 va = __builtin_bit_cast(u32x4, qf[0][st]), vb = __builtin_bit_cast(u32x4, qf[1][st]);
#pragma unroll
                for (int e = 0; e < 4; ++e) { qa += bflo(va[e]) * bflo(va[e]) + bfhi(va[e]) * bfhi(va[e]); qbm += bflo(vb[e]) * bflo(vb[e]) + bfhi(vb[e]) * bfhi(vb[e]); } }
            qa += __shfl_xor(qa, 32); qbm += __shfl_xor(qbm, 32);
            const float qaL = qa, qbL = qbm;
#pragma unroll
            for (int o = 16; o > 0; o >>= 1) { qa = fmaxf(qa, __shfl_xor(qa, o)); qbm = fmaxf(qbm, __shfl_xor(qbm, o)); }
            if (lane == 0) { sq[8 + 2 * wid] = __float_as_uint(qa); sq[9 + 2 * wid] = __float_as_uint(qbm); }
            __syncthreads();
            float qA = 0.f, qB = 0.f;
#pragma unroll
            for (int w8 = 0; w8 < 8; ++w8) { qA = fmaxf(qA, __uint_as_float(sq[8 + 2 * w8])); qB = fmaxf(qB, __uint_as_float(sq[9 + 2 * w8])); }
            const float kA = __uint_as_float(kmx[b * 8 + h * 2]), kB = __uint_as_float(kmx[b * 8 + h * 2 + 1]);
            mA = -sqrtf(qaL * kA) - 1.f; mB = -sqrtf(qbL * kB) - 1.f;
            const float bnd = 2.02f * fmaxf(sqrtf(qA * kA), sqrtf(qB * kB)) + 1.f;
            const float dsk = (168.f + bnd) / slope2;
            const int Dsk = dsk > 16384.f ? 16384 : (int)dsk + 1;
            const int Q0 = qb * 256;
            const int x = Q0 - 63 - Dsk; lo = x <= 0 ? 0 : (x + 63) >> 6;
            const int y = (Q0 + 255 + Dsk) >> 6; hi = y > 127 ? 127 : y;
        }
        const int d0 = qb * 4, nright = hi - d0 + 1, nstage = hi - lo + 1;
        u32x4 kreg, vreg;
        { const int kb = d0 * 64; kreg = *(const u32x4*)(kg + (size_t)kb * LDAB); vreg = *(const u32x4*)(vg + kb); }
        __syncthreads();
        *(u32x4*)(shm + kwoff) = kreg;
        *(u32x2*)(shm + vwoff0) = (u32x2){vreg.x, vreg.y}; *(u32x2*)(shm + vwoff1) = (u32x2){vreg.z, vreg.w};
        __syncthreads();
        for (int idx = 0; idx < nstage; ++idx) {
            const int kt = idx < nright ? d0 + idx : d0 - 1 - (idx - nright);
            const int buf = idx & 1;
            if (idx + 1 < nstage) {
                const int idn = idx + 1; const int ktn = idn < nright ? d0 + idn : d0 - 1 - (idn - nright);
                const int kbn = ktn * 64;
                kreg = *(const u32x4*)(kg + (size_t)kbn * LDAB); vreg = *(const u32x4*)(vg + kbn);
            }
            const unsigned char* Ks = shm + buf * 8192; const unsigned char* Vs = shm + 16384 + buf * 8192;
#pragma unroll
            for (int j = 0; j < 2; ++j) {
                const int kb = kt * 64 + 32 * j;
                bf16x8 kf[2][2], vf[2][2];
#pragma unroll
                for (int mp = 0; mp < 2; ++mp)
#pragma unroll
                    for (int st = 0; st < 2; ++st) kf[mp][st] = *(const bf16x8*)(Ks + (32 * j + r32) * 128 + (((mp * 4 + 2 * st + hh) ^ (r32 & 7)) * 16));
#pragma unroll
                for (int dt = 0; dt < 2; ++dt)
#pragma unroll
                    for (int s_ = 0; s_ < 2; ++s_) vf[dt][s_] = *(const bf16x8*)(Vs + (32 * dt + r32) * 128 + (((4 * j + 2 * s_ + hh) ^ (r32 & 7)) * 16));
                float qoff = (float)(kb + 4 * hh - qi); asm volatile("" : "+v"(qoff));
                f32x16 tA, tB;
                if (kb >= q0 + 32 || kb + 32 <= q0) {
                    const bool right = kb >= q0 + 32;
                    const float Lq = right ? -slope2 * qoff : slope2 * qoff;
                    const float LA = Lq - mA, LB = Lq - mB, sl = right ? -slope2 : slope2;
#pragma unroll
                    for (int reg = 0; reg < 16; ++reg) { tA[reg] = __builtin_fmaf(sl, CRW(reg), LA); tB[reg] = __builtin_fmaf(sl, CRW(reg), LB); }
                } else {
#pragma unroll
                    for (int reg = 0; reg < 16; ++reg) { const float bias = -slope2 * fabsf(qoff + CRW(reg)); tA[reg] = bias - mA; tB[reg] = bias - mB; }
                }
                tA = MFMA32(kf[0][0], qf[0][0], tA); tA = MFMA32(kf[0][1], qf[0][1], tA);
                tB = MFMA32(kf[1][0], qf[1][0], tB); tB = MFMA32(kf[1][1], qf[1][1], tB);
                float mxA = 0.f, mxB = 0.f;
#pragma unroll
                for (int reg = 0; reg < 16; ++reg) { mxA = fmaxf(mxA, tA[reg]); mxB = fmaxf(mxB, tB[reg]); }
                mxA = fmaxf(mxA, __shfl_xor(mxA, 32)); mxB = fmaxf(mxB, __shfl_xor(mxB, 32));
                if (__builtin_amdgcn_ballot_w64(mxA > 0.f) != 0ull) {
                    const float alpha = fexp2(-mxA); mA += mxA; lA *= alpha;
#pragma unroll
                    for (int i = 0; i < 16; ++i) { OA[0][i] *= alpha; OA[1][i] *= alpha; tA[i] -= mxA; }
                }
                if (__builtin_amdgcn_ballot_w64(mxB > 0.f) != 0ull) {
                    const float alpha = fexp2(-mxB); mB += mxB; lB *= alpha;
#pragma unroll
                    for (int i = 0; i < 16; ++i) { OBb[0][i] *= alpha; OBb[1][i] *= alpha; tB[i] -= mxB; }
                }
                float psA = 0.f, psB = 0.f;
#pragma unroll
                for (int reg = 0; reg < 16; ++reg) { tA[reg] = fexp2(tA[reg]); psA += tA[reg]; tB[reg] = fexp2(tB[reg]); psB += tB[reg]; }
                lA += psA; lB += psB;
                const bf16x8 pA0 = packpv(tA, 0), pA1 = packpv(tA, 1), pB0 = packpv(tB, 0), pB1 = packpv(tB, 1);
#pragma unroll
                for (int dt = 0; dt < 2; ++dt) {
                    OA[dt] = MFMA32(vf[dt][0], pA0, OA[dt]); OA[dt] = MFMA32(vf[dt][1], pA1, OA[dt]);
                    OBb[dt] = MFMA32(vf[dt][0], pB0, OBb[dt]); OBb[dt] = MFMA32(vf[dt][1], pB1, OBb[dt]);
                }
            }
            if (idx + 1 < nstage) {
                unsigned char* wb = shm + (buf ^ 1) * 8192;
                *(u32x4*)(wb + kwoff) = kreg;
                *(u32x2*)(wb + vwoff0) = (u32x2){vreg.x, vreg.y}; *(u32x2*)(wb + vwoff1) = (u32x2){vreg.z, vreg.w};
            }
            __syncthreads();
        }
        lA += __shfl_xor(lA, 32); lB += __shfl_xor(lB, 32);
        const float iA = 1.f / lA, iB = lam / lB;
        float ss = 0.f;
#pragma unroll
        for (int dt = 0; dt < 2; ++dt)
#pragma unroll
            for (int i = 0; i < 16; ++i) { const float v = OA[dt][i] * iA - OBb[dt][i] * iB; OA[dt][i] = v; ss += v * v; }
        ss += __shfl_xor(ss, 32);
        const float rstd = __builtin_amdgcn_rsqf(ss * (1.f / 64.f) + EPS) * (1.f - lam_init);
        bf16_t* orow = OB + ((size_t)b * SEQ + qi) * DM + 384 + h * 64;
#pragma unroll
        for (int dt = 0; dt < 2; ++dt)
#pragma unroll
            for (int g4 = 0; g4 < 4; ++g4) {
                const int d = 32 * dt + 8 * g4 + 4 * hh;
                const f32x4 gv = *(const f32x4*)(dg + d);
                u32x2 w = {pk2(OA[dt][4 * g4] * rstd * gv[0], OA[dt][4 * g4 + 1] * rstd * gv[1]), pk2(OA[dt][4 * g4 + 2] * rstd * gv[2], OA[dt][4 * g4 + 3] * rstd * gv[3])};
                *(u32x2*)(orow + d) = w;
            }
    }
    for (int item = first_win; item < 768;) {
        int tid = tid0; asm volatile("" : "+v"(tid));
        win_block(p, l, item - 512, tid, shm);
        __syncthreads();
        if (tid == 0) sq[0] = atomicAdd(qctr, 1u);
        __syncthreads();
        item = (int)sq[0];
    }
}

DI void phase_post(const Params& p, int l, int gw, int nw, int lane) {
    unsigned char* ws = p.ws;
    const bf16_t* OT = (const bf16_t*)(ws + OFF_WB); const bf16_t* PAB = (const bf16_t*)(ws + OFF_PAB); bf16_t* OB = (bf16_t*)(ws + OFF_OB);
    const float gl = p.in[12][l * 64 + lane];
    for (int u = gw; u < 6144; u += nw) {
        const int half = u & 1, h = (u % 12) >> 1, ck = u / 12, b = ck >> 7, chunk = ck & 127;
        const size_t itf = ((size_t)((b * 6 + h) * 2) * 128 + chunk), itb = ((size_t)((b * 6 + h) * 2 + 1) * 128 + (127 - chunk));
        const size_t tok0 = (size_t)b * SEQ + chunk * 64 + half * 32;
#pragma unroll 1
        for (int g = 0; g < 2; ++g) {
            float av[16], zv[16];
#pragma unroll
            for (int j = 0; j < 16; ++j) {
                const int t = half * 32 + g * 16 + j;
                av[j] = bf2f(OT[itf * 4096 + t * 64 + lane]) + bf2f(OT[itb * 4096 + (63 - t) * 64 + lane]);
                zv[j] = bf2f(PAB[(tok0 + g * 16 + j) * LDAB + 1408 + h * 64 + lane]);
            }
#pragma unroll
            for (int j = 0; j < 16; ++j) {
                const float ss = wave_sum(av[j] * av[j]);
                const float y = av[j] * __builtin_amdgcn_rsqf(ss * (1.f / 64.f) + EPS) * gl;
                OB[(tok0 + g * 16 + j) * DM + 640 + h * 64 + lane] = f2bf(y * silu(zv[j]));
            }
        }
    }
}

#define XB_TMO      128
#define XB_XCNT(j)  (256  + 64 * (j))
#define XB_XSUB(j)  (1280 + 64 * (j))
#define XB_XGEN(j)  (2304 + 64 * (j))
#define XB_TOP      3328
#define XB_TOPGEN   3392
#define XCD_BAR_WORDS 3456
#define XB_SPIN_CAP (1u << 18)
DI unsigned xb_ld(unsigned* p)              { return __hip_atomic_load(p, __ATOMIC_RELAXED, __HIP_MEMORY_SCOPE_AGENT); }
DI unsigned xb_add(unsigned* p, unsigned v) { return __hip_atomic_fetch_add(p, v, __ATOMIC_RELAXED, __HIP_MEMORY_SCOPE_AGENT); }
DI unsigned xb_xcc_id() { return (unsigned)__builtin_amdgcn_s_getreg((3 << 11) | 20) & 0xFu; }
#define XB_SPIN(cond, bar) do { unsigned _sp = 0; while (cond) { __builtin_amdgcn_s_sleep(1); \
    if ((++_sp & 255u) == 0u) { if (xb_ld(&(bar)[XB_TMO])) break; if (_sp > XB_SPIN_CAP) { atomicAdd(&(bar)[XB_TMO], 1u); break; } } } } while (0)
struct XcdBarrier { unsigned* bar; unsigned x; volatile LAS unsigned* st; };
DI XcdBarrier xcd_barrier_post(unsigned* bar, volatile LAS unsigned* st) {
    XcdBarrier b; b.bar = bar; b.x = xb_xcc_id(); b.st = st;
    if (threadIdx.x == 0) (void)xb_add(&bar[XB_XCNT(b.x)], 1u);
    return b;
}
DI void xcd_barrier_complete(unsigned* bar, unsigned x, unsigned& nloc, unsigned& nx) {
    const unsigned G = gridDim.x * gridDim.y * gridDim.z;
    unsigned sum, cnt, mine, sp = 0u;
    for (;;) {
        sum = 0u; cnt = 0u; mine = 0u;
#pragma unroll
        for (unsigned j = 0; j < 16; ++j) { const unsigned c = xb_ld(&bar[XB_XCNT(j)]); sum += c; cnt += (c > 0u) ? 1u : 0u; mine = (j == x) ? c : mine; }
        if (sum == G) break;
        __builtin_amdgcn_s_sleep(1);
        if ((++sp & 255u) == 0u) { if (xb_ld(&bar[XB_TMO])) break; if (sp > XB_SPIN_CAP) { atomicAdd(&bar[XB_TMO], 1u); break; } }
    }
    nloc = mine > 0u ? mine : 1u; nx = cnt > 0u ? cnt : 1u;
}
DI void xcd_barrier(const XcdBarrier& b) {
    asm volatile("s_waitcnt vmcnt(0)" ::: "memory");
    __syncthreads();
    if (threadIdx.x == 0) {
        unsigned* bar = b.bar;
        __builtin_amdgcn_s_waitcnt(0);
        unsigned nloc = b.st[0], nx = b.st[1];
        if (nloc == 0u) { xcd_barrier_complete(bar, b.x, nloc, nx); b.st[0] = nloc; b.st[1] = nx; }
        const unsigned old = xb_add(&bar[XB_XSUB(b.x)], 1u);
        const unsigned gen = old / nloc;
        if (old + 1u == (gen + 1u) * nloc) {
            __builtin_amdgcn_fence(__ATOMIC_RELEASE, "agent");
            asm volatile("s_waitcnt vmcnt(0)" ::: "memory");
            const unsigned og = xb_add(&bar[XB_TOP], 1u);
            const unsigned tg = og / nx;
            if (og + 1u == (tg + 1u) * nx) xb_add(&bar[XB_TOPGEN], 1u);
            else XB_SPIN(xb_ld(&bar[XB_TOPGEN]) == tg, bar);
            __builtin_amdgcn_fence(__ATOMIC_ACQUIRE, "agent");
            xb_add(&bar[XB_XGEN(b.x)], 1u);
            asm volatile("s_waitcnt vmcnt(0)" ::: "memory");
        } else {
            XB_SPIN(xb_ld(&bar[XB_XGEN(b.x)]) == gen, bar);
            __builtin_amdgcn_fence(__ATOMIC_ACQUIRE, "agent");
            asm volatile("s_waitcnt vmcnt(0)" ::: "memory");
        }
    }
    __syncthreads();
}

constexpr int NPHASE = 30;
DI void run_phase(const Params& p, int ph, unsigned char* shm, int tid) {
    const int wid = tid >> 6, lane = tid & 63;
    const int gw = blockIdx.x * 8 + wid, nw = gridDim.x * 8;
    unsigned char* ws = p.ws;
    if (ph == 0) { if (EN(0)) { phase_init(p, gw, nw, lane); phase_convw(p, 0, shm, tid); } return; }
    if (ph == NPHASE - 1) { if (EN(27)) phase_final(p, gw, nw, lane); return; }
    const int l = (ph - 1) / 14, sub = (ph - 1) % 14;
    float* rss = (float*)(ws + OFF_RSS);
    bf16_t* XB = (bf16_t*)(ws + OFF_XB);
    LAS unsigned char* lds = (LAS unsigned char*)shm;
    pg8::StaticOrder S;
    if (sub == 0) { if (EN(0)) if (l > 0) phase_convw(p, l, shm, tid); return; }
    if (EN(1)) if (sub == 1 || sub == 12) {
        const int f = sub == 1 ? 0 : 1;
        pg8::Gemm g{XB, (const bf16_t*)(ws + (f ? OFF_W_FFN2IN : OFF_W_FFN1IN)), MTOK, NFF, DM};
        EpiSwiglu E{(bf16_t*)(ws + OFF_BIG), rss + (size_t)((3 * l + (f ? 2 : 0)) & 1) * MTOK * 16};
        S.init(MTOK, NFF, gridDim.x, blockIdx.x);
        pg8::gemm_phase(tid, lds, g, S, E);
        if ((REPMASK >> 1) & 1) { __syncthreads(); pg8::gemm_phase(tid, lds, g, S, E); }
        return;
    }
    if (EN(2)) if (sub == 2 || sub == 13 || sub == 11) {
        const bf16_t* A; const bf16_t* Bt; int K; float scale; int nn;
        if (sub == 2) { A = (const bf16_t*)(ws + OFF_BIG); Bt = (const bf16_t*)(ws + OFF_W_FFN1OUT); K = DFFP; scale = 0.5f; nn = 3 * l + 1; }
        else if (sub == 13) { A = (const bf16_t*)(ws + OFF_BIG); Bt = (const bf16_t*)(ws + OFF_W_FFN2OUT); K = DFFP; scale = 0.5f; nn = 3 * l + 3; }
        else { A = (const bf16_t*)(ws + OFF_OB); Bt = (const bf16_t*)(ws + OFF_W_MIXOUT); K = DM; scale = 1.f; nn = 3 * l + 2; }
        pg8::Gemm g{A, Bt, MTOK, DM, K};
        EpiResid E{p.out, XB, rss + (size_t)(nn & 1) * MTOK * 16, scale};
        S.init(MTOK, DM, gridDim.x, blockIdx.x);
        pg8::gemm_phase(tid, lds, g, S, E); return;
    }
    if (EN(3)) if (sub == 3) {
        pg8::Gemm g{XB, (const bf16_t*)(ws + OFF_W_MIXIN), MTOK, NMIX, DM};
        EpiMixIn E{(bf16_t*)(ws + OFF_PAB), (bf16_t*)(ws + OFF_PC), (float*)(ws + OFF_BG), rss + (size_t)((3 * l + 1) & 1) * MTOK * 16};
        S.init(MTOK, NMIX, gridDim.x, blockIdx.x);
        pg8::gemm_phase(tid, lds, g, S, E);
        return;
    }
    if (EN(4)) if (sub == 4) { REP(4) phase_prep(p, l, gw, nw, lane); return; }
    if (EN(5)) if (sub == 5) { REP(5) phase_chunk(p, l, gw, nw, lane, wid, shm); return; }
    if (EN(6)) if (sub == 6) {
        if (blockIdx.x < 48) phase_scan(p, lane, wid, shm);
        phase_diff(p, l, tid, shm);
        return;
    }
    if (EN(10)) if (sub == 7) { phase_outp(p, gw, nw, lane); return; }


    if (EN(9)) if (sub == 10) { REP(9) phase_post(p, l, gw, nw, lane); return; }
}

__global__ __launch_bounds__(512, 2) void mega(Params p) {
    extern __shared__ __attribute__((aligned(16))) unsigned char shm[];
    __shared__ uint4 xb_words;
    if (threadIdx.x == 0) xb_words = make_uint4(0u, 0u, 0u, 0u);
    __syncthreads();
    const XcdBarrier xb = xcd_barrier_post((unsigned*)(p.ws + OFF_BAR), (volatile LAS unsigned*)&xb_words);
#ifndef PROBE_DUP
    for (int ph = p.p0; ph < p.p1; ++ph) {
        if (ph == 1 || ph == 9 || ph == 10 || ph == 23 || ph == 24) continue;
        int tid = threadIdx.x; asm volatile("" : "+v"(tid));
        Params q = p;
#if defined(__HIP_DEVICE_COMPILE__)
        {
            typedef __attribute__((address_space(1))) unsigned char GUC; typedef __attribute__((address_space(1))) float GF; typedef __attribute__((address_space(1))) const float GCF;
            unsigned long long wsi = (unsigned long long)p.ws, oi = (unsigned long long)p.out; asm volatile("" : "+s"(wsi), "+s"(oi));
            q.ws = (unsigned char*)(GUC*)wsi; q.out = (float*)(GF*)oi;
#pragma unroll
            for (int ii = 0; ii < 18; ++ii) q.in[ii] = (const float*)(GCF*)(unsigned long long)p.in[ii];
        }
#endif
        run_phase(q, ph, shm, tid);
        if (ph + 1 < p.p1) {
            if (ph == 0) cg::this_grid().sync();
            else xcd_barrier(xb);
        }
    }
#else
    for (int st = 0; st < 2 * NPHASE; ++st) {
        const int ph = st >> 1;
        if (ph == 1 || ph == 9 || ph == 10 || ph == 23 || ph == 24) continue;
        const int subp = (ph >= 1 && ph <= 28) ? (ph - 1) % 14 : (ph == 0 ? 14 : 15);
        if ((st & 1) && !((PROBE_DUP >> subp) & 1)) continue;
        int tid = threadIdx.x; asm volatile("" : "+v"(tid));
        Params q = p; asm volatile("" : "+s"(q.ws), "+s"(q.out));
        run_phase(q, ph, shm, tid);
        cg::this_grid().sync();
    }
#endif
}

extern "C" void kernel_launch(void* const* d_in, const int* in_sizes, int n_in, void* d_out, int out_size, void* d_ws, size_t ws_size, hipStream_t stream) {
    static int grid = 0;
    if (!grid) {
        hipFuncSetAttribute((const void*)mega, hipFuncAttributeMaxDynamicSharedMemorySize, LDS_BYTES);
        int dev = 0, cus = 0, per = 0;
        hipGetDevice(&dev);
        hipDeviceGetAttribute(&cus, hipDeviceAttributeMultiprocessorCount, dev);
        hipOccupancyMaxActiveBlocksPerMultiprocessor(&per, mega, 512, LDS_BYTES);
        if (per < 1) per = 1;
        grid = cus * per;
        if (grid > 256) grid = 256;
    }
    (void)hipMemsetAsync((unsigned char*)d_ws + OFF_BAR, 0, 3456 * 4, stream);
    Params p{};
    for (int i = 0; i < 18; ++i) p.in[i] = (const float*)d_in[i];
    p.out = (float*)d_out; p.ws = (unsigned char*)d_ws;
#if MULTI
    for (int ph = 0; ph < NPHASE; ++ph) {
        if (ph == 1 || ph == 9 || ph == 10 || ph == 23 || ph == 24) continue;
        p.p0 = ph; p.p1 = ph + 1;
        hipLaunchKernelGGL(mega, dim3(grid), dim3(512), LDS_BYTES, stream, p);
    }
#else
    p.p0 = 0; p.p1 = NPHASE;
    void* args[] = {&p};
    hipError_t e = hipLaunchCooperativeKernel((const void*)mega, dim3(grid), dim3(512), args, LDS_BYTES, stream);
    if (e != hipSuccess) fprintf(stderr, "cooperative launch failed: %s (grid %d)\n", hipGetErrorString(e), grid);
#endif
}
```

```cpp
#include <hip/hip_runtime.h>
#include <hip/hip_cooperative_groups.h>
#include <cstdio>
namespace cg = cooperative_groups;


#ifndef REPMASK
#define REPMASK 0
#endif
#define REP(k) for (int rep_ = 0; rep_ < (((REPMASK >> (k)) & 1) ? 2 : 1); ++rep_)
#ifndef MULTI
#define MULTI 0
#endif

#ifdef ONLY
#define EN(k) (ONLY==(k))
#else
#define EN(k) 1
#endif
#define DI __device__ __forceinline__
#define LAS __attribute__((address_space(3)))
typedef unsigned short bf16_t;
typedef short bf16x8 __attribute__((ext_vector_type(8)));
typedef short s16x4 __attribute__((ext_vector_type(4)));
typedef float f32x4 __attribute__((ext_vector_type(4)));
typedef float f32x16 __attribute__((ext_vector_type(16)));
typedef float f32x2 __attribute__((ext_vector_type(2)));
typedef unsigned u32x4 __attribute__((ext_vector_type(4)));
typedef unsigned u32x2 __attribute__((ext_vector_type(2)));
typedef __bf16 bf16v2 __attribute__((ext_vector_type(2)));

constexpr int DM = 1024, NBATCH = 4, SEQ = 8192, MTOK = NBATCH * SEQ, DFF = 2752, DFFP = 2816, NFF = 2 * DFFP, NMIX = 3072;
constexpr int LDAB = 1792, LDC = 1280;
constexpr float EPS = 1e-6f, LOG2E = 1.4426950408889634f;
constexpr int LDS_BYTES = 131072;

constexpr size_t SZ_W_FFNIN = (size_t)NFF * DM * 2, SZ_W_FFNOUT = (size_t)DM * DFFP * 2, SZ_W_MIXIN = (size_t)NMIX * DM * 2, SZ_W_MIXOUT = (size_t)DM * DM * 2;
constexpr size_t OFF_W_FFN1IN = 0;
constexpr size_t OFF_W_FFN1OUT = OFF_W_FFN1IN + SZ_W_FFNIN;
constexpr size_t OFF_W_MIXIN = OFF_W_FFN1OUT + SZ_W_FFNOUT;
constexpr size_t OFF_W_MIXOUT = OFF_W_MIXIN + SZ_W_MIXIN;
constexpr size_t OFF_W_FFN2IN = OFF_W_MIXOUT + SZ_W_MIXOUT;
constexpr size_t OFF_W_FFN2OUT = OFF_W_FFN2IN + SZ_W_FFNIN;
constexpr size_t OFF_XB = OFF_W_FFN2OUT + SZ_W_FFNOUT;
constexpr size_t SZ_TILE = (size_t)3072 * 4096 * 2;
constexpr size_t OFF_QC = OFF_XB, OFF_KTC = OFF_XB + SZ_TILE;
constexpr size_t OFF_OB = OFF_XB + (size_t)MTOK * DM * 2;
constexpr size_t OFF_BIG = OFF_OB + (size_t)MTOK * DM * 2;
constexpr size_t OFF_PAB = OFF_BIG, OFF_PC = OFF_BIG + (size_t)MTOK * LDAB * 2;
constexpr size_t OFF_U = OFF_PC, OFF_WB = OFF_PC + (size_t)6144 * 8192;
constexpr size_t OFF_BG = OFF_WB + (size_t)6144 * 8192;
constexpr size_t OFF_RSS = OFF_BG + (size_t)MTOK * 24 * 4;
constexpr size_t OFF_VT = OFF_RSS + (size_t)2 * MTOK * 16 * 4;
constexpr size_t OFF_KC = OFF_VT + (size_t)NBATCH * 6 * 64 * SEQ * 2;
constexpr size_t OFF_VTC = OFF_KC + SZ_TILE;
constexpr size_t OFF_SST = OFF_KC;
constexpr size_t OFF_QK = OFF_VTC + SZ_TILE;
constexpr size_t OFF_GC = OFF_QK + (size_t)6144 * 8192;
constexpr size_t OFF_MISC = OFF_GC + (size_t)6144 * 64 * 4;
constexpr size_t OFF_BAR = OFF_MISC + 512;
constexpr size_t WS_TOTAL = OFF_BAR + 3456 * 4;
static_assert(WS_TOTAL <= (size_t)536870912, "workspace too large");
static_assert((size_t)MTOK * DFFP * 2 <= OFF_BG - OFF_BIG, "hidden does not fit");

struct Params {
    const float* in[18];
    float* out;
    unsigned char* ws;
    int p0, p1;
};

DI unsigned pk2(float a, float b) { f32x2 v = {a, b}; bf16v2 r = __builtin_convertvector(v, bf16v2); return __builtin_bit_cast(unsigned, r); }
DI bf16_t f2bf(float a) { return (bf16_t)(pk2(a, 0.f) & 0xffffu); }
DI float bf2f(bf16_t v) { return __uint_as_float(((unsigned)v) << 16); }
DI float bflo(unsigned v) { return __uint_as_float(v << 16); }
DI float bfhi(unsigned v) { return __uint_as_float(v & 0xffff0000u); }
DI float wave_sum(float v) {
    v += __builtin_bit_cast(float, __builtin_amdgcn_update_dpp(0, __builtin_bit_cast(int, v), 0xB1, 0xf, 0xf, true));
    v += __builtin_bit_cast(float, __builtin_amdgcn_update_dpp(0, __builtin_bit_cast(int, v), 0x4E, 0xf, 0xf, true));
    v += __builtin_bit_cast(float, __builtin_amdgcn_update_dpp(0, __builtin_bit_cast(int, v), 0x141, 0xf, 0xf, true));
    v += __builtin_bit_cast(float, __builtin_amdgcn_update_dpp(0, __builtin_bit_cast(int, v), 0x140, 0xf, 0xf, true));
    const int iv = __builtin_bit_cast(int, v);
    const float a = __builtin_bit_cast(float, __builtin_amdgcn_readlane(iv, 0)), b = __builtin_bit_cast(float, __builtin_amdgcn_readlane(iv, 16));
    const float c = __builtin_bit_cast(float, __builtin_amdgcn_readlane(iv, 32)), d = __builtin_bit_cast(float, __builtin_amdgcn_readlane(iv, 48));
    return (a + b) + (c + d);
}
DI bf16x8 ld2x8(const bf16_t* a, const bf16_t* b) { u32x2 x = *(const u32x2*)a, y = *(const u32x2*)b; u32x4 r = {x.x, x.y, y.x, y.y}; return __builtin_bit_cast(bf16x8, r); }
DI unsigned rot16(unsigned x) { return (x >> 16) | (x << 16); }
DI bf16x8 ld2x8rev(const bf16_t* a, const bf16_t* b) {
    u32x2 x = *(const u32x2*)a, y = *(const u32x2*)b; u32x4 r = {rot16(x.y), rot16(x.x), rot16(y.y), rot16(y.x)}; return __builtin_bit_cast(bf16x8, r);
}
DI bf16x8 pack8(f32x4 a, f32x4 b) { u32x4 r = {pk2(a[0], a[1]), pk2(a[2], a[3]), pk2(b[0], b[1]), pk2(b[2], b[3])}; return __builtin_bit_cast(bf16x8, r); }
DI float fexp2(float x) { return __builtin_amdgcn_exp2f(x); }
DI float fexp(float x) { return __builtin_amdgcn_exp2f(x * LOG2E); }
DI float silu(float x) { return x * __builtin_amdgcn_rcpf(1.f + fexp(-x)); }
DI float row_rstd(const float* rp, int row) {
    const f32x4 a = *(const f32x4*)(rp + (size_t)row * 16), b = *(const f32x4*)(rp + (size_t)row * 16 + 4), c = *(const f32x4*)(rp + (size_t)row * 16 + 8), d = *(const f32x4*)(rp + (size_t)row * 16 + 12);
    const float s = ((a[0] + a[1]) + (a[2] + a[3])) + ((b[0] + b[1]) + (b[2] + b[3])) + ((c[0] + c[1]) + (c[2] + c[3])) + ((d[0] + d[1]) + (d[2] + d[3]));
    return __builtin_amdgcn_rsqf(s * (1.f / DM) + EPS);
}
#define MFMA16(a, b, c) __builtin_amdgcn_mfma_f32_16x16x32_bf16((a), (b), (c), 0, 0, 0)
#define MFMA32(a, b, c) __builtin_amdgcn_mfma_f32_32x32x16_bf16((a), (b), (c), 0, 0, 0)

namespace pg8 {
constexpr int BM = 256, BK = 64, HALF = 128, HTB = HALF * BK * 2, STAGE_BYTES = 8 * HTB, NXCD = 8, WGM = 8;
DI int lds_byte(int r, int c) { const int st = (r >> 4) * 2 + (c >> 5), rr = r & 15, cc = c & 31, ob = rr * 64 + cc * 2; return st * 1024 + (ob ^ (((ob >> 9) & 1) << 5)); }
DI void stage_rc(int b, int& R, int& C) { const int st = b / 1024, sb = b % 1024, swz = sb ^ (((sb >> 9) & 1) << 5); R = (st >> 1) * 16 + swz / 64; C = (st & 1) * 32 + (swz % 64) / 2; }
DI int perm32(int rho) { const int n = rho >> 4, i = rho & 15; return 8 * (i >> 2) + 4 * n + (i & 3); }
struct Unit { int pm, pn; };
struct Gemm { const bf16_t* A; const bf16_t* Bt; int M, N, K; };
struct StaticOrder {
    int nM, nN, nwg, G, c;
    DI void init(int M, int N, int G_, int c_) { nM = M / BM; nN = N / BM; nwg = nM * nN; G = G_; c = c_; }
    DI bool next(int i, Unit& u) const {
        const long L = (long)i * G + c; if (L >= nwg) return false;
        int wgid = (int)L; { const int q = nwg / NXCD, r = nwg % NXCD, xcd = wgid % NXCD, off = wgid / NXCD; wgid = (xcd < r ? xcd * (q + 1) : r * (q + 1) + (xcd - r) * q) + off; }
        const int nig = WGM * nN, gid = wgid / nig, fm = gid * WGM, gsz = (nM - fm) < WGM ? (nM - fm) : WGM;
        u.pm = fm + ((wgid % nig) % gsz); u.pn = (wgid % nig) / gsz; return true;
    }
};
template <class Epi>
DI void gemm_phase(int tid, LAS unsigned char* lds, const Gemm g, const StaticOrder& S, const Epi& E) {
    const int wid = __builtin_amdgcn_readfirstlane(tid >> 6), lane = tid & 63, wr = wid >> 2, wc = wid & 3, fr = lane & 15, fq = lane >> 4;
    const int K = g.K, nt = K / BK;
    unsigned voffA[2], voffB[2];
#pragma unroll
    for (int i = 0; i < 2; ++i) { int R, C; stage_rc(tid * 16 + i * 8192, R, C); const int Rb = (R & ~31) + perm32(R & 31);
        voffA[i] = (unsigned)(R * K + C) * 2u; voffB[i] = (unsigned)(Rb * K + C) * 2u; }
    const size_t kstep = (size_t)(BK * 2);
    const size_t hstep = (size_t)HALF * K * 2;
    const size_t tstep = 2 * hstep;
    const unsigned ldsw = (unsigned)wid * 1024u;
    const int aoff = lds_byte(wr * 64 + fr, fq * 8), boff = lds_byte(wc * 32 + fr, fq * 8);
#define PG8_SA(b, h) (((b) * 2 + (h)) * HTB)
#define PG8_SB(b, h) ((4 + (b) * 2 + (h)) * HTB)
#define PG8_STAGE(bufoff, gbase, voff) do { _Pragma("unroll") for (int _i = 0; _i < 2; ++_i) \
        __builtin_amdgcn_global_load_lds((const unsigned*)((const char*)(gbase) + (voff)[_i]), (LAS unsigned*)(lds + (bufoff) + ldsw + _i * 8192), 16, 0, 0); } while (0)
#define PG8_LDA(dst, b, h) do { _Pragma("unroll") for (int m = 0; m < 4; ++m) _Pragma("unroll") for (int k = 0; k < 2; ++k) dst[m][k] = *(const LAS bf16x8*)(lds + PG8_SA(b, h) + aoff + m * 2048 + k * 1024); } while (0)
#define PG8_LDB(dst, b, h) do { _Pragma("unroll") for (int n = 0; n < 2; ++n) _Pragma("unroll") for (int k = 0; k < 2; ++k) dst[n][k] = *(const LAS bf16x8*)(lds + PG8_SB(b, h) + boff + n * 2048 + k * 1024); } while (0)
#define PG8_MMA(ai, bj, At, Bt) do { __builtin_amdgcn_s_setprio(1); _Pragma("unroll") for (int m = 0; m < 4; ++m) _Pragma("unroll") for (int n = 0; n < 2; ++n) _Pragma("unroll") for (int k = 0; k < 2; ++k) \
        acc[ai][bj][m][n] = __builtin_amdgcn_mfma_f32_16x16x32_bf16(Bt[n][k], At[m][k], acc[ai][bj][m][n], 0, 0, 0); __builtin_amdgcn_s_setprio(0); } while (0)
#define PG8_WAIT_V(n) asm volatile("s_waitcnt vmcnt(" #n ")" ::: "memory")
#define PG8_WAIT_L(n) asm volatile("s_waitcnt lgkmcnt(" #n ")" ::: "memory")
#define PG8_BAR __builtin_amdgcn_s_barrier()
#define PG8_SCHED __builtin_amdgcn_sched_barrier(0)
    Unit cur, nxt; int ui = 0;
    if (!S.next(0, cur)) return;
    f32x4 acc[2][2][4][2];
#pragma unroll
    for (int a = 0; a < 2; ++a)
#pragma unroll
        for (int b = 0; b < 2; ++b)
#pragma unroll
            for (int m = 0; m < 4; ++m)
#pragma unroll
                for (int n = 0; n < 2; ++n) acc[a][b][m][n] = (f32x4){0.f, 0.f, 0.f, 0.f};
    bf16x8 At[4][2], B0[2][2], B1[2][2];
    const char* cA = (const char*)g.A + (size_t)cur.pm * tstep; const char* cB = (const char*)g.Bt + (size_t)cur.pn * tstep;
    PG8_STAGE(PG8_SB(0, 0), cB, voffB); PG8_STAGE(PG8_SA(0, 0), cA, voffA); PG8_STAGE(PG8_SB(0, 1), cB + hstep, voffB); PG8_STAGE(PG8_SA(0, 1), cA + hstep, voffA);
    if (wr == 1) PG8_BAR;
    PG8_WAIT_V(4); PG8_BAR;
    PG8_STAGE(PG8_SB(1, 0), cB + kstep, voffB); PG8_STAGE(PG8_SA(1, 0), cA + kstep, voffA); PG8_STAGE(PG8_SB(1, 1), cB + hstep + kstep, voffB);
    PG8_WAIT_V(6); PG8_BAR;
    for (;;) {
        const bool has_next = S.next(ui + 1, nxt);
        const char* nA = has_next ? (const char*)g.A + (size_t)nxt.pm * tstep : cA; const char* nB = has_next ? (const char*)g.Bt + (size_t)nxt.pn * tstep : cB;
        for (int t = 0; t < nt; t += 2) {
            const bool last = (t == nt - 2);
            const char* a1 = cA + (size_t)(t + 1) * kstep;
            const char* a2 = last ? nA : cA + (size_t)(t + 2) * kstep; const char* b2 = last ? nB : cB + (size_t)(t + 2) * kstep;
            const char* a3 = a2 + kstep; const char* b3 = b2 + kstep;
            PG8_LDB(B0, 0, 0); PG8_SCHED; PG8_LDA(At, 0, 0); PG8_STAGE(PG8_SA(1, 1), a1 + hstep, voffA);
            PG8_WAIT_L(8); PG8_BAR; PG8_WAIT_L(0); PG8_MMA(0, 0, At, B0); PG8_BAR; PG8_SCHED;
            PG8_LDB(B1, 0, 1); PG8_STAGE(PG8_SB(0, 0), b2, voffB);
            PG8_BAR; PG8_WAIT_L(0); PG8_MMA(0, 1, At, B1); PG8_BAR;
            PG8_LDA(At, 0, 1); PG8_STAGE(PG8_SA(0, 0), a2, voffA);
            PG8_BAR; PG8_WAIT_L(0); PG8_MMA(1, 0, At, B0); PG8_BAR; PG8_SCHED;
            PG8_STAGE(PG8_SB(0, 1), b2 + hstep, voffB);
            PG8_WAIT_V(6); PG8_BAR; PG8_MMA(1, 1, At, B1); PG8_BAR;
            PG8_LDB(B0, 1, 0); PG8_SCHED; PG8_LDA(At, 1, 0); PG8_STAGE(PG8_SA(0, 1), a2 + hstep, voffA);
            PG8_WAIT_L(8); PG8_BAR; PG8_WAIT_L(0); PG8_MMA(0, 0, At, B0); PG8_BAR; PG8_SCHED;
            PG8_LDB(B1, 1, 1); PG8_STAGE(PG8_SB(1, 0), b3, voffB);
            PG8_BAR; PG8_WAIT_L(0); PG8_MMA(0, 1, At, B1); PG8_BAR;
            PG8_LDA(At, 1, 1); PG8_STAGE(PG8_SA(1, 0), a3, voffA);
            PG8_BAR; PG8_WAIT_L(0); PG8_MMA(1, 0, At, B0); PG8_BAR; PG8_SCHED;
            PG8_STAGE(PG8_SB(1, 1), b3 + hstep, voffB);
            PG8_WAIT_V(6); PG8_BAR; PG8_MMA(1, 1, At, B1); PG8_BAR;
        }
        E(acc, cur, wr, wc, fr, fq);
        if (!has_next) break;
#pragma unroll
        for (int a = 0; a < 2; ++a)
#pragma unroll
            for (int b = 0; b < 2; ++b)
#pragma unroll
                for (int m = 0; m < 4; ++m)
#pragma unroll
                    for (int n = 0; n < 2; ++n) acc[a][b][m][n] = (f32x4){0.f, 0.f, 0.f, 0.f};
        cur = nxt; cA = nA; cB = nB; ++ui;
    }
    PG8_WAIT_V(0);
    if (wr == 0) PG8_BAR;
    PG8_BAR;
#undef PG8_SA
#undef PG8_SB
#undef PG8_STAGE
#undef PG8_LDA
#undef PG8_LDB
#undef PG8_MMA
#undef PG8_WAIT_V
#undef PG8_WAIT_L
#undef PG8_BAR
#undef PG8_SCHED
}
}
using pg8::Unit;
typedef f32x4 AccT[2][2][4][2];

struct EpiSwiglu {
    bf16_t* H; const float* rss;
    DI void operator()(const AccT& acc, const Unit& u, int wr, int wc, int fr, int fq) const {
        const int row0 = u.pm * 256 + wr * 64 + fr, col0 = u.pn * 128 + wc * 32 + 8 * fq;
#pragma unroll
        for (int ai = 0; ai < 2; ++ai)
#pragma unroll
            for (int m = 0; m < 4; ++m) {
                const int row = row0 + ai * 128 + m * 16;
                const float rstd = row_rstd(rss, row);
                float hv[8];
#pragma unroll
                for (int n = 0; n < 2; ++n)
#pragma unroll
                    for (int j = 0; j < 4; ++j) { const float gg = acc[ai][0][m][n][j] * rstd, uu = acc[ai][1][m][n][j] * rstd; hv[4 * n + j] = silu(gg) * uu; }
                u32x4 w = {pk2(hv[0], hv[1]), pk2(hv[2], hv[3]), pk2(hv[4], hv[5]), pk2(hv[6], hv[7])};
                *(u32x4*)(H + (size_t)row * DFFP + col0) = w;
            }
    }
};
struct EpiResid {
    const float* Xin; float* X; bf16_t* XB; float* rssn; float scale;
    DI void operator()(const AccT& acc, const Unit& u, int wr, int wc, int fr, int fq) const {
        const int row0 = u.pm * 256 + wr * 64 + fr, col0 = u.pn * 256 + wc * 32 + 8 * fq;
#pragma unroll
        for (int ai = 0; ai < 2; ++ai)
#pragma unroll
            for (int m = 0; m < 4; ++m) {
                const int row = row0 + ai * 128 + m * 16; float ss = 0.f;
#pragma unroll
                for (int bj = 0; bj < 2; ++bj) {
                    float* xp = X + (size_t)row * DM + col0 + bj * 128; const float* xi = Xin + (size_t)row * DM + col0 + bj * 128;
                    f32x4 x0 = *(const f32x4*)xi, x1 = *(const f32x4*)(xi + 4);
                    x0 += acc[ai][bj][m][0] * scale; x1 += acc[ai][bj][m][1] * scale;
                    *(f32x4*)xp = x0; *(f32x4*)(xp + 4) = x1;
                    u32x4 w = {pk2(x0[0], x0[1]), pk2(x0[2], x0[3]), pk2(x1[0], x1[1]), pk2(x1[2], x1[3])};
                    *(u32x4*)(XB + (size_t)row * DM + col0 + bj * 128) = w;
#pragma unroll
                    for (int j = 0; j < 4; ++j) ss += x0[j] * x0[j] + x1[j] * x1[j];
                }
                ss += __shfl_xor(ss, 16); ss += __shfl_xor(ss, 32);
                if (fq == 0) rssn[(size_t)row * 16 + u.pn * 4 + wc] = ss;
            }
    }
};
struct EpiMixIn {
    bf16_t* PAB; bf16_t* PC; float* BG; const float* rss;
    DI void operator()(const AccT& acc, const Unit& u, int wr, int wc, int fr, int fq) const {
        const int row0 = u.pm * 256 + wr * 64 + fr;
        bf16_t* base; int ld, ct;
        if (u.pn < 7) { base = PAB; ld = LDAB; ct = u.pn * 256; } else { base = PC; ld = LDC; ct = (u.pn - 7) * 256; }
        const int col0 = ct + wc * 32 + 8 * fq;
        const bool isbg = (u.pn == 11) && (wc == 0) && (fq < 3);
#pragma unroll
        for (int ai = 0; ai < 2; ++ai)
#pragma unroll
            for (int m = 0; m < 4; ++m) {
                const int row = row0 + ai * 128 + m * 16;
                const float rstd = row_rstd(rss, row);
#pragma unroll
                for (int bj = 0; bj < 2; ++bj) {
                    const f32x4 v0 = acc[ai][bj][m][0] * rstd, v1 = acc[ai][bj][m][1] * rstd;
                    u32x4 w = {pk2(v0[0], v0[1]), pk2(v0[2], v0[3]), pk2(v1[0], v1[1]), pk2(v1[2], v1[3])};
                    *(u32x4*)(base + (size_t)row * ld + col0 + bj * 128) = w;
                    if (bj == 1 && isbg) { float* bp = BG + (size_t)row * 24 + 8 * fq; *(f32x4*)bp = v0; *(f32x4*)(bp + 4) = v1; }
                }
            }
    }
};

DI int map_src(int kind, int n) {
    if (kind == 0) return n;
    if (kind == 1) { const int pn = n >> 8, bj = (n >> 7) & 1, i = n & 127; const int hid = pn * 128 + i; return hid < DFF ? hid + bj * DFF : -1; }
    if (n < 1408) return n;
    if (n < 1792) return 2560 + (n - 1408);
    if (n < 2944) return 1408 + (n - 1792);
    if (n < 2968) return n;
    return -1;
}
DI void conv_w(const float* __restrict__ W, int ldw, int Kreal, bf16_t* __restrict__ Bt, int Np, int Kp, const float* __restrict__ gain, int kind, float* tile, int tid) {
    const int tnn = Np >> 8, ntile = tnn * (Kp >> 6);
    for (int t = blockIdx.x; t < ntile; t += gridDim.x) {
        const int n0 = (t % tnn) << 8, k0 = (t / tnn) << 6;
        {
            const int tn = tid & 255, tk = tid >> 8; const int src = map_src(kind, n0 + tn);
            float v[32];
#pragma unroll
            for (int r = 0; r < 32; ++r) { const int k = k0 + tk + 2 * r; v[r] = 0.f;
                if (src >= 0 && k < Kreal) { v[r] = W[(size_t)k * ldw + src]; if (gain) v[r] *= gain[k]; } }
#pragma unroll
            for (int r = 0; r < 32; ++r) tile[(tk + 2 * r) * 257 + tn] = v[r];
        }
        __syncthreads();
#pragma unroll
        for (int i = 0; i < 4; ++i) {
            const int id = tid + i * 512; const int rn = id >> 3, kk = (id & 7) * 8; float a[8];
#pragma unroll
            for (int j = 0; j < 8; ++j) a[j] = tile[(kk + j) * 257 + rn];
            u32x4 w = {pk2(a[0], a[1]), pk2(a[2], a[3]), pk2(a[4], a[5]), pk2(a[6], a[7])};
            *(u32x4*)(Bt + (size_t)(n0 + rn) * Kp + k0 + kk) = w;
        }
        __syncthreads();
    }
}
DI void phase_convw(const Params& p, int l, unsigned char* shm, int tid) {
    float* tile = (float*)shm; unsigned char* ws = p.ws;
    conv_w(p.in[2] + (size_t)l * DM * 2 * DFF, 2 * DFF, DM, (bf16_t*)(ws + OFF_W_FFN1IN), NFF, DM, p.in[1] + l * DM, 1, tile, tid);
    conv_w(p.in[3] + (size_t)l * DFF * DM, DM, DFF, (bf16_t*)(ws + OFF_W_FFN1OUT), DM, DFFP, nullptr, 0, tile, tid);
    conv_w(p.in[5] + (size_t)l * DM * 2968, 2968, DM, (bf16_t*)(ws + OFF_W_MIXIN), NMIX, DM, p.in[4] + l * DM, 2, tile, tid);
    conv_w(p.in[13] + (size_t)l * DM * DM, DM, DM, (bf16_t*)(ws + OFF_W_MIXOUT), DM, DM, nullptr, 0, tile, tid);
    conv_w(p.in[15] + (size_t)l * DM * 2 * DFF, 2 * DFF, DM, (bf16_t*)(ws + OFF_W_FFN2IN), NFF, DM, p.in[14] + l * DM, 1, tile, tid);
    conv_w(p.in[16] + (size_t)l * DFF * DM, DM, DFF, (bf16_t*)(ws + OFF_W_FFN2OUT), DM, DFFP, nullptr, 0, tile, tid);
}

DI void phase_init(const Params& p, int gw, int nw, int lane) {
    const float* x = p.in[0]; float* X = p.out; bf16_t* XB = (bf16_t*)(p.ws + OFF_XB); float* rss = (float*)(p.ws + OFF_RSS);
    for (int row0 = gw * 4; row0 < MTOK; row0 += nw * 4) {
        f32x4 v[4][4];
#pragma unroll
        for (int r = 0; r < 4; ++r)
#pragma unroll
            for (int i = 0; i < 4; ++i) v[r][i] = *(const f32x4*)(x + (size_t)(row0 + r) * DM + i * 256 + lane * 4);
#pragma unroll
        for (int r = 0; r < 4; ++r) {
            float ss = 0.f;
#pragma unroll
            for (int i = 0; i < 4; ++i) {
                const size_t o = (size_t)(row0 + r) * DM + i * 256 + lane * 4;
                u32x2 w = {pk2(v[r][i][0], v[r][i][1]), pk2(v[r][i][2], v[r][i][3])}; *(u32x2*)(XB + o) = w;
                ss += v[r][i][0] * v[r][i][0] + v[r][i][1] * v[r][i][1] + v[r][i][2] * v[r][i][2] + v[r][i][3] * v[r][i][3];
            }
            ss = wave_sum(ss); if (lane < 16) rss[(size_t)(row0 + r) * 16 + lane] = lane == 0 ? ss : 0.f;
        }
    }
    if (gw == 0) { unsigned* misc = (unsigned*)(p.ws + OFF_MISC); misc[lane] = 0u; misc[64 + lane] = 0u; }
}
DI void phase_final(const Params& p, int gw, int nw, int lane) {
    float* X = p.out; const float* rss = (const float*)(p.ws + OFF_RSS); const float* g = p.in[17];
    for (int row0 = gw * 4; row0 < MTOK; row0 += nw * 4) {
        f32x4 v[4][4]; float rstd[4];
#pragma unroll
        for (int r = 0; r < 4; ++r) {
            rstd[r] = row_rstd(rss, row0 + r);
#pragma unroll
            for (int i = 0; i < 4; ++i) v[r][i] = *(const f32x4*)(X + (size_t)(row0 + r) * DM + i * 256 + lane * 4);
        }
#pragma unroll
        for (int r = 0; r < 4; ++r)
#pragma unroll
            for (int i = 0; i < 4; ++i) {
                const int c = i * 256 + lane * 4; const f32x4 gv = *(const f32x4*)(g + c);
                *(f32x4*)(X + (size_t)(row0 + r) * DM + c) = v[r][i] * rstd[r] * gv;
            }
    }
}

DI void store_row64(bf16_t* dst, const float (&val)[64]) {
#pragma unroll
    for (int i = 0; i < 8; ++i) { u32x4 w = {pk2(val[8 * i], val[8 * i + 1]), pk2(val[8 * i + 2], val[8 * i + 3]), pk2(val[8 * i + 4], val[8 * i + 5]), pk2(val[8 * i + 6], val[8 * i + 7])};
        *(u32x4*)(dst + 8 * i) = w; }
}
DI void phase_prep(const Params& p, int l, int gw, int nw, int lane0) {
    unsigned char* ws = p.ws;
    const bf16_t* PAB = (const bf16_t*)(ws + OFF_PAB); const bf16_t* PC = (const bf16_t*)(ws + OFF_PC);
    bf16_t* QC = (bf16_t*)(ws + OFF_QC); bf16_t* KC = (bf16_t*)(ws + OFF_KC); bf16_t* KTC = (bf16_t*)(ws + OFF_KTC); bf16_t* VTC = (bf16_t*)(ws + OFF_VTC);
    bf16_t* VT = (bf16_t*)(ws + OFF_VT);
    const float* cw = p.in[6] + (size_t)l * 5 * 1152;
    for (int u = gw; u < 512 * 25; u += nw) {
        int lane = lane0; asm volatile("" : "+v"(lane));
        const int grp = u % 25, ck = u / 25, b = ck >> 7, chunk = ck & 127;
        if (grp == 24) {
            const bf16_t* kr = PAB + ((size_t)b * SEQ + chunk * 64 + lane) * LDAB + 896;
            unsigned* kmx = (unsigned*)(ws + OFF_MISC) + l * 32 + b * 8;
#pragma unroll
            for (int hm = 0; hm < 8; ++hm) {
                float ss = 0.f;
#pragma unroll
                for (int c4 = 0; c4 < 4; ++c4) { const u32x4 v = *(const u32x4*)(kr + hm * 32 + c4 * 8);
#pragma unroll
                    for (int e = 0; e < 4; ++e) { const float a = bflo(v[e]), bb = bfhi(v[e]); ss += a * a + bb * bb; } }
#pragma unroll
                for (int o = 32; o > 0; o >>= 1) ss = fmaxf(ss, __shfl_xor(ss, o));
                if (lane == 0) atomicMax(kmx + hm, __float_as_uint(ss));
            }
            continue;
        }
        float val[64];
        if (grp < 18) {
            const int type = grp / 6, h = grp % 6, col = type * 384 + h * 64 + lane;
            const float w0 = cw[col], w1 = cw[1152 + col], w2 = cw[2 * 1152 + col], w3 = cw[3 * 1152 + col], w4 = cw[4 * 1152 + col];
            float xv[68];
#pragma unroll
            for (int i = 0; i < 68; ++i) { const int pos = chunk * 64 - 2 + i;
                xv[i] = (pos >= 0 && pos < SEQ) ? bf2f(PC[((size_t)b * SEQ + pos) * LDC + col]) : 0.f; }
#pragma unroll
            for (int t = 0; t < 64; ++t) { const float v = w0 * xv[t] + w1 * xv[t + 1] + w2 * xv[t + 2] + w3 * xv[t + 3] + w4 * xv[t + 4]; val[t] = silu(v); }
            if (type < 2) {
                const float sc = type == 0 ? 0.125f : 1.f;
#pragma unroll
                for (int t = 0; t < 64; ++t) { const float ss = wave_sum(val[t] * val[t]); val[t] *= __builtin_amdgcn_rsqf(ss + EPS) * sc; }
            }
            const size_t tb = ((size_t)(b * 6 + h) * 128 + chunk) * 4096;
            if (type == 0) {
#pragma unroll
                for (int t = 0; t < 64; ++t) QC[tb + t * 64 + lane] = f2bf(val[t]);
            } else if (type == 1) {
#pragma unroll
                for (int t = 0; t < 64; ++t) KC[tb + t * 64 + lane] = f2bf(val[t]);
                store_row64(KTC + tb + lane * 64, val);
            } else {
                store_row64(VTC + tb + lane * 64, val);
            }
        } else {
            const int vh = grp - 18; const int col = (vh < 2 ? 512 + vh * 64 : 1152 + (vh - 2) * 64) + lane;
            const size_t tok0 = (size_t)b * SEQ + chunk * 64;
#pragma unroll
            for (int t = 0; t < 64; ++t) val[t] = bf2f(PAB[(tok0 + t) * LDAB + col]);
            store_row64(VT + ((size_t)(b * 6 + vh) * 64 + lane) * SEQ + chunk * 64, val);
        }
    }
}

DI void phase_chunk(const Params& p, int l, int gw, int nw, int lane0, int wid, unsigned char* shm) {
    unsigned char* ws = p.ws;
    float* Mf = (float*)(shm + wid * 16384); bf16_t* AB = (bf16_t*)Mf; bf16_t* ABG = AB + 4096;
    const bf16_t* QC = (const bf16_t*)(ws + OFF_QC); const bf16_t* KC = (const bf16_t*)(ws + OFF_KC);
    const bf16_t* KTC = (const bf16_t*)(ws + OFF_KTC); const bf16_t* VTC = (const bf16_t*)(ws + OFF_VTC);
    const float* BG = (const float*)(ws + OFF_BG);
    bf16_t* U = (bf16_t*)(ws + OFF_U); bf16_t* WB = (bf16_t*)(ws + OFF_WB); bf16_t* QK = (bf16_t*)(ws + OFF_QK); float* GC = (float*)(ws + OFF_GC);
    for (int it = gw; it < 6144; it += nw) {
        int lane = lane0; asm volatile("" : "+v"(lane));
        const int fr = lane & 15, q = lane >> 4;
        const int chunk = it & 127, seq = it >> 7, dir = seq & 1, bh = seq >> 1, b = bh / 6, h = bh % 6;
        const int pch = dir ? 127 - chunk : chunk;
        const size_t tb = ((size_t)bh * 128 + pch) * 4096;
        const int tkl = dir ? 63 - lane : lane;
        const size_t tok = (size_t)b * SEQ + pch * 64 + tkl;
        const float braw = BG[tok * 24 + dir * 6 + h], araw = BG[tok * 24 + 12 + dir * 6 + h];
        const float beta = 1.f / (1.f + expf(-braw));
        const float Aa = expf(p.in[10][l * 12 + dir * 6 + h]); const float xx = araw + p.in[11][l * 12 + dir * 6 + h];
        const float sp = fmaxf(xx, 0.f) + log1pf(expf(-fabsf(xx)));
        const float g = -Aa * sp;
        float gc = g;
#pragma unroll
        for (int o = 1; o < 64; o <<= 1) { const float t = __shfl_up(gc, o); if (lane >= o) gc += t; }
        GC[(size_t)it * 64 + lane] = gc;
        bf16x8 kf[4][2], qf[4][2];
#pragma unroll
        for (int m = 0; m < 4; ++m)
#pragma unroll
            for (int s = 0; s < 2; ++s) { const int row = 16 * m + fr; const int tr = dir ? 63 - row : row;
                kf[m][s] = *(const bf16x8*)(KC + tb + tr * 64 + 32 * s + 8 * q); qf[m][s] = *(const bf16x8*)(QC + tb + tr * 64 + 32 * s + 8 * q); }
#pragma unroll
        for (int m = 0; m < 4; ++m)
#pragma unroll
            for (int n = 0; n <= m; ++n) {
                f32x4 acc = {0.f, 0.f, 0.f, 0.f};
                acc = MFMA16(kf[m][0], kf[n][0], acc); acc = MFMA16(kf[m][1], kf[n][1], acc);
                const int s_ = 16 * n + fr; const float gcs = __shfl(gc, s_);
#pragma unroll
                for (int r = 0; r < 4; ++r) { const int c = 16 * m + 4 * q + r; const float gcc = __shfl(gc, c), bc = __shfl(beta, c);
                    Mf[c * 64 + s_] = (s_ < c) ? bc * acc[r] * fexp(gcc - gcs) : 0.f; }
                __builtin_amdgcn_sched_barrier(0);
            }
#pragma unroll
        for (int n = 0; n < 4; ++n)
#pragma unroll
            for (int m = 0; m < 4; ++m) {
                f32x4 v = {0.f, 0.f, 0.f, 0.f};
                const int c = 16 * n + fr;
                if (m <= n) {
                    f32x4 acc = {0.f, 0.f, 0.f, 0.f};
                    acc = MFMA16(kf[m][0], qf[n][0], acc); acc = MFMA16(kf[m][1], qf[n][1], acc);
                    const float gcc = __shfl(gc, c);
#pragma unroll
                    for (int r = 0; r < 4; ++r) { const int s_ = 16 * m + 4 * q + r; const float gcs = __shfl(gc, s_); v[r] = (s_ <= c) ? acc[r] * fexp(gcc - gcs) : 0.f; }
                }
                u32x2 w = {pk2(v[0], v[1]), pk2(v[2], v[3])};
                *(u32x2*)(QK + (size_t)it * 4096 + c * 64 + 16 * m + 4 * q) = w;
                __builtin_amdgcn_sched_barrier(0);
            }
        __builtin_amdgcn_sched_barrier(0);
        bf16x8 vfr[4][2], ktf[4][2];
#pragma unroll
        for (int n = 0; n < 4; ++n) {
            const bf16_t* vp = VTC + tb + (16 * n + fr) * 64 + 8 * q; vfr[n][0] = *(const bf16x8*)vp; vfr[n][1] = *(const bf16x8*)(vp + 32);
            const bf16_t* kp = KTC + tb + (16 * n + fr) * 64 + 8 * q; ktf[n][0] = *(const bf16x8*)kp; ktf[n][1] = *(const bf16x8*)(kp + 32);
        }
        float x[64];
#pragma unroll
        for (int i = 0; i < 64; ++i) {
            float a = (i == lane) ? 1.f : 0.f;
#pragma unroll
            for (int m = 0; m < i; ++m) a -= Mf[i * 64 + m] * x[m];
            x[i] = a;
            __builtin_amdgcn_sched_barrier(0);
        }
        {
            const float bj = beta, bgj = beta * fexp(gc);
#pragma unroll
            for (int i = 0; i < 64; ++i) { AB[i * 64 + tkl] = f2bf(x[i] * bj); ABG[i * 64 + tkl] = f2bf(x[i] * bgj); }
        }
        __builtin_amdgcn_sched_barrier(0);
#pragma unroll
        for (int m = 0; m < 4; ++m) {
            const bf16x8 a0 = *(const bf16x8*)(AB + (16 * m + fr) * 64 + 8 * q), a1 = *(const bf16x8*)(AB + (16 * m + fr) * 64 + 32 + 8 * q);
#pragma unroll
            for (int n = 0; n < 4; ++n) {
                const bf16x8 b0 = vfr[n][0], b1 = vfr[n][1];
                f32x4 acc = {0.f, 0.f, 0.f, 0.f};
                acc = MFMA16(a0, b0, acc); acc = MFMA16(a1, b1, acc);
                u32x2 w = {pk2(acc[0], acc[1]), pk2(acc[2], acc[3])};
                *(u32x2*)(U + (size_t)it * 4096 + (16 * n + fr) * 64 + 16 * m + 4 * q) = w;
            }
        }
        __builtin_amdgcn_sched_barrier(0);
#pragma unroll
        for (int n = 0; n < 4; ++n) {
            const bf16x8 b0 = *(const bf16x8*)(ABG + (16 * n + fr) * 64 + 8 * q), b1 = *(const bf16x8*)(ABG + (16 * n + fr) * 64 + 32 + 8 * q);
#pragma unroll
            for (int m = 0; m < 4; ++m) {
                const bf16x8 a0 = ktf[m][0], a1 = ktf[m][1];
                f32x4 acc = {0.f, 0.f, 0.f, 0.f};
                acc = MFMA16(a0, b0, acc); acc = MFMA16(a1, b1, acc);
                u32x2 w = {pk2(acc[0], acc[1]), pk2(acc[2], acc[3])};
                *(u32x2*)(WB + (size_t)it * 4096 + (16 * n + fr) * 64 + 16 * m + 4 * q) = w;
            }
        }
    }
}

constexpr int SCAN_SLOT = 25600;
DI void scan_issue(LAS unsigned char* slot, const bf16_t* WB, const bf16_t* U, const bf16_t* KTC, const float* GC, int seq, int bh, int dir, int lw, int i, int lane) {
    const int it = seq * 128 + i; const int pch = dir ? 127 - i : i;
    const bf16_t* Wp = WB + (size_t)it * 4096; const bf16_t* Kp = KTC + ((size_t)bh * 128 + pch) * 4096;
    const bf16_t* Up = U + (size_t)it * 4096 + (16 * lw) * 64; const float* gcp = GC + (size_t)it * 64;
    const int r8 = lane >> 3, c8 = lane & 7;
#pragma unroll
    for (int jj = 0; jj < 2; ++jj) {
        const int j = 2 * lw + jj;
        const int row = 8 * j + r8; const int cid = c8 ^ (row & 7);
        __builtin_amdgcn_global_load_lds((const unsigned*)(Wp + row * 64 + cid * 8), (LAS unsigned*)(slot + j * 1024), 16, 0, 0);
        __builtin_amdgcn_global_load_lds((const unsigned*)(Kp + row * 64 + cid * 8), (LAS unsigned*)(slot + 8192 + j * 1024), 16, 0, 0);
    }
#pragma unroll
    for (int j = 0; j < 2; ++j) {
        const int row = 8 * j + r8; const int cid = c8 ^ (row & 7);
        __builtin_amdgcn_global_load_lds((const unsigned*)(Up + row * 64 + cid * 8), (LAS unsigned*)(slot + 16384 + lw * 2048 + j * 1024), 16, 0, 0);
    }
    __builtin_amdgcn_global_load_lds((const unsigned*)(gcp + (lane & 15) * 4), (LAS unsigned*)(slot + 24576), 16, 0, 0);
}
DI u32x2 lds_piece(const LAS unsigned char* tile, int row, int e) {
    return *(const LAS u32x2*)(tile + row * 128 + ((((e >> 3) ^ (row & 7))) << 4) + ((e & 4) << 1));
}
DI bf16x8 mk8(u32x2 x, u32x2 y) { u32x4 r = {x.x, x.y, y.x, y.y}; return __builtin_bit_cast(bf16x8, r); }
DI bf16x8 mk8rev(u32x2 x, u32x2 y) { u32x4 r = {rot16(x.y), rot16(x.x), rot16(y.y), rot16(y.x)}; return __builtin_bit_cast(bf16x8, r); }
DI void scan_step(const LAS unsigned char* slot, int vs, int dir, int fr, int q, f32x4 (&S)[4], bf16_t* sst) {
    bf16x8 Sb[2];
    Sb[0] = pack8(S[0], S[1]); Sb[1] = pack8(S[2], S[3]);
    {
        const u32x4 s0 = __builtin_bit_cast(u32x4, Sb[0]), s1 = __builtin_bit_cast(u32x4, Sb[1]);
        *(u32x2*)(sst + 0) = (u32x2){s0.x, s0.y}; *(u32x2*)(sst + 16) = (u32x2){s0.z, s0.w};
        *(u32x2*)(sst + 32) = (u32x2){s1.x, s1.y}; *(u32x2*)(sst + 48) = (u32x2){s1.z, s1.w};
    }
    const LAS unsigned char* ut = slot + 16384 + vs * 2048;
    const LAS float* gcl_p = (const LAS float*)(slot + 24576);
    const float gcl = gcl_p[63]; const float gl = fexp(gcl);
    f32x4 vg[4];
#pragma unroll
    for (int m = 0; m < 4; ++m) {
        const int c = 16 * m + fr;
        const bf16x8 w0 = mk8(lds_piece(slot, c, 4 * q), lds_piece(slot, c, 16 + 4 * q)), w1 = mk8(lds_piece(slot, c, 32 + 4 * q), lds_piece(slot, c, 48 + 4 * q));
        f32x4 acc = {0.f, 0.f, 0.f, 0.f};
        acc = MFMA16(w0, Sb[0], acc); acc = MFMA16(w1, Sb[1], acc);
        const u32x2 uu = lds_piece(ut, fr, 16 * m + 4 * q);
        const f32x4 gcv = *(const LAS f32x4*)(slot + 24576 + (16 * m + 4 * q) * 4);
        vg[m][0] = (bflo(uu.x) - acc[0]) * fexp(gcl - gcv[0]); vg[m][1] = (bfhi(uu.x) - acc[1]) * fexp(gcl - gcv[1]);
        vg[m][2] = (bflo(uu.y) - acc[2]) * fexp(gcl - gcv[2]); vg[m][3] = (bfhi(uu.y) - acc[3]) * fexp(gcl - gcv[3]);
    }
    bf16x8 Vg[2];
    Vg[0] = pack8(vg[0], vg[1]); Vg[1] = pack8(vg[2], vg[3]);
#pragma unroll
    for (int kt = 0; kt < 4; ++kt) {
        const int k = 16 * kt + fr;
        bf16x8 k0, k1;
        if (dir == 0) { k0 = mk8(lds_piece(slot + 8192, k, 4 * q), lds_piece(slot + 8192, k, 16 + 4 * q)); k1 = mk8(lds_piece(slot + 8192, k, 32 + 4 * q), lds_piece(slot + 8192, k, 48 + 4 * q)); }
        else { k0 = mk8rev(lds_piece(slot + 8192, k, 60 - 4 * q), lds_piece(slot + 8192, k, 44 - 4 * q)); k1 = mk8rev(lds_piece(slot + 8192, k, 28 - 4 * q), lds_piece(slot + 8192, k, 12 - 4 * q)); }
        f32x4 acc = S[kt] * gl;
        acc = MFMA16(k0, Vg[0], acc); acc = MFMA16(k1, Vg[1], acc);
        S[kt] = acc;
    }
}
DI void phase_scan(const Params& p, int lane, int wid, unsigned char* shm) {
    unsigned char* ws = p.ws;
    const bf16_t* KTC = (const bf16_t*)(ws + OFF_KTC);
    const bf16_t* U = (const bf16_t*)(ws + OFF_U); const bf16_t* WB = (const bf16_t*)(ws + OFF_WB);
    const float* GC = (const float*)(ws + OFF_GC); bf16_t* SST = (bf16_t*)(ws + OFF_SST);
    const int seq = blockIdx.x, dir = seq & 1, bh = seq >> 1;
    const int fr = lane & 15, q = lane >> 4;
    LAS unsigned char* ring = (LAS unsigned char*)shm;
    if (wid >= 4) {
        const int lw = wid - 4;
        scan_issue(ring, WB, U, KTC, GC, seq, bh, dir, lw, 0, lane);
        scan_issue(ring + SCAN_SLOT, WB, U, KTC, GC, seq, bh, dir, lw, 1, lane);
        scan_issue(ring + 2 * SCAN_SLOT, WB, U, KTC, GC, seq, bh, dir, lw, 2, lane);
        int slot_n = 3;
        for (int i = 0; i < 128; ++i) {
            scan_issue(ring + slot_n * SCAN_SLOT, WB, U, KTC, GC, seq, bh, dir, lw, i + 3 < 128 ? i + 3 : 127, lane);
            asm volatile("s_waitcnt vmcnt(21)" ::: "memory");
            __builtin_amdgcn_s_barrier();
            slot_n = slot_n == 4 ? 0 : slot_n + 1;
        }
        asm volatile("s_waitcnt vmcnt(0)" ::: "memory");
    } else {
        const int vs = wid;
        f32x4 S[4];
#pragma unroll
        for (int i = 0; i < 4; ++i) S[i] = (f32x4){0.f, 0.f, 0.f, 0.f};
        bf16_t* sst = SST + (size_t)seq * 128 * 4096 + (16 * vs + fr) * 64 + 4 * q;
        int slot_c = 0;
        for (int i = 0; i < 128; ++i) {
            __builtin_amdgcn_s_barrier();
            asm volatile("" ::: "memory");
            scan_step(ring + slot_c * SCAN_SLOT, vs, dir, fr, q, S, sst + (size_t)i * 4096);
            slot_c = slot_c == 4 ? 0 : slot_c + 1;
        }
    }
}
DI void phase_outp(const Params& p, int gw, int nw, int lane0) {
    unsigned char* ws = p.ws;
    const bf16_t* QC = (const bf16_t*)(ws + OFF_QC);
    const bf16_t* U = (const bf16_t*)(ws + OFF_U); const bf16_t* WB = (const bf16_t*)(ws + OFF_WB); const bf16_t* QK = (const bf16_t*)(ws + OFF_QK);
    const float* GC = (const float*)(ws + OFF_GC); const bf16_t* SST = (const bf16_t*)(ws + OFF_SST);
    for (int it = gw; it < 6144; it += nw) {
        int lane = lane0; asm volatile("" : "+v"(lane));
        const int fr = lane & 15, q = lane >> 4;
        const int chunk = it & 127, seq = it >> 7, dir = seq & 1, bh = seq >> 1, b = bh / 6, h = bh % 6;
        const int pch = dir ? 127 - chunk : chunk;
        const size_t tb = ((size_t)bh * 128 + pch) * 4096;
        const bf16_t* Wp = WB + (size_t)it * 4096; const bf16_t* Up = U + (size_t)it * 4096; const bf16_t* QKp = QK + (size_t)it * 4096;
        const bf16_t* Sp = SST + (size_t)it * 4096; const float* gcp = GC + (size_t)it * 64;
        bf16_t* OT = (bf16_t*)(ws + OFF_WB) + (size_t)it * 4096;
        bf16x8 wf[4][2], qf[4][2], kf[4][2]; f32x4 eg[4];
#pragma unroll
        for (int m = 0; m < 4; ++m) {
            const int c = 16 * m + fr; const int tr = dir ? 63 - c : c;
            wf[m][0] = *(const bf16x8*)(Wp + c * 64 + 8 * q); wf[m][1] = *(const bf16x8*)(Wp + c * 64 + 32 + 8 * q);
            qf[m][0] = *(const bf16x8*)(QC + tb + tr * 64 + 8 * q); qf[m][1] = *(const bf16x8*)(QC + tb + tr * 64 + 32 + 8 * q);
            const bf16_t* kp = QKp + c * 64 + 4 * q;
            kf[m][0] = ld2x8(kp, kp + 16); kf[m][1] = ld2x8(kp + 32, kp + 48);
            const f32x4 gcv = *(const f32x4*)(gcp + 16 * m + 4 * q);
#pragma unroll
            for (int r = 0; r < 4; ++r) eg[m][r] = fexp(gcv[r]);
        }
#pragma unroll 1
        for (int vs = 0; vs < 4; ++vs) {
            const bf16x8 Sb0 = *(const bf16x8*)(Sp + (16 * vs + fr) * 64 + 8 * q), Sb1 = *(const bf16x8*)(Sp + (16 * vs + fr) * 64 + 32 + 8 * q);
            f32x4 vn[4], o[4];
#pragma unroll
            for (int m = 0; m < 4; ++m) {
                f32x4 acc = {0.f, 0.f, 0.f, 0.f};
                acc = MFMA16(wf[m][0], Sb0, acc); acc = MFMA16(wf[m][1], Sb1, acc);
                const u32x2 uu = *(const u32x2*)(Up + (16 * vs + fr) * 64 + 16 * m + 4 * q);
                vn[m][0] = bflo(uu.x) - acc[0]; vn[m][1] = bfhi(uu.x) - acc[1]; vn[m][2] = bflo(uu.y) - acc[2]; vn[m][3] = bfhi(uu.y) - acc[3];
                f32x4 a2 = {0.f, 0.f, 0.f, 0.f};
                a2 = MFMA16(qf[m][0], Sb0, a2); a2 = MFMA16(qf[m][1], Sb1, a2);
                o[m] = a2 * eg[m];
            }
            const bf16x8 Vb0 = pack8(vn[0], vn[1]), Vb1 = pack8(vn[2], vn[3]);
#pragma unroll
            for (int m = 0; m < 4; ++m) {
                f32x4 acc = o[m];
                acc = MFMA16(kf[m][0], Vb0, acc); acc = MFMA16(kf[m][1], Vb1, acc);
#pragma unroll
                for (int r = 0; r < 4; ++r) { const int c = 16 * m + 4 * q + r; OT[c * 64 + 16 * vs + fr] = f2bf(acc[r]); }
            }
        }
    }
}

DI bf16x8 packpv(const f32x16& pv, int s) {
    u32x4 r = {pk2(pv[8 * s], pv[8 * s + 1]), pk2(pv[8 * s + 2], pv[8 * s + 3]), pk2(pv[8 * s + 4], pv[8 * s + 5]), pk2(pv[8 * s + 6], pv[8 * s + 7])};
    return __builtin_bit_cast(bf16x8, r);
}
DI bf16x8 packp(const float (&pv)[16], int s) {
    u32x4 r = {pk2(pv[8 * s], pv[8 * s + 1]), pk2(pv[8 * s + 2], pv[8 * s + 3]), pk2(pv[8 * s + 4], pv[8 * s + 5]), pk2(pv[8 * s + 6], pv[8 * s + 7])};
    return __builtin_bit_cast(bf16x8, r);
}
#define CRW(reg) ((float)(((reg) & 3) + 8 * ((reg) >> 2)))

DI void phase_win(const Params& p, int l, int gw, int nw, int lane) {
    unsigned char* ws = p.ws;
    const bf16_t* PAB = (const bf16_t*)(ws + OFF_PAB); const bf16_t* VT = (const bf16_t*)(ws + OFF_VT); bf16_t* OB = (bf16_t*)(ws + OFF_OB);
    const int r32 = lane & 31, hh = lane >> 5;
    for (int item = gw; item < 6144; item += nw) {
        const int qt = item & 255, qh = (item >> 8) % 6, b = item / 1536, kvh = qh / 3;
        const int q0 = qt * 32, qi = q0 + r32;
        const bf16_t* qrow = PAB + ((size_t)b * SEQ + qi) * LDAB + qh * 64;
        bf16x8 qf[4];
#pragma unroll
        for (int st = 0; st < 4; ++st) qf[st] = *(const bf16x8*)(qrow + 16 * st + 8 * hh);
        const float slope2 = exp2f(-8.f * (float)(qh + 1) / 6.f) * LOG2E, scale2 = 0.125f * LOG2E;
        float m = p.in[7][l * 6 + qh] * LOG2E, lsum = hh == 0 ? 1.f : 0.f;
        f32x16 O[2];
#pragma unroll
        for (int i = 0; i < 16; ++i) { O[0][i] = 0.f; O[1][i] = 0.f; }
        const int kb0 = q0 - 128 < 0 ? 0 : q0 - 128, kb1 = q0 + 160 > SEQ ? SEQ : q0 + 160;
        for (int kb = kb0; kb < kb1; kb += 32) {
            const bf16_t* krow = PAB + ((size_t)b * SEQ + kb + r32) * LDAB + 384 + kvh * 64;
            f32x16 s;
#pragma unroll
            for (int i = 0; i < 16; ++i) s[i] = 0.f;
#pragma unroll
            for (int st = 0; st < 4; ++st) { const bf16x8 kf = *(const bf16x8*)(krow + 16 * st + 8 * hh); s = MFMA32(kf, qf[st], s); }
            bf16x8 vf[2][2];
#pragma unroll
            for (int dt = 0; dt < 2; ++dt) { const bf16_t* vrow = VT + ((size_t)(b * 6 + kvh) * 64 + 32 * dt + r32) * SEQ + kb + 4 * hh;
                vf[dt][0] = ld2x8(vrow, vrow + 8); vf[dt][1] = ld2x8(vrow + 16, vrow + 24); }
            const float qoff = (float)(kb + 4 * hh - qi);
            float t[16]; float mx = m;
#pragma unroll
            for (int reg = 0; reg < 16; ++reg) { const float ad = fabsf(qoff + CRW(reg)); float tv = s[reg] * scale2 - slope2 * ad; tv = (ad <= 128.f) ? tv : -1e30f; t[reg] = tv; mx = fmaxf(mx, tv); }
            mx = fmaxf(mx, __shfl_xor(mx, 32));
            const float alpha = fexp2(m - mx); m = mx;
            float ps = 0.f;
#pragma unroll
            for (int reg = 0; reg < 16; ++reg) { t[reg] = fexp2(t[reg] - m); ps += t[reg]; }
            lsum = lsum * alpha + ps;
#pragma unroll
            for (int i = 0; i < 16; ++i) { O[0][i] *= alpha; O[1][i] *= alpha; }
            const bf16x8 pf0 = packp(t, 0), pf1 = packp(t, 1);
#pragma unroll
            for (int dt = 0; dt < 2; ++dt) { O[dt] = MFMA32(vf[dt][0], pf0, O[dt]); O[dt] = MFMA32(vf[dt][1], pf1, O[dt]); }
        }
        lsum += __shfl_xor(lsum, 32);
        const float inv = 1.f / lsum;
        bf16_t* orow = OB + ((size_t)b * SEQ + qi) * DM + qh * 64;
#pragma unroll
        for (int dt = 0; dt < 2; ++dt)
#pragma unroll
            for (int g4 = 0; g4 < 4; ++g4) {
                u32x2 w = {pk2(O[dt][4 * g4] * inv, O[dt][4 * g4 + 1] * inv), pk2(O[dt][4 * g4 + 2] * inv, O[dt][4 * g4 + 3] * inv)};
                *(u32x2*)(orow + 32 * dt + 8 * g4 + 4 * hh) = w;
            }
    }
}

DI void win_block(const Params& p, int l, int item, int tid, unsigned char* shm) {
    unsigned char* ws = p.ws;
    const bf16_t* PAB = (const bf16_t*)(ws + OFF_PAB); const bf16_t* VT = (const bf16_t*)(ws + OFF_VT); bf16_t* OB = (bf16_t*)(ws + OFF_OB);
    const int lane = tid & 63, wid = tid >> 6, r32 = lane & 31, hh = lane >> 5;
    const int qblk = item & 31, kvh = (item >> 5) & 1, b = item >> 6;
    const int Q0 = qblk * 256, K0 = Q0 - 128;
    {
        const int srow = tid >> 3, sch = tid & 7;
        const int kwoff = srow * 128 + ((sch ^ (srow & 7)) * 16);
        const int vblk = sch >> 1, vhalf = sch & 1;
        const int vwoff0 = 65536 + srow * 128 + (((2 * vblk) ^ (srow & 7)) * 16) + 8 * vhalf;
        const int vwoff1 = 65536 + srow * 128 + (((2 * vblk + 1) ^ (srow & 7)) * 16) + 8 * vhalf;
        __syncthreads();
#pragma unroll 1
        for (int g0 = 0; g0 < 8; g0 += 4) {
            u32x4 kr[4], vr[4];
#pragma unroll
            for (int gg = 0; gg < 4; ++gg) {
                const int g = g0 + gg;
                int kpos = K0 + g * 64 + srow; kpos = kpos < 0 ? 0 : (kpos > SEQ - 1 ? SEQ - 1 : kpos);
                int key0 = K0 + g * 64; key0 = key0 < 0 ? 0 : (key0 > SEQ - 64 ? SEQ - 64 : key0);
                kr[gg] = *(const u32x4*)(PAB + ((size_t)b * SEQ + kpos) * LDAB + 384 + kvh * 64 + sch * 8);
                vr[gg] = *(const u32x4*)(VT + ((size_t)(b * 6 + kvh) * 64 + srow) * SEQ + key0 + sch * 8);
            }
#pragma unroll
            for (int gg = 0; gg < 4; ++gg) {
                const int g = g0 + gg;
                *(u32x4*)(shm + g * 8192 + kwoff) = kr[gg];
                *(u32x2*)(shm + g * 8192 + vwoff0) = (u32x2){vr[gg].x, vr[gg].y}; *(u32x2*)(shm + g * 8192 + vwoff1) = (u32x2){vr[gg].z, vr[gg].w};
            }
        }
        __syncthreads();
    }
    const int q0 = Q0 + wid * 32, qi = q0 + r32;
    const int kb0 = q0 - 128 < 0 ? 0 : q0 - 128, kb1 = q0 + 160 > SEQ ? SEQ : q0 + 160;
#pragma unroll 1
    for (int g3 = 0; g3 < 3; ++g3) {
        const int qh = kvh * 3 + g3;
        const bf16_t* qrow = PAB + ((size_t)b * SEQ + qi) * LDAB + qh * 64;
        bf16x8 qf[4];
#pragma unroll
        for (int st = 0; st < 4; ++st) qf[st] = *(const bf16x8*)(qrow + 16 * st + 8 * hh);
        const float slope2 = exp2f(-8.f * (float)(qh + 1) / 6.f) * LOG2E, scale2 = 0.125f * LOG2E;
        float m = p.in[7][l * 6 + qh] * LOG2E, lsum = hh == 0 ? 1.f : 0.f;
        f32x16 O[2];
#pragma unroll
        for (int i = 0; i < 16; ++i) { O[0][i] = 0.f; O[1][i] = 0.f; }
        for (int kb = kb0; kb < kb1; kb += 32) {
            const int kl = kb - K0, g = kl >> 6, j = (kl >> 5) & 1;
            const unsigned char* Ks = shm + g * 8192; const unsigned char* Vs = shm + 65536 + g * 8192;
            f32x16 s;
#pragma unroll
            for (int i = 0; i < 16; ++i) s[i] = 0.f;
#pragma unroll
            for (int st = 0; st < 4; ++st) { const bf16x8 kf = *(const bf16x8*)(Ks + (32 * j + r32) * 128 + (((2 * st + hh) ^ (r32 & 7)) * 16)); s = MFMA32(kf, qf[st], s); }
            bf16x8 vf[2][2];
#pragma unroll
            for (int dt = 0; dt < 2; ++dt)
#pragma unroll
                for (int s_ = 0; s_ < 2; ++s_) vf[dt][s_] = *(const bf16x8*)(Vs + (32 * dt + r32) * 128 + (((4 * j + 2 * s_ + hh) ^ (r32 & 7)) * 16));
            float qoff = (float)(kb + 4 * hh - qi); asm volatile("" : "+v"(qoff));
            float t[16]; float mx = m;
#pragma unroll
            for (int reg = 0; reg < 16; ++reg) { const float ad = fabsf(qoff + CRW(reg)); float tv = s[reg] * scale2 - slope2 * ad; tv = (ad <= 128.f) ? tv : -1e30f; t[reg] = tv; mx = fmaxf(mx, tv); }
            mx = fmaxf(mx, __shfl_xor(mx, 32));
            const float alpha = fexp2(m - mx); m = mx;
            float ps = 0.f;
#pragma unroll
            for (int reg = 0; reg < 16; ++reg) { t[reg] = fexp2(t[reg] - m); ps += t[reg]; }
            lsum = lsum * alpha + ps;
#pragma unroll
            for (int i = 0; i < 16; ++i) { O[0][i] *= alpha; O[1][i] *= alpha; }
            const bf16x8 pf0 = packp(t, 0), pf1 = packp(t, 1);
#pragma unroll
            for (int dt = 0; dt < 2; ++dt) { O[dt] = MFMA32(vf[dt][0], pf0, O[dt]); O[dt] = MFMA32(vf[dt][1], pf1, O[dt]); }
        }
        lsum += __shfl_xor(lsum, 32);
        const float inv = 1.f / lsum;
        bf16_t* orow = OB + ((size_t)b * SEQ + qi) * DM + qh * 64;
#pragma unroll
        for (int dt = 0; dt < 2; ++dt)
#pragma unroll
            for (int g4 = 0; g4 < 4; ++g4) {
                u32x2 w = {pk2(O[dt][4 * g4] * inv, O[dt][4 * g4 + 1] * inv), pk2(O[dt][4 * g4 + 2] * inv, O[dt][4 * g4 + 3] * inv)};
                *(u32x2*)(orow + 32 * dt + 8 * g4 + 4 * hh) = w;
            }
    }
}

DI bf16x8 scale_frag(bf16x8 v, float sc) {
    u32x4 u = __builtin_bit_cast(u32x4, v), r;
#pragma unroll
    for (int i = 0; i < 4; ++i) r[i] = pk2(bflo(u[i]) * sc, bfhi(u[i]) * sc);
    return __builtin_bit_cast(bf16x8, r);
}
DI void phase_diff(const Params& p, int l, int tid0, unsigned char* shm) {
    unsigned char* ws = p.ws;
    const bf16_t* PAB = (const bf16_t*)(ws + OFF_PAB); const bf16_t* VT = (const bf16_t*)(ws + OFF_VT); bf16_t* OB = (bf16_t*)(ws + OFF_OB);
    const float lam_init = l == 0 ? 0.2f : (0.8f - 0.6f * 0.7408182206817179f);
    float lam;
    {
        const int lane = tid0 & 63;
        const float* dl = p.in[8] + l * 128;
        float a = 0.f, c = 0.f;
        if (lane < 32) { a = dl[lane] * dl[32 + lane]; c = dl[64 + lane] * dl[96 + lane]; }
        a = wave_sum(a); c = wave_sum(c);
        lam = expf(a) - expf(c) + lam_init;
    }
    const float* dg = p.in[9] + l * 64;
    unsigned* qctr = (unsigned*)(ws + OFF_MISC) + 64 + l;
    const unsigned* kmx = (const unsigned*)(ws + OFF_MISC) + l * 32;
    __shared__ unsigned sq_words[32];
    volatile LAS unsigned* sq = (volatile LAS unsigned*)&sq_words[0];
    int first_win = 768;
    for (;;) {
        int tid = tid0; asm volatile("" : "+v"(tid));
        __syncthreads();
        if (tid == 0) sq[0] = atomicAdd(qctr, 1u);
        __syncthreads();
        const int idx_item = (int)sq[0];
        if (idx_item >= 512) { first_win = idx_item; break; }
        const int lane = tid & 63, wid = tid >> 6, r32 = lane & 31, hh = lane >> 5;
        const int qb = idx_item & 31, b = (idx_item >> 5) & 3, h = 3 - (idx_item >> 7);
        const int q0 = qb * 256 + wid * 32, qi = q0 + r32;
        const bf16_t* qrow = PAB + ((size_t)b * SEQ + qi) * LDAB + 640 + h * 64;
        const float scale2 = 0.17677669529663687f * LOG2E;
        bf16x8 qf[2][2];
#pragma unroll
        for (int mp = 0; mp < 2; ++mp)
#pragma unroll
            for (int st = 0; st < 2; ++st) qf[mp][st] = scale_frag(*(const bf16x8*)(qrow + mp * 32 + 16 * st + 8 * hh), scale2);
        const float slope2 = exp2f(-2.f * (float)(h + 1)) * LOG2E;
        float mA = -1e30f, mB = -1e30f, lA = 0.f, lB = 0.f;
        f32x16 OA[2], OBb[2];
#pragma unroll
        for (int i = 0; i < 16; ++i) { OA[0][i] = 0.f; OA[1][i] = 0.f; OBb[0][i] = 0.f; OBb[1][i] = 0.f; }
        const int srow = tid >> 3, sch = tid & 7;
        const bf16_t* kg = PAB + ((size_t)b * SEQ + srow) * LDAB + 896 + h * 64 + sch * 8;
        const bf16_t* vg = VT + ((size_t)(b * 6 + 2 + h) * 64 + srow) * SEQ + sch * 8;
        const int kwoff = srow * 128 + ((sch ^ (srow & 7)) * 16);
        const int vblk = sch >> 1, vhalf = sch & 1;
        const int vwoff0 = 16384 + srow * 128 + (((2 * vblk) ^ (srow & 7)) * 16) + 8 * vhalf;
        const int vwoff1 = 16384 + srow * 128 + (((2 * vblk + 1) ^ (srow & 7)) * 16) + 8 * vhalf;
        int lo, hi;
        {
            float qa = 0.f, qbm = 0.f;
#pragma unroll
            for (int st = 0; st < 2; ++st) { const u32x4 va = __builtin_bit_cast(u32x4, qf[0][st]), vb = __builtin_bit_cast(u32x4, qf[1][st]);
#pragma unroll
                for (int e = 0; e < 4; ++e) { qa += bflo(va[e]) * bflo(va[e]) + bfhi(va[e]) * bfhi(va[e]); qbm += bflo(vb[e]) * bflo(vb[e]) + bfhi(vb[e]) * bfhi(vb[e]); } }
            qa += __shfl_xor(qa, 32); qbm += __shfl_xor(qbm, 32);
            const float qaL = qa, qbL = qbm;
#pragma unroll
            for (int o = 16; o > 0; o >>= 1) { qa = fmaxf(qa, __shfl_xor(qa, o)); qbm = fmaxf(qbm, __shfl_xor(qbm, o)); }
            if (lane == 0) { sq[8 + 2 * wid] = __float_as_uint(qa); sq[9 + 2 * wid] = __float_as_uint(qbm); }
            __syncthreads();
            float qA = 0.f, qB = 0.f;
#pragma unroll
            for (int w8 = 0; w8 < 8; ++w8) { qA = fmaxf(qA, __uint_as_float(sq[8 + 2 * w8])); qB = fmaxf(qB, __uint_as_float(sq[9 + 2 * w8])); }
            const float kA = __uint_as_float(kmx[b * 8 + h * 2]), kB = __uint_as_float(kmx[b * 8 + h * 2 + 1]);
            mA = -sqrtf(qaL * kA) - 1.f; mB = -sqrtf(qbL * kB) - 1.f;
            const float bnd = 2.02f * fmaxf(sqrtf(qA * kA), sqrtf(qB * kB)) + 1.f;
            const float dsk = (168.f + bnd) / slope2;
            const int Dsk = dsk > 16384.f ? 16384 : (int)dsk + 1;
            const int Q0 = qb * 256;
            const int x = Q0 - 63 - Dsk; lo = x <= 0 ? 0 : (x + 63) >> 6;
            const int y = (Q0 + 255 + Dsk) >> 6; hi = y > 127 ? 127 : y;
        }
        const int d0 = qb * 4, nright = hi - d0 + 1, nstage = hi - lo + 1;
        u32x4 kreg, vreg;
        { const int kb = d0 * 64; kreg = *(const u32x4*)(kg + (size_t)kb * LDAB); vreg = *(const u32x4*)(vg + kb); }
        __syncthreads();
        *(u32x4*)(shm + kwoff) = kreg;
        *(u32x2*)(shm + vwoff0) = (u32x2){vreg.x, vreg.y}; *(u32x2*)(shm + vwoff1) = (u32x2){vreg.z, vreg.w};
        __syncthreads();
        for (int idx = 0; idx < nstage; ++idx) {
            const int kt = idx < nright ? d0 + idx : d0 - 1 - (idx - nright);
            const int buf = idx & 1;
            if (idx + 1 < nstage) {
                const int idn = idx + 1; const int ktn = idn < nright ? d0 + idn : d0 - 1 - (idn - nright);
                const int kbn = ktn * 64;
                kreg = *(const u32x4*)(kg + (size_t)kbn * LDAB); vreg = *(const u32x4*)(vg + kbn);
            }
            const unsigned char* Ks = shm + buf * 8192; const unsigned char* Vs = shm + 16384 + buf * 8192;
#pragma unroll
            for (int j = 0; j < 2; ++j) {
                const int kb = kt * 64 + 32 * j;
                bf16x8 kf[2][2], vf[2][2];
#pragma unroll
                for (int mp = 0; mp < 2; ++mp)
#pragma unroll
                    for (int st = 0; st < 2; ++st) kf[mp][st] = *(const bf16x8*)(Ks + (32 * j + r32) * 128 + (((mp * 4 + 2 * st + hh) ^ (r32 & 7)) * 16));
#pragma unroll
                for (int dt = 0; dt < 2; ++dt)
#pragma unroll
                    for (int s_ = 0; s_ < 2; ++s_) vf[dt][s_] = *(const bf16x8*)(Vs + (32 * dt + r32) * 128 + (((4 * j + 2 * s_ + hh) ^ (r32 & 7)) * 16));
                float qoff = (float)(kb + 4 * hh - qi); asm volatile("" : "+v"(qoff));
                f32x16 tA, tB;
                if (kb >= q0 + 32 || kb + 32 <= q0) {
                    const bool right = kb >= q0 + 32;
                    const float Lq = right ? -slope2 * qoff : slope2 * qoff;
                    const float LA = Lq - mA, LB = Lq - mB, sl = right ? -slope2 : slope2;
#pragma unroll
                    for (int reg = 0; reg < 16; ++reg) { tA[reg] = __builtin_fmaf(sl, CRW(reg), LA); tB[reg] = __builtin_fmaf(sl, CRW(reg), LB); }
                } else {
#pragma unroll
                    for (int reg = 0; reg < 16; ++reg) { const float bias = -slope2 * fabsf(qoff + CRW(reg)); tA[reg] = bias - mA; tB[reg] = bias - mB; }
                }
                tA = MFMA32(kf[0][0], qf[0][0], tA); tA = MFMA32(kf[0][1], qf[0][1], tA);
                tB = MFMA32(kf[1][0], qf[1][0], tB); tB = MFMA32(kf[1][1], qf[1][1], tB);
                float mxA = 0.f, mxB = 0.f;
#pragma unroll
                for (int reg = 0; reg < 16; ++reg) { mxA = fmaxf(mxA, tA[reg]); mxB = fmaxf(mxB, tB[reg]); }
                mxA = fmaxf(mxA, __shfl_xor(mxA, 32)); mxB = fmaxf(mxB, __shfl_xor(mxB, 32));
                if (__builtin_amdgcn_ballot_w64(mxA > 0.f) != 0ull) {
                    const float alpha = fexp2(-mxA); mA += mxA; lA *= alpha;
#pragma unroll
                    for (int i = 0; i < 16; ++i) { OA[0][i] *= alpha; OA[1][i] *= alpha; tA[i] -= mxA; }
                }
                if (__builtin_amdgcn_ballot_w64(mxB > 0.f) != 0ull) {
                    const float alpha = fexp2(-mxB); mB += mxB; lB *= alpha;
#pragma unroll
                    for (int i = 0; i < 16; ++i) { OBb[0][i] *= alpha; OBb[1][i] *= alpha; tB[i] -= mxB; }
                }
                float psA = 0.f, psB = 0.f;
#pragma unroll
                for (int reg = 0; reg < 16; ++reg) { tA[reg] = fexp2(tA[reg]); psA += tA[reg]; tB[reg] = fexp2(tB[reg]); psB += tB[reg]; }
                lA += psA; lB += psB;
                const bf16x8 pA0 = packpv(tA, 0), pA1 = packpv(tA, 1), pB0 = packpv(tB, 0), pB1 = packpv(tB, 1);
#pragma unroll
                for (int dt = 0; dt < 2; ++dt) {
                    OA[dt] = MFMA32(vf[dt][0], pA0, OA[dt]); OA[dt] = MFMA32(vf[dt][1], pA1, OA[dt]);
                    OBb[dt] = MFMA32(vf[dt][0], pB0, OBb[dt]); OBb[dt] = MFMA32(vf[dt][1], pB1, OBb[dt]);
                }
            }
            if (idx + 1 < nstage) {
                unsigned char* wb = shm + (buf ^ 1) * 8192;
                *(u32x4*)(wb + kwoff) = kreg;
                *(u32x2*)(wb + vwoff0) = (u32x2){vreg.x, vreg.y}; *(u32x2*)(wb + vwoff1) = (u32x2){vreg.z, vreg.w};
            }
            __syncthreads();
        }
        lA += __shfl_xor(lA, 32); lB += __shfl_xor(lB, 32);
        const float iA = 1.f / lA, iB = lam / lB;
        float ss = 0.f;
#pragma unroll
        for (int dt = 0; dt < 2; ++dt)
#pragma unroll
            for (int i = 0; i < 16; ++i) { const float v = OA[dt][i] * iA - OBb[dt][i] * iB; OA[dt][i] = v; ss += v * v; }
        ss += __shfl_xor(ss, 32);
        const float rstd = __builtin_amdgcn_rsqf(ss * (1.f / 64.f) + EPS) * (1.f - lam_init);
        bf16_t* orow = OB + ((size_t)b * SEQ + qi) * DM + 384 + h * 64;
#pragma unroll
        for (int dt = 0; dt < 2; ++dt)
#pragma unroll
            for (int g4 = 0; g4 < 4; ++g4) {
                const int d = 32 * dt + 8 * g4 + 4 * hh;
                const f32x4 gv = *(const f32x4*)(dg + d);
                u32x2 w = {pk2(OA[dt][4 * g4] * rstd * gv[0], OA[dt][4 * g4 + 1] * rstd * gv[1]), pk2(OA[dt][4 * g4 + 2] * rstd * gv[2], OA[dt][4 * g4 + 3] * rstd * gv[3])};
                *(u32x2*)(orow + d) = w;
            }
    }
    for (int item = first_win; item < 768;) {
        int tid = tid0; asm volatile("" : "+v"(tid));
        win_block(p, l, item - 512, tid, shm);
        __syncthreads();
        if (tid == 0) sq[0] = atomicAdd(qctr, 1u);
        __syncthreads();
        item = (int)sq[0];
    }
}

DI void phase_post(const Params& p, int l, int gw, int nw, int lane) {
    unsigned char* ws = p.ws;
    const bf16_t* OT = (const bf16_t*)(ws + OFF_WB); const bf16_t* PAB = (const bf16_t*)(ws + OFF_PAB); bf16_t* OB = (bf16_t*)(ws + OFF_OB);
    const float gl = p.in[12][l * 64 + lane];
    for (int u = gw; u < 6144; u += nw) {
        const int half = u & 1, h = (u % 12) >> 1, ck = u / 12, b = ck >> 7, chunk = ck & 127;
        const size_t itf = ((size_t)((b * 6 + h) * 2) * 128 + chunk), itb = ((size_t)((b * 6 + h) * 2 + 1) * 128 + (127 - chunk));
        const size_t tok0 = (size_t)b * SEQ + chunk * 64 + half * 32;
#pragma unroll 1
        for (int g = 0; g < 2; ++g) {
            float av[16], zv[16];
#pragma unroll
            for (int j = 0; j < 16; ++j) {
                const int t = half * 32 + g * 16 + j;
                av[j] = bf2f(OT[itf * 4096 + t * 64 + lane]) + bf2f(OT[itb * 4096 + (63 - t) * 64 + lane]);
                zv[j] = bf2f(PAB[(tok0 + g * 16 + j) * LDAB + 1408 + h * 64 + lane]);
            }
#pragma unroll
            for (int j = 0; j < 16; ++j) {
                const float ss = wave_sum(av[j] * av[j]);
                const float y = av[j] * __builtin_amdgcn_rsqf(ss * (1.f / 64.f) + EPS) * gl;
                OB[(tok0 + g * 16 + j) * DM + 640 + h * 64 + lane] = f2bf(y * silu(zv[j]));
            }
        }
    }
}

#define XB_TMO      128
#define XB_XCNT(j)  (256  + 64 * (j))
#define XB_XSUB(j)  (1280 + 64 * (j))
#define XB_XGEN(j)  (2304 + 64 * (j))
#define XB_TOP      3328
#define XB_TOPGEN   3392
#define XCD_BAR_WORDS 3456
#define XB_SPIN_CAP (1u << 18)
DI unsigned xb_ld(unsigned* p)              { return __hip_atomic_load(p, __ATOMIC_RELAXED, __HIP_MEMORY_SCOPE_AGENT); }
DI unsigned xb_add(unsigned* p, unsigned v) { return __hip_atomic_fetch_add(p, v, __ATOMIC_RELAXED, __HIP_MEMORY_SCOPE_AGENT); }
DI unsigned xb_xcc_id() { return (unsigned)__builtin_amdgcn_s_getreg((3 << 11) | 20) & 0xFu; }
#define XB_SPIN(cond, bar) do { unsigned _sp = 0; while (cond) { __builtin_amdgcn_s_sleep(1); \
    if ((++_sp & 255u) == 0u) { if (xb_ld(&(bar)[XB_TMO])) break; if (_sp > XB_SPIN_CAP) { atomicAdd(&(bar)[XB_TMO], 1u); break; } } } } while (0)
struct XcdBarrier { unsigned* bar; unsigned x; volatile LAS unsigned* st; };
DI XcdBarrier xcd_barrier_post(unsigned* bar, volatile LAS unsigned* st) {
    XcdBarrier b; b.bar = bar; b.x = xb_xcc_id(); b.st = st;
    if (threadIdx.x == 0) (void)xb_add(&bar[XB_XCNT(b.x)], 1u);
    return b;
}
DI void xcd_barrier_complete(unsigned* bar, unsigned x, unsigned& nloc, unsigned& nx) {
    const unsigned G = gridDim.x * gridDim.y * gridDim.z;
    unsigned sum, cnt, mine, sp = 0u;
    for (;;) {
        sum = 0u; cnt = 0u; mine = 0u;
#pragma unroll
        for (unsigned j = 0; j < 16; ++j) { const unsigned c = xb_ld(&bar[XB_XCNT(j)]); sum += c; cnt += (c > 0u) ? 1u : 0u; mine = (j == x) ? c : mine; }
        if (sum == G) break;
        __builtin_amdgcn_s_sleep(1);
        if ((++sp & 255u) == 0u) { if (xb_ld(&bar[XB_TMO])) break; if (sp > XB_SPIN_CAP) { atomicAdd(&bar[XB_TMO], 1u); break; } }
    }
    nloc = mine > 0u ? mine : 1u; nx = cnt > 0u ? cnt : 1u;
}
DI void xcd_barrier(const XcdBarrier& b) {
    asm volatile("s_waitcnt vmcnt(0)" ::: "memory");
    __syncthreads();
    if (threadIdx.x == 0) {
        unsigned* bar = b.bar;
        __builtin_amdgcn_s_waitcnt(0);
        unsigned nloc = b.st[0], nx = b.st[1];
        if (nloc == 0u) { xcd_barrier_complete(bar, b.x, nloc, nx); b.st[0] = nloc; b.st[1] = nx; }
        const unsigned old = xb_add(&bar[XB_XSUB(b.x)], 1u);
        const unsigned gen = old / nloc;
        if (old + 1u == (gen + 1u) * nloc) {
            __builtin_amdgcn_fence(__ATOMIC_RELEASE, "agent");
            asm volatile("s_waitcnt vmcnt(0)" ::: "memory");
            const unsigned og = xb_add(&bar[XB_TOP], 1u);
            const unsigned tg = og / nx;
            if (og + 1u == (tg + 1u) * nx) xb_add(&bar[XB_TOPGEN], 1u);
            else XB_SPIN(xb_ld(&bar[XB_TOPGEN]) == tg, bar);
            __builtin_amdgcn_fence(__ATOMIC_ACQUIRE, "agent");
            xb_add(&bar[XB_XGEN(b.x)], 1u);
            asm volatile("s_waitcnt vmcnt(0)" ::: "memory");
        } else {
            XB_SPIN(xb_ld(&bar[XB_XGEN(b.x)]) == gen, bar);
            __builtin_amdgcn_fence(__ATOMIC_ACQUIRE, "agent");
            asm volatile("s_waitcnt vmcnt(0)" ::: "memory");
        }
    }
    __syncthreads();
}

constexpr int NPHASE = 30;
DI void run_phase(const Params& p, int ph, unsigned char* shm, int tid) {
    const int wid = tid >> 6, lane = tid & 63;
    const int gw = blockIdx.x * 8 + wid, nw = gridDim.x * 8;
    unsigned char* ws = p.ws;
    if (ph == 0) { if (EN(0)) { phase_init(p, gw, nw, lane); phase_convw(p, 0, shm, tid); } return; }
    if (ph == NPHASE - 1) { if (EN(27)) phase_final(p, gw, nw, lane); return; }
    const int l = (ph - 1) / 14, sub = (ph - 1) % 14;
    float* rss = (float*)(ws + OFF_RSS);
    bf16_t* XB = (bf16_t*)(ws + OFF_XB);
    LAS unsigned char* lds = (LAS unsigned char*)shm;
    pg8::StaticOrder S;
    if (sub == 0) { if (EN(0)) if (l > 0) phase_convw(p, l, shm, tid); return; }
    if (EN(1)) if (sub == 1 || sub == 12) {
        const int f = sub == 1 ? 0 : 1;
        pg8::Gemm g{XB, (const bf16_t*)(ws + (f ? OFF_W_FFN2IN : OFF_W_FFN1IN)), MTOK, NFF, DM};
        EpiSwiglu E{(bf16_t*)(ws + OFF_BIG), rss + (size_t)((3 * l + (f ? 2 : 0)) & 1) * MTOK * 16};
        S.init(MTOK, NFF, gridDim.x, blockIdx.x);
        pg8::gemm_phase(tid, lds, g, S, E);
        if ((REPMASK >> 1) & 1) { __syncthreads(); pg8::gemm_phase(tid, lds, g, S, E); }
        return;
    }
    if (EN(2)) if (sub == 2 || sub == 13 || sub == 11) {
        const bf16_t* A; const bf16_t* Bt; int K; float scale; int nn;
        if (sub == 2) { A = (const bf16_t*)(ws + OFF_BIG); Bt = (const bf16_t*)(ws + OFF_W_FFN1OUT); K = DFFP; scale = 0.5f; nn = 3 * l + 1; }
        else if (sub == 13) { A = (const bf16_t*)(ws + OFF_BIG); Bt = (const bf16_t*)(ws + OFF_W_FFN2OUT); K = DFFP; scale = 0.5f; nn = 3 * l + 3; }
        else { A = (const bf16_t*)(ws + OFF_OB); Bt = (const bf16_t*)(ws + OFF_W_MIXOUT); K = DM; scale = 1.f; nn = 3 * l + 2; }
        pg8::Gemm g{A, Bt, MTOK, DM, K};
        EpiResid E{(l == 0 && sub == 2) ? p.in[0] : (const float*)p.out, p.out, XB, rss + (size_t)(nn & 1) * MTOK * 16, scale};
        S.init(MTOK, DM, gridDim.x, blockIdx.x);
        pg8::gemm_phase(tid, lds, g, S, E); return;
    }
    if (EN(3)) if (sub == 3) {
        pg8::Gemm g{XB, (const bf16_t*)(ws + OFF_W_MIXIN), MTOK, NMIX, DM};
        EpiMixIn E{(bf16_t*)(ws + OFF_PAB), (bf16_t*)(ws + OFF_PC), (float*)(ws + OFF_BG), rss + (size_t)((3 * l + 1) & 1) * MTOK * 16};
        S.init(MTOK, NMIX, gridDim.x, blockIdx.x);
        pg8::gemm_phase(tid, lds, g, S, E);
        return;
    }
    if (EN(4)) if (sub == 4) { REP(4) phase_prep(p, l, gw, nw, lane); return; }
    if (EN(5)) if (sub == 5) { REP(5) phase_chunk(p, l, gw, nw, lane, wid, shm); return; }
    if (EN(6)) if (sub == 6) {
        if (blockIdx.x < 48) phase_scan(p, lane, wid, shm);
        phase_diff(p, l, tid, shm);
        return;
    }
    if (EN(10)) if (sub == 7) { phase_outp(p, gw, nw, lane); return; }


    if (EN(9)) if (sub == 10) { REP(9) phase_post(p, l, gw, nw, lane); return; }
}

__global__ __launch_bounds__(512, 2) void mega(Params p) {
    extern __shared__ __attribute__((aligned(16))) unsigned char shm[];
    __shared__ uint4 xb_words;
    if (threadIdx.x == 0) xb_words = make_uint4(0u, 0u, 0u, 0u);
    __syncthreads();
    const XcdBarrier xb = xcd_barrier_post((unsigned*)(p.ws + OFF_BAR), (volatile LAS unsigned*)&xb_words);
#ifndef PROBE_DUP
    for (int ph = p.p0; ph < p.p1; ++ph) {
        if (ph == 1 || ph == 9 || ph == 10 || ph == 23 || ph == 24) continue;
        int tid = threadIdx.x; asm volatile("" : "+v"(tid));
        Params q = p;
#if defined(__HIP_DEVICE_COMPILE__)
        {
            typedef __attribute__((address_space(1))) unsigned char GUC; typedef __attribute__((address_space(1))) float GF; typedef __attribute__((address_space(1))) const float GCF;
            unsigned long long wsi = (unsigned long long)p.ws, oi = (unsigned long long)p.out; asm volatile("" : "+s"(wsi), "+s"(oi));
            q.ws = (unsigned char*)(GUC*)wsi; q.out = (float*)(GF*)oi;
#pragma unroll
            for (int ii = 0; ii < 18; ++ii) q.in[ii] = (const float*)(GCF*)(unsigned long long)p.in[ii];
        }
#endif
        run_phase(q, ph, shm, tid);
        if (ph + 1 < p.p1) {
            if (ph == 0) cg::this_grid().sync();
            else xcd_barrier(xb);
        }
    }
#else
    for (int st = 0; st < 2 * NPHASE; ++st) {
        const int ph = st >> 1;
        if (ph == 1 || ph == 9 || ph == 10 || ph == 23 || ph == 24) continue;
        const int subp = (ph >= 1 && ph <= 28) ? (ph - 1) % 14 : (ph == 0 ? 14 : 15);
        if ((st & 1) && !((PROBE_DUP >> subp) & 1)) continue;
        int tid = threadIdx.x; asm volatile("" : "+v"(tid));
        Params q = p; asm volatile("" : "+s"(q.ws), "+s"(q.out));
        run_phase(q, ph, shm, tid);
        cg::this_grid().sync();
    }
#endif
}

extern "C" void kernel_launch(void* const* d_in, const int* in_sizes, int n_in, void* d_out, int out_size, void* d_ws, size_t ws_size, hipStream_t stream) {
    static int grid = 0;
    if (!grid) {
        hipFuncSetAttribute((const void*)mega, hipFuncAttributeMaxDynamicSharedMemorySize, LDS_BYTES);
        int dev = 0, cus = 0, per = 0;
        hipGetDevice(&dev);
        hipDeviceGetAttribute(&cus, hipDeviceAttributeMultiprocessorCount, dev);
        hipOccupancyMaxActiveBlocksPerMultiprocessor(&per, mega, 512, LDS_BYTES);
        if (per < 1) per = 1;
        grid = cus * per;
        if (grid > 256) grid = 256;
    }
    (void)hipMemsetAsync((unsigned char*)d_ws + OFF_BAR, 0, 3456 * 4, stream);
    Params p{};
    for (int i = 0; i < 18; ++i) p.in[i] = (const float*)d_in[i];
    p.out = (float*)d_out; p.ws = (unsigned char*)d_ws;
#if MULTI
    for (int ph = 0; ph < NPHASE; ++ph) {
        if (ph == 1 || ph == 9 || ph == 10 || ph == 23 || ph == 24) continue;
        p.p0 = ph; p.p1 = ph + 1;
        hipLaunchKernelGGL(mega, dim3(grid), dim3(512), LDS_BYTES, stream, p);
    }
#else
    p.p0 = 0; p.p1 = NPHASE;
    void* args[] = {&p};
    hipError_t e = hipLaunchCooperativeKernel((const void*)mega, dim3(grid), dim3(512), args, LDS_BYTES, stream);
    if (e != hipSuccess) fprintf(stderr, "cooperative launch failed: %s (grid %d)\n", hipGetErrorString(e), grid);
#endif
}
```

```cpp
#include <hip/hip_runtime.h>
#include <hip/hip_cooperative_groups.h>
#include <cstdio>
namespace cg = cooperative_groups;


#ifndef REPMASK
#define REPMASK 0
#endif
#define REP(k) for (int rep_ = 0; rep_ < (((REPMASK >> (k)) & 1) ? 2 : 1); ++rep_)
#ifndef MULTI
#define MULTI 0
#endif

#ifdef ONLY
#define EN(k) (ONLY==(k))
#else
#define EN(k) 1
#endif
#define DI __device__ __forceinline__
#define LAS __attribute__((address_space(3)))
typedef unsigned short bf16_t;
typedef short bf16x8 __attribute__((ext_vector_type(8)));
typedef short s16x4 __attribute__((ext_vector_type(4)));
typedef float f32x4 __attribute__((ext_vector_type(4)));
typedef float f32x16 __attribute__((ext_vector_type(16)));
typedef float f32x2 __attribute__((ext_vector_type(2)));
typedef unsigned u32x4 __attribute__((ext_vector_type(4)));
typedef unsigned u32x2 __attribute__((ext_vector_type(2)));
typedef __bf16 bf16v2 __attribute__((ext_vector_type(2)));

constexpr int DM = 1024, NBATCH = 4, SEQ = 8192, MTOK = NBATCH * SEQ, DFF = 2752, DFFP = 2816, NFF = 2 * DFFP, NMIX = 3072;
constexpr int LDAB = 1792, LDC = 1280;
constexpr float EPS = 1e-6f, LOG2E = 1.4426950408889634f;
constexpr int LDS_BYTES = 131072;

constexpr size_t SZ_W_FFNIN = (size_t)NFF * DM * 2, SZ_W_FFNOUT = (size_t)DM * DFFP * 2, SZ_W_MIXIN = (size_t)NMIX * DM * 2, SZ_W_MIXOUT = (size_t)DM * DM * 2;
constexpr size_t OFF_W_FFN1IN = 0;
constexpr size_t OFF_W_FFN1OUT = OFF_W_FFN1IN + SZ_W_FFNIN;
constexpr size_t OFF_W_MIXIN = OFF_W_FFN1OUT + SZ_W_FFNOUT;
constexpr size_t OFF_W_MIXOUT = OFF_W_MIXIN + SZ_W_MIXIN;
constexpr size_t OFF_W_FFN2IN = OFF_W_MIXOUT + SZ_W_MIXOUT;
constexpr size_t OFF_W_FFN2OUT = OFF_W_FFN2IN + SZ_W_FFNIN;
constexpr size_t OFF_XB = OFF_W_FFN2OUT + SZ_W_FFNOUT;
constexpr size_t SZ_TILE = (size_t)3072 * 4096 * 2;
constexpr size_t OFF_QC = OFF_XB, OFF_KTC = OFF_XB + SZ_TILE;
constexpr size_t OFF_OB = OFF_XB + (size_t)MTOK * DM * 2;
constexpr size_t OFF_BIG = OFF_OB + (size_t)MTOK * DM * 2;
constexpr size_t OFF_PAB = OFF_BIG, OFF_PC = OFF_BIG + (size_t)MTOK * LDAB * 2;
constexpr size_t OFF_U = OFF_PC, OFF_WB = OFF_PC + (size_t)6144 * 8192;
constexpr size_t OFF_BG = OFF_WB + (size_t)6144 * 8192;
constexpr size_t OFF_RSS = OFF_BG + (size_t)MTOK * 24 * 4;
constexpr size_t OFF_VT = OFF_RSS + (size_t)2 * MTOK * 16 * 4;
constexpr size_t OFF_KC = OFF_VT + (size_t)NBATCH * 6 * 64 * SEQ * 2;
constexpr size_t OFF_VTC = OFF_KC + SZ_TILE;
constexpr size_t OFF_SST = OFF_KC;
constexpr size_t OFF_QK = OFF_VTC + SZ_TILE;
constexpr size_t OFF_GC = OFF_QK + (size_t)6144 * 8192;
constexpr size_t OFF_MISC = OFF_GC + (size_t)6144 * 64 * 4;
constexpr size_t OFF_BAR = OFF_MISC + 1024;
constexpr size_t WS_TOTAL = OFF_BAR + 3456 * 4;
static_assert(WS_TOTAL <= (size_t)536870912, "workspace too large");
static_assert((size_t)MTOK * DFFP * 2 <= OFF_BG - OFF_BIG, "hidden does not fit");

struct Params {
    const float* in[18];
    float* out;
    unsigned char* ws;
    int p0, p1;
};

DI unsigned pk2(float a, float b) { f32x2 v = {a, b}; bf16v2 r = __builtin_convertvector(v, bf16v2); return __builtin_bit_cast(unsigned, r); }
DI bf16_t f2bf(float a) { return (bf16_t)(pk2(a, 0.f) & 0xffffu); }
DI float bf2f(bf16_t v) { return __uint_as_float(((unsigned)v) << 16); }
DI float bflo(unsigned v) { return __uint_as_float(v << 16); }
DI float bfhi(unsigned v) { return __uint_as_float(v & 0xffff0000u); }
DI float wave_sum(float v) {
    v += __builtin_bit_cast(float, __builtin_amdgcn_update_dpp(0, __builtin_bit_cast(int, v), 0xB1, 0xf, 0xf, true));
    v += __builtin_bit_cast(float, __builtin_amdgcn_update_dpp(0, __builtin_bit_cast(int, v), 0x4E, 0xf, 0xf, true));
    v += __builtin_bit_cast(float, __builtin_amdgcn_update_dpp(0, __builtin_bit_cast(int, v), 0x141, 0xf, 0xf, true));
    v += __builtin_bit_cast(float, __builtin_amdgcn_update_dpp(0, __builtin_bit_cast(int, v), 0x140, 0xf, 0xf, true));
    const int iv = __builtin_bit_cast(int, v);
    const float a = __builtin_bit_cast(float, __builtin_amdgcn_readlane(iv, 0)), b = __builtin_bit_cast(float, __builtin_amdgcn_readlane(iv, 16));
    const float c = __builtin_bit_cast(float, __builtin_amdgcn_readlane(iv, 32)), d = __builtin_bit_cast(float, __builtin_amdgcn_readlane(iv, 48));
    return (a + b) + (c + d);
}
DI bf16x8 ld2x8(const bf16_t* a, const bf16_t* b) { u32x2 x = *(const u32x2*)a, y = *(const u32x2*)b; u32x4 r = {x.x, x.y, y.x, y.y}; return __builtin_bit_cast(bf16x8, r); }
DI unsigned rot16(unsigned x) { return (x >> 16) | (x << 16); }
DI bf16x8 ld2x8rev(const bf16_t* a, const bf16_t* b) {
    u32x2 x = *(const u32x2*)a, y = *(const u32x2*)b; u32x4 r = {rot16(x.y), rot16(x.x), rot16(y.y), rot16(y.x)}; return __builtin_bit_cast(bf16x8, r);
}
DI bf16x8 pack8(f32x4 a, f32x4 b) { u32x4 r = {pk2(a[0], a[1]), pk2(a[2], a[3]), pk2(b[0], b[1]), pk2(b[2], b[3])}; return __builtin_bit_cast(bf16x8, r); }
DI float fexp2(float x) { return __builtin_amdgcn_exp2f(x); }
DI float fexp(float x) { return __builtin_amdgcn_exp2f(x * LOG2E); }
DI float silu(float x) { return x * __builtin_amdgcn_rcpf(1.f + fexp(-x)); }
DI float row_rstd(const float* rp, int row) {
    const f32x4 a = *(const f32x4*)(rp + (size_t)row * 16), b = *(const f32x4*)(rp + (size_t)row * 16 + 4), c = *(const f32x4*)(rp + (size_t)row * 16 + 8), d = *(const f32x4*)(rp + (size_t)row * 16 + 12);
    const float s = ((a[0] + a[1]) + (a[2] + a[3])) + ((b[0] + b[1]) + (b[2] + b[3])) + ((c[0] + c[1]) + (c[2] + c[3])) + ((d[0] + d[1]) + (d[2] + d[3]));
    return __builtin_amdgcn_rsqf(s * (1.f / DM) + EPS);
}
#define MFMA16(a, b, c) __builtin_amdgcn_mfma_f32_16x16x32_bf16((a), (b), (c), 0, 0, 0)
#define MFMA32(a, b, c) __builtin_amdgcn_mfma_f32_32x32x16_bf16((a), (b), (c), 0, 0, 0)

namespace pg8 {
constexpr int BM = 256, BK = 64, HALF = 128, HTB = HALF * BK * 2, STAGE_BYTES = 8 * HTB, NXCD = 8, WGM = 8;
DI int lds_byte(int r, int c) { const int st = (r >> 4) * 2 + (c >> 5), rr = r & 15, cc = c & 31, ob = rr * 64 + cc * 2; return st * 1024 + (ob ^ (((ob >> 9) & 1) << 5)); }
DI void stage_rc(int b, int& R, int& C) { const int st = b / 1024, sb = b % 1024, swz = sb ^ (((sb >> 9) & 1) << 5); R = (st >> 1) * 16 + swz / 64; C = (st & 1) * 32 + (swz % 64) / 2; }
DI int perm32(int rho) { const int n = rho >> 4, i = rho & 15; return 8 * (i >> 2) + 4 * n + (i & 3); }
struct Unit { int pm, pn; };
struct Gemm { const bf16_t* A; const bf16_t* Bt; int M, N, K; };
struct StaticOrder {
    int nM, nN, nwg, G, c;
    DI void init(int M, int N, int G_, int c_) { nM = M / BM; nN = N / BM; nwg = nM * nN; G = G_; c = c_; }
    DI bool next(int i, Unit& u) const {
        const long L = (long)i * G + c; if (L >= nwg) return false;
        int wgid = (int)L; { const int q = nwg / NXCD, r = nwg % NXCD, xcd = wgid % NXCD, off = wgid / NXCD; wgid = (xcd < r ? xcd * (q + 1) : r * (q + 1) + (xcd - r) * q) + off; }
        const int nig = WGM * nN, gid = wgid / nig, fm = gid * WGM, gsz = (nM - fm) < WGM ? (nM - fm) : WGM;
        u.pm = fm + ((wgid % nig) % gsz); u.pn = (wgid % nig) / gsz; return true;
    }
};
template <class Epi>
DI void gemm_phase(int tid, LAS unsigned char* lds, const Gemm g, const StaticOrder& S, const Epi& E) {
    const int wid = __builtin_amdgcn_readfirstlane(tid >> 6), lane = tid & 63, wr = wid >> 2, wc = wid & 3, fr = lane & 15, fq = lane >> 4;
    const int K = g.K, nt = K / BK;
    unsigned voffA[2], voffB[2];
#pragma unroll
    for (int i = 0; i < 2; ++i) { int R, C; stage_rc(tid * 16 + i * 8192, R, C); const int Rb = (R & ~31) + perm32(R & 31);
        voffA[i] = (unsigned)(R * K + C) * 2u; voffB[i] = (unsigned)(Rb * K + C) * 2u; }
    const size_t kstep = (size_t)(BK * 2);
    const size_t hstep = (size_t)HALF * K * 2;
    const size_t tstep = 2 * hstep;
    const unsigned ldsw = (unsigned)wid * 1024u;
    const int aoff = lds_byte(wr * 64 + fr, fq * 8), boff = lds_byte(wc * 32 + fr, fq * 8);
#define PG8_SA(b, h) (((b) * 2 + (h)) * HTB)
#define PG8_SB(b, h) ((4 + (b) * 2 + (h)) * HTB)
#define PG8_STAGE(bufoff, gbase, voff) do { _Pragma("unroll") for (int _i = 0; _i < 2; ++_i) \
        __builtin_amdgcn_global_load_lds((const unsigned*)((const char*)(gbase) + (voff)[_i]), (LAS unsigned*)(lds + (bufoff) + ldsw + _i * 8192), 16, 0, 0); } while (0)
#define PG8_LDA(dst, b, h) do { _Pragma("unroll") for (int m = 0; m < 4; ++m) _Pragma("unroll") for (int k = 0; k < 2; ++k) dst[m][k] = *(const LAS bf16x8*)(lds + PG8_SA(b, h) + aoff + m * 2048 + k * 1024); } while (0)
#define PG8_LDB(dst, b, h) do { _Pragma("unroll") for (int n = 0; n < 2; ++n) _Pragma("unroll") for (int k = 0; k < 2; ++k) dst[n][k] = *(const LAS bf16x8*)(lds + PG8_SB(b, h) + boff + n * 2048 + k * 1024); } while (0)
#define PG8_MMA(ai, bj, At, Bt) do { __builtin_amdgcn_s_setprio(1); _Pragma("unroll") for (int m = 0; m < 4; ++m) _Pragma("unroll") for (int n = 0; n < 2; ++n) _Pragma("unroll") for (int k = 0; k < 2; ++k) \
        acc[ai][bj][m][n] = __builtin_amdgcn_mfma_f32_16x16x32_bf16(Bt[n][k], At[m][k], acc[ai][bj][m][n], 0, 0, 0); __builtin_amdgcn_s_setprio(0); } while (0)
#define PG8_WAIT_V(n) asm volatile("s_waitcnt vmcnt(" #n ")" ::: "memory")
#define PG8_WAIT_L(n) asm volatile("s_waitcnt lgkmcnt(" #n ")" ::: "memory")
#define PG8_BAR __builtin_amdgcn_s_barrier()
#define PG8_SCHED __builtin_amdgcn_sched_barrier(0)
    Unit cur, nxt; int ui = 0;
    if (!S.next(0, cur)) return;
    f32x4 acc[2][2][4][2];
#pragma unroll
    for (int a = 0; a < 2; ++a)
#pragma unroll
        for (int b = 0; b < 2; ++b)
#pragma unroll
            for (int m = 0; m < 4; ++m)
#pragma unroll
                for (int n = 0; n < 2; ++n) acc[a][b][m][n] = (f32x4){0.f, 0.f, 0.f, 0.f};
    bf16x8 At[4][2], B0[2][2], B1[2][2];
    const char* cA = (const char*)g.A + (size_t)cur.pm * tstep; const char* cB = (const char*)g.Bt + (size_t)cur.pn * tstep;
    PG8_STAGE(PG8_SB(0, 0), cB, voffB); PG8_STAGE(PG8_SA(0, 0), cA, voffA); PG8_STAGE(PG8_SB(0, 1), cB + hstep, voffB); PG8_STAGE(PG8_SA(0, 1), cA + hstep, voffA);
    if (wr == 1) PG8_BAR;
    PG8_WAIT_V(4); PG8_BAR;
    PG8_STAGE(PG8_SB(1, 0), cB + kstep, voffB); PG8_STAGE(PG8_SA(1, 0), cA + kstep, voffA); PG8_STAGE(PG8_SB(1, 1), cB + hstep + kstep, voffB);
    PG8_WAIT_V(6); PG8_BAR;
    for (;;) {
        const bool has_next = S.next(ui + 1, nxt);
        const char* nA = has_next ? (const char*)g.A + (size_t)nxt.pm * tstep : cA; const char* nB = has_next ? (const char*)g.Bt + (size_t)nxt.pn * tstep : cB;
        for (int t = 0; t < nt; t += 2) {
            const bool last = (t == nt - 2);
            const char* a1 = cA + (size_t)(t + 1) * kstep;
            const char* a2 = last ? nA : cA + (size_t)(t + 2) * kstep; const char* b2 = last ? nB : cB + (size_t)(t + 2) * kstep;
            const char* a3 = a2 + kstep; const char* b3 = b2 + kstep;
            PG8_LDB(B0, 0, 0); PG8_SCHED; PG8_LDA(At, 0, 0); PG8_STAGE(PG8_SA(1, 1), a1 + hstep, voffA);
            PG8_WAIT_L(8); PG8_BAR; PG8_WAIT_L(0); PG8_MMA(0, 0, At, B0); PG8_BAR; PG8_SCHED;
            PG8_LDB(B1, 0, 1); PG8_STAGE(PG8_SB(0, 0), b2, voffB);
            PG8_BAR; PG8_WAIT_L(0); PG8_MMA(0, 1, At, B1); PG8_BAR;
            PG8_LDA(At, 0, 1); PG8_STAGE(PG8_SA(0, 0), a2, voffA);
            PG8_BAR; PG8_WAIT_L(0); PG8_MMA(1, 0, At, B0); PG8_BAR; PG8_SCHED;
            PG8_STAGE(PG8_SB(0, 1), b2 + hstep, voffB);
            PG8_WAIT_V(6); PG8_BAR; PG8_MMA(1, 1, At, B1); PG8_BAR;
            PG8_LDB(B0, 1, 0); PG8_SCHED; PG8_LDA(At, 1, 0); PG8_STAGE(PG8_SA(0, 1), a2 + hstep, voffA);
            PG8_WAIT_L(8); PG8_BAR; PG8_WAIT_L(0); PG8_MMA(0, 0, At, B0); PG8_BAR; PG8_SCHED;
            PG8_LDB(B1, 1, 1); PG8_STAGE(PG8_SB(1, 0), b3, voffB);
            PG8_BAR; PG8_WAIT_L(0); PG8_MMA(0, 1, At, B1); PG8_BAR;
            PG8_LDA(At, 1, 1); PG8_STAGE(PG8_SA(1, 0), a3, voffA);
            PG8_BAR; PG8_WAIT_L(0); PG8_MMA(1, 0, At, B0); PG8_BAR; PG8_SCHED;
            PG8_STAGE(PG8_SB(1, 1), b3 + hstep, voffB);
            PG8_WAIT_V(6); PG8_BAR; PG8_MMA(1, 1, At, B1); PG8_BAR;
        }
        E(acc, cur, wr, wc, fr, fq);
        if (!has_next) break;
#pragma unroll
        for (int a = 0; a < 2; ++a)
#pragma unroll
            for (int b = 0; b < 2; ++b)
#pragma unroll
                for (int m = 0; m < 4; ++m)
#pragma unroll
                    for (int n = 0; n < 2; ++n) acc[a][b][m][n] = (f32x4){0.f, 0.f, 0.f, 0.f};
        cur = nxt; cA = nA; cB = nB; ++ui;
    }
    PG8_WAIT_V(0);
    if (wr == 0) PG8_BAR;
    PG8_BAR;
#undef PG8_SA
#undef PG8_SB
#undef PG8_STAGE
#undef PG8_LDA
#undef PG8_LDB
#undef PG8_MMA
#undef PG8_WAIT_V
#undef PG8_WAIT_L
#undef PG8_BAR
#undef PG8_SCHED
}
}
using pg8::Unit;
typedef f32x4 AccT[2][2][4][2];

struct EpiSwiglu {
    bf16_t* H; const float* rss;
    DI void operator()(const AccT& acc, const Unit& u, int wr, int wc, int fr, int fq) const {
        const int row0 = u.pm * 256 + wr * 64 + fr, col0 = u.pn * 128 + wc * 32 + 8 * fq;
#pragma unroll
        for (int ai = 0; ai < 2; ++ai)
#pragma unroll
            for (int m = 0; m < 4; ++m) {
                const int row = row0 + ai * 128 + m * 16;
                const float rstd = row_rstd(rss, row);
                float hv[8];
#pragma unroll
                for (int n = 0; n < 2; ++n)
#pragma unroll
                    for (int j = 0; j < 4; ++j) { const float gg = acc[ai][0][m][n][j] * rstd, uu = acc[ai][1][m][n][j] * rstd; hv[4 * n + j] = silu(gg) * uu; }
                u32x4 w = {pk2(hv[0], hv[1]), pk2(hv[2], hv[3]), pk2(hv[4], hv[5]), pk2(hv[6], hv[7])};
                *(u32x4*)(H + (size_t)row * DFFP + col0) = w;
            }
    }
};
struct EpiResid {
    const float* Xin; float* X; bf16_t* XB; float* rssn; float scale;
    DI void operator()(const AccT& acc, const Unit& u, int wr, int wc, int fr, int fq) const {
        const int row0 = u.pm * 256 + wr * 64 + fr, col0 = u.pn * 256 + wc * 32 + 8 * fq;
#pragma unroll
        for (int ai = 0; ai < 2; ++ai)
#pragma unroll
            for (int m = 0; m < 4; ++m) {
                const int row = row0 + ai * 128 + m * 16; float ss = 0.f;
#pragma unroll
                for (int bj = 0; bj < 2; ++bj) {
                    float* xp = X + (size_t)row * DM + col0 + bj * 128; const float* xi = Xin + (size_t)row * DM + col0 + bj * 128;
                    f32x4 x0 = *(const f32x4*)xi, x1 = *(const f32x4*)(xi + 4);
                    x0 += acc[ai][bj][m][0] * scale; x1 += acc[ai][bj][m][1] * scale;
                    *(f32x4*)xp = x0; *(f32x4*)(xp + 4) = x1;
                    u32x4 w = {pk2(x0[0], x0[1]), pk2(x0[2], x0[3]), pk2(x1[0], x1[1]), pk2(x1[2], x1[3])};
                    *(u32x4*)(XB + (size_t)row * DM + col0 + bj * 128) = w;
#pragma unroll
                    for (int j = 0; j < 4; ++j) ss += x0[j] * x0[j] + x1[j] * x1[j];
                }
                ss += __shfl_xor(ss, 16); ss += __shfl_xor(ss, 32);
                if (fq == 0) rssn[(size_t)row * 16 + u.pn * 4 + wc] = ss;
            }
    }
};
struct EpiMixIn {
    bf16_t* PAB; bf16_t* PC; float* BG; const float* rss;
    DI void operator()(const AccT& acc, const Unit& u, int wr, int wc, int fr, int fq) const {
        const int row0 = u.pm * 256 + wr * 64 + fr;
        bf16_t* base; int ld, ct;
        if (u.pn < 7) { base = PAB; ld = LDAB; ct = u.pn * 256; } else { base = PC; ld = LDC; ct = (u.pn - 7) * 256; }
        const int col0 = ct + wc * 32 + 8 * fq;
        const bool isbg = (u.pn == 11) && (wc == 0) && (fq < 3);
#pragma unroll
        for (int ai = 0; ai < 2; ++ai)
#pragma unroll
            for (int m = 0; m < 4; ++m) {
                const int row = row0 + ai * 128 + m * 16;
                const float rstd = row_rstd(rss, row);
#pragma unroll
                for (int bj = 0; bj < 2; ++bj) {
                    const f32x4 v0 = acc[ai][bj][m][0] * rstd, v1 = acc[ai][bj][m][1] * rstd;
                    u32x4 w = {pk2(v0[0], v0[1]), pk2(v0[2], v0[3]), pk2(v1[0], v1[1]), pk2(v1[2], v1[3])};
                    *(u32x4*)(base + (size_t)row * ld + col0 + bj * 128) = w;
                    if (bj == 1 && isbg) { float* bp = BG + (size_t)row * 24 + 8 * fq; *(f32x4*)bp = v0; *(f32x4*)(bp + 4) = v1; }
                }
            }
    }
};

DI int map_src(int kind, int n) {
    if (kind == 0) return n;
    if (kind == 1) { const int pn = n >> 8, bj = (n >> 7) & 1, i = n & 127; const int hid = pn * 128 + i; return hid < DFF ? hid + bj * DFF : -1; }
    if (n < 1408) return n;
    if (n < 1792) return 2560 + (n - 1408);
    if (n < 2944) return 1408 + (n - 1792);
    if (n < 2968) return n;
    return -1;
}
DI void conv_w(const float* __restrict__ W, int ldw, int Kreal, bf16_t* __restrict__ Bt, int Np, int Kp, const float* __restrict__ gain, int kind, float* tile, int tid) {
    const int tnn = Np >> 8, ntile = tnn * (Kp >> 6);
    for (int t = blockIdx.x; t < ntile; t += gridDim.x) {
        const int n0 = (t % tnn) << 8, k0 = (t / tnn) << 6;
        {
            const int tn = tid & 255, tk = tid >> 8; const int src = map_src(kind, n0 + tn);
            float v[32];
#pragma unroll
            for (int r = 0; r < 32; ++r) { const int k = k0 + tk + 2 * r; v[r] = 0.f;
                if (src >= 0 && k < Kreal) { v[r] = W[(size_t)k * ldw + src]; if (gain) v[r] *= gain[k]; } }
#pragma unroll
            for (int r = 0; r < 32; ++r) tile[(tk + 2 * r) * 257 + tn] = v[r];
        }
        __syncthreads();
#pragma unroll
        for (int i = 0; i < 4; ++i) {
            const int id = tid + i * 512; const int rn = id >> 3, kk = (id & 7) * 8; float a[8];
#pragma unroll
            for (int j = 0; j < 8; ++j) a[j] = tile[(kk + j) * 257 + rn];
            u32x4 w = {pk2(a[0], a[1]), pk2(a[2], a[3]), pk2(a[4], a[5]), pk2(a[6], a[7])};
            *(u32x4*)(Bt + (size_t)(n0 + rn) * Kp + k0 + kk) = w;
        }
        __syncthreads();
    }
}
DI void phase_convw(const Params& p, int l, unsigned char* shm, int tid) {
    float* tile = (float*)shm; unsigned char* ws = p.ws;
    conv_w(p.in[2] + (size_t)l * DM * 2 * DFF, 2 * DFF, DM, (bf16_t*)(ws + OFF_W_FFN1IN), NFF, DM, p.in[1] + l * DM, 1, tile, tid);
    conv_w(p.in[3] + (size_t)l * DFF * DM, DM, DFF, (bf16_t*)(ws + OFF_W_FFN1OUT), DM, DFFP, nullptr, 0, tile, tid);
    conv_w(p.in[5] + (size_t)l * DM * 2968, 2968, DM, (bf16_t*)(ws + OFF_W_MIXIN), NMIX, DM, p.in[4] + l * DM, 2, tile, tid);
    conv_w(p.in[13] + (size_t)l * DM * DM, DM, DM, (bf16_t*)(ws + OFF_W_MIXOUT), DM, DM, nullptr, 0, tile, tid);
    conv_w(p.in[15] + (size_t)l * DM * 2 * DFF, 2 * DFF, DM, (bf16_t*)(ws + OFF_W_FFN2IN), NFF, DM, p.in[14] + l * DM, 1, tile, tid);
    conv_w(p.in[16] + (size_t)l * DFF * DM, DM, DFF, (bf16_t*)(ws + OFF_W_FFN2OUT), DM, DFFP, nullptr, 0, tile, tid);
}

DI void phase_init(const Params& p, int gw, int nw, int lane) {
    const float* x = p.in[0]; float* X = p.out; bf16_t* XB = (bf16_t*)(p.ws + OFF_XB); float* rss = (float*)(p.ws + OFF_RSS);
    for (int row0 = gw * 4; row0 < MTOK; row0 += nw * 4) {
        f32x4 v[4][4];
#pragma unroll
        for (int r = 0; r < 4; ++r)
#pragma unroll
            for (int i = 0; i < 4; ++i) v[r][i] = *(const f32x4*)(x + (size_t)(row0 + r) * DM + i * 256 + lane * 4);
#pragma unroll
        for (int r = 0; r < 4; ++r) {
            float ss = 0.f;
#pragma unroll
            for (int i = 0; i < 4; ++i) {
                const size_t o = (size_t)(row0 + r) * DM + i * 256 + lane * 4;
                u32x2 w = {pk2(v[r][i][0], v[r][i][1]), pk2(v[r][i][2], v[r][i][3])}; *(u32x2*)(XB + o) = w;
                ss += v[r][i][0] * v[r][i][0] + v[r][i][1] * v[r][i][1] + v[r][i][2] * v[r][i][2] + v[r][i][3] * v[r][i][3];
            }
            ss = wave_sum(ss); if (lane < 16) rss[(size_t)(row0 + r) * 16 + lane] = lane == 0 ? ss : 0.f;
        }
    }
    if (gw == 0) { unsigned* misc = (unsigned*)(p.ws + OFF_MISC); misc[lane] = 0u; misc[64 + lane] = 0u; misc[128 + lane] = 0u; misc[192 + lane] = 0u; }
}
DI void phase_final(const Params& p, int gw, int nw, int lane) {
    float* X = p.out; const float* rss = (const float*)(p.ws + OFF_RSS); const float* g = p.in[17];
    for (int row0 = gw * 4; row0 < MTOK; row0 += nw * 4) {
        f32x4 v[4][4]; float rstd[4];
#pragma unroll
        for (int r = 0; r < 4; ++r) {
            rstd[r] = row_rstd(rss, row0 + r);
#pragma unroll
            for (int i = 0; i < 4; ++i) v[r][i] = *(const f32x4*)(X + (size_t)(row0 + r) * DM + i * 256 + lane * 4);
        }
#pragma unroll
        for (int r = 0; r < 4; ++r)
#pragma unroll
            for (int i = 0; i < 4; ++i) {
                const int c = i * 256 + lane * 4; const f32x4 gv = *(const f32x4*)(g + c);
                *(f32x4*)(X + (size_t)(row0 + r) * DM + c) = v[r][i] * rstd[r] * gv;
            }
    }
}

DI void store_row64(bf16_t* dst, const float (&val)[64]) {
#pragma unroll
    for (int i = 0; i < 8; ++i) { u32x4 w = {pk2(val[8 * i], val[8 * i + 1]), pk2(val[8 * i + 2], val[8 * i + 3]), pk2(val[8 * i + 4], val[8 * i + 5]), pk2(val[8 * i + 6], val[8 * i + 7])};
        *(u32x4*)(dst + 8 * i) = w; }
}
DI void phase_prep(const Params& p, int l, int gw, int nw, int lane0) {
    unsigned char* ws = p.ws;
    const bf16_t* PAB = (const bf16_t*)(ws + OFF_PAB); const bf16_t* PC = (const bf16_t*)(ws + OFF_PC);
    bf16_t* QC = (bf16_t*)(ws + OFF_QC); bf16_t* KC = (bf16_t*)(ws + OFF_KC); bf16_t* KTC = (bf16_t*)(ws + OFF_KTC); bf16_t* VTC = (bf16_t*)(ws + OFF_VTC);
    bf16_t* VT = (bf16_t*)(ws + OFF_VT);
    const float* cw = p.in[6] + (size_t)l * 5 * 1152;
    for (int u = gw; u < 512 * 25; u += nw) {
        int lane = lane0; asm volatile("" : "+v"(lane));
        const int grp = u % 25, ck = u / 25, b = ck >> 7, chunk = ck & 127;
        if (grp == 24) {
            const bf16_t* kr = PAB + ((size_t)b * SEQ + chunk * 64 + lane) * LDAB + 896;
            unsigned* kmx = (unsigned*)(ws + OFF_MISC) + l * 32 + b * 8;
#pragma unroll
            for (int hm = 0; hm < 8; ++hm) {
                float ss = 0.f;
#pragma unroll
                for (int c4 = 0; c4 < 4; ++c4) { const u32x4 v = *(const u32x4*)(kr + hm * 32 + c4 * 8);
#pragma unroll
                    for (int e = 0; e < 4; ++e) { const float a = bflo(v[e]), bb = bfhi(v[e]); ss += a * a + bb * bb; } }
#pragma unroll
                for (int o = 32; o > 0; o >>= 1) ss = fmaxf(ss, __shfl_xor(ss, o));
                if (lane == 0) atomicMax(kmx + hm, __float_as_uint(ss));
            }
            continue;
        }
        float val[64];
        if (grp < 18) {
            const int type = grp / 6, h = grp % 6, col = type * 384 + h * 64 + lane;
            const float w0 = cw[col], w1 = cw[1152 + col], w2 = cw[2 * 1152 + col], w3 = cw[3 * 1152 + col], w4 = cw[4 * 1152 + col];
            float xv[68];
#pragma unroll
            for (int i = 0; i < 68; ++i) { const int pos = chunk * 64 - 2 + i;
                xv[i] = (pos >= 0 && pos < SEQ) ? bf2f(PC[((size_t)b * SEQ + pos) * LDC + col]) : 0.f; }
#pragma unroll
            for (int t = 0; t < 64; ++t) { const float v = w0 * xv[t] + w1 * xv[t + 1] + w2 * xv[t + 2] + w3 * xv[t + 3] + w4 * xv[t + 4]; val[t] = silu(v); }
            if (type < 2) {
                const float sc = type == 0 ? 0.125f : 1.f;
#pragma unroll
                for (int t = 0; t < 64; ++t) { const float ss = wave_sum(val[t] * val[t]); val[t] *= __builtin_amdgcn_rsqf(ss + EPS) * sc; }
            }
            const size_t tb = ((size_t)(b * 6 + h) * 128 + chunk) * 4096;
            if (type == 0) {
#pragma unroll
                for (int t = 0; t < 64; ++t) QC[tb + t * 64 + lane] = f2bf(val[t]);
            } else if (type == 1) {
#pragma unroll
                for (int t = 0; t < 64; ++t) KC[tb + t * 64 + lane] = f2bf(val[t]);
                store_row64(KTC + tb + lane * 64, val);
            } else {
                store_row64(VTC + tb + lane * 64, val);
            }
        } else {
            const int vh = grp - 18; const int col = (vh < 2 ? 512 + vh * 64 : 1152 + (vh - 2) * 64) + lane;
            const size_t tok0 = (size_t)b * SEQ + chunk * 64;
#pragma unroll
            for (int t = 0; t < 64; ++t) val[t] = bf2f(PAB[(tok0 + t) * LDAB + col]);
            store_row64(VT + ((size_t)(b * 6 + vh) * 64 + lane) * SEQ + chunk * 64, val);
        }
    }
}

DI void phase_chunk(const Params& p, int l, int gw, int nw, int lane0, int wid, unsigned char* shm) {
    unsigned char* ws = p.ws;
    float* Mf = (float*)(shm + wid * 16384); bf16_t* AB = (bf16_t*)Mf; bf16_t* ABG = AB + 4096;
    const bf16_t* QC = (const bf16_t*)(ws + OFF_QC); const bf16_t* KC = (const bf16_t*)(ws + OFF_KC);
    const bf16_t* KTC = (const bf16_t*)(ws + OFF_KTC); const bf16_t* VTC = (const bf16_t*)(ws + OFF_VTC);
    const float* BG = (const float*)(ws + OFF_BG);
    bf16_t* U = (bf16_t*)(ws + OFF_U); bf16_t* WB = (bf16_t*)(ws + OFF_WB); bf16_t* QK = (bf16_t*)(ws + OFF_QK); float* GC = (float*)(ws + OFF_GC);
    for (int it = gw; it < 6144; it += nw) {
        int lane = lane0; asm volatile("" : "+v"(lane));
        const int fr = lane & 15, q = lane >> 4;
        const int chunk = it & 127, seq = it >> 7, dir = seq & 1, bh = seq >> 1, b = bh / 6, h = bh % 6;
        const int pch = dir ? 127 - chunk : chunk;
        const size_t tb = ((size_t)bh * 128 + pch) * 4096;
        const int tkl = dir ? 63 - lane : lane;
        const size_t tok = (size_t)b * SEQ + pch * 64 + tkl;
        const float braw = BG[tok * 24 + dir * 6 + h], araw = BG[tok * 24 + 12 + dir * 6 + h];
        const float beta = 1.f / (1.f + expf(-braw));
        const float Aa = expf(p.in[10][l * 12 + dir * 6 + h]); const float xx = araw + p.in[11][l * 12 + dir * 6 + h];
        const float sp = fmaxf(xx, 0.f) + log1pf(expf(-fabsf(xx)));
        const float g = -Aa * sp;
        float gc = g;
#pragma unroll
        for (int o = 1; o < 64; o <<= 1) { const float t = __shfl_up(gc, o); if (lane >= o) gc += t; }
        GC[(size_t)it * 64 + lane] = gc;
        bf16x8 kf[4][2], qf[4][2];
#pragma unroll
        for (int m = 0; m < 4; ++m)
#pragma unroll
            for (int s = 0; s < 2; ++s) { const int row = 16 * m + fr; const int tr = dir ? 63 - row : row;
                kf[m][s] = *(const bf16x8*)(KC + tb + tr * 64 + 32 * s + 8 * q); qf[m][s] = *(const bf16x8*)(QC + tb + tr * 64 + 32 * s + 8 * q); }
#pragma unroll
        for (int m = 0; m < 4; ++m)
#pragma unroll
            for (int n = 0; n <= m; ++n) {
                f32x4 acc = {0.f, 0.f, 0.f, 0.f};
                acc = MFMA16(kf[m][0], kf[n][0], acc); acc = MFMA16(kf[m][1], kf[n][1], acc);
                const int s_ = 16 * n + fr; const float gcs = __shfl(gc, s_);
#pragma unroll
                for (int r = 0; r < 4; ++r) { const int c = 16 * m + 4 * q + r; const float gcc = __shfl(gc, c), bc = __shfl(beta, c);
                    Mf[c * 64 + s_] = (s_ < c) ? bc * acc[r] * fexp(gcc - gcs) : 0.f; }
                __builtin_amdgcn_sched_barrier(0);
            }
#pragma unroll
        for (int n = 0; n < 4; ++n)
#pragma unroll
            for (int m = 0; m < 4; ++m) {
                f32x4 v = {0.f, 0.f, 0.f, 0.f};
                const int c = 16 * n + fr;
                if (m <= n) {
                    f32x4 acc = {0.f, 0.f, 0.f, 0.f};
                    acc = MFMA16(kf[m][0], qf[n][0], acc); acc = MFMA16(kf[m][1], qf[n][1], acc);
                    const float gcc = __shfl(gc, c);
#pragma unroll
                    for (int r = 0; r < 4; ++r) { const int s_ = 16 * m + 4 * q + r; const float gcs = __shfl(gc, s_); v[r] = (s_ <= c) ? acc[r] * fexp(gcc - gcs) : 0.f; }
                }
                u32x2 w = {pk2(v[0], v[1]), pk2(v[2], v[3])};
                *(u32x2*)(QK + (size_t)it * 4096 + c * 64 + 16 * m + 4 * q) = w;
                __builtin_amdgcn_sched_barrier(0);
            }
        __builtin_amdgcn_sched_barrier(0);
        bf16x8 vfr[4][2], ktf[4][2];
#pragma unroll
        for (int n = 0; n < 4; ++n) {
            const bf16_t* vp = VTC + tb + (16 * n + fr) * 64 + 8 * q; vfr[n][0] = *(const bf16x8*)vp; vfr[n][1] = *(const bf16x8*)(vp + 32);
            const bf16_t* kp = KTC + tb + (16 * n + fr) * 64 + 8 * q; ktf[n][0] = *(const bf16x8*)kp; ktf[n][1] = *(const bf16x8*)(kp + 32);
        }
        float x[64];
#pragma unroll
        for (int i = 0; i < 64; ++i) {
            float a = (i == lane) ? 1.f : 0.f;
#pragma unroll
            for (int m = 0; m < i; ++m) a -= Mf[i * 64 + m] * x[m];
            x[i] = a;
            __builtin_amdgcn_sched_barrier(0);
        }
        {
            const float bj = beta, bgj = beta * fexp(gc);
#pragma unroll
            for (int i = 0; i < 64; ++i) { AB[i * 64 + tkl] = f2bf(x[i] * bj); ABG[i * 64 + tkl] = f2bf(x[i] * bgj); }
        }
        __builtin_amdgcn_sched_barrier(0);
#pragma unroll
        for (int m = 0; m < 4; ++m) {
            const bf16x8 a0 = *(const bf16x8*)(AB + (16 * m + fr) * 64 + 8 * q), a1 = *(const bf16x8*)(AB + (16 * m + fr) * 64 + 32 + 8 * q);
#pragma unroll
            for (int n = 0; n < 4; ++n) {
                const bf16x8 b0 = vfr[n][0], b1 = vfr[n][1];
                f32x4 acc = {0.f, 0.f, 0.f, 0.f};
                acc = MFMA16(a0, b0, acc); acc = MFMA16(a1, b1, acc);
                u32x2 w = {pk2(acc[0], acc[1]), pk2(acc[2], acc[3])};
                *(u32x2*)(U + (size_t)it * 4096 + (16 * n + fr) * 64 + 16 * m + 4 * q) = w;
            }
        }
        __builtin_amdgcn_sched_barrier(0);
#pragma unroll
        for (int n = 0; n < 4; ++n) {
            const bf16x8 b0 = *(const bf16x8*)(ABG + (16 * n + fr) * 64 + 8 * q), b1 = *(const bf16x8*)(ABG + (16 * n + fr) * 64 + 32 + 8 * q);
#pragma unroll
            for (int m = 0; m < 4; ++m) {
                const bf16x8 a0 = ktf[m][0], a1 = ktf[m][1];
                f32x4 acc = {0.f, 0.f, 0.f, 0.f};
                acc = MFMA16(a0, b0, acc); acc = MFMA16(a1, b1, acc);
                u32x2 w = {pk2(acc[0], acc[1]), pk2(acc[2], acc[3])};
                *(u32x2*)(WB + (size_t)it * 4096 + (16 * n + fr) * 64 + 16 * m + 4 * q) = w;
            }
        }
    }
}

constexpr int SCAN_SLOT = 25600;
DI void scan_issue(LAS unsigned char* slot, const bf16_t* WB, const bf16_t* U, const bf16_t* KTC, const float* GC, int seq, int bh, int dir, int lw, int i, int lane) {
    const int it = seq * 128 + i; const int pch = dir ? 127 - i : i;
    const bf16_t* Wp = WB + (size_t)it * 4096; const bf16_t* Kp = KTC + ((size_t)bh * 128 + pch) * 4096;
    const bf16_t* Up = U + (size_t)it * 4096 + (16 * lw) * 64; const float* gcp = GC + (size_t)it * 64;
    const int r8 = lane >> 3, c8 = lane & 7;
#pragma unroll
    for (int jj = 0; jj < 2; ++jj) {
        const int j = 2 * lw + jj;
        const int row = 8 * j + r8; const int cid = c8 ^ (row & 7);
        __builtin_amdgcn_global_load_lds((const unsigned*)(Wp + row * 64 + cid * 8), (LAS unsigned*)(slot + j * 1024), 16, 0, 0);
        __builtin_amdgcn_global_load_lds((const unsigned*)(Kp + row * 64 + cid * 8), (LAS unsigned*)(slot + 8192 + j * 1024), 16, 0, 0);
    }
#pragma unroll
    for (int j = 0; j < 2; ++j) {
        const int row = 8 * j + r8; const int cid = c8 ^ (row & 7);
        __builtin_amdgcn_global_load_lds((const unsigned*)(Up + row * 64 + cid * 8), (LAS unsigned*)(slot + 16384 + lw * 2048 + j * 1024), 16, 0, 0);
    }
    __builtin_amdgcn_global_load_lds((const unsigned*)(gcp + (lane & 15) * 4), (LAS unsigned*)(slot + 24576), 16, 0, 0);
}
DI u32x2 lds_piece(const LAS unsigned char* tile, int row, int e) {
    return *(const LAS u32x2*)(tile + row * 128 + ((((e >> 3) ^ (row & 7))) << 4) + ((e & 4) << 1));
}
DI bf16x8 mk8(u32x2 x, u32x2 y) { u32x4 r = {x.x, x.y, y.x, y.y}; return __builtin_bit_cast(bf16x8, r); }
DI bf16x8 mk8rev(u32x2 x, u32x2 y) { u32x4 r = {rot16(x.y), rot16(x.x), rot16(y.y), rot16(y.x)}; return __builtin_bit_cast(bf16x8, r); }
DI void scan_step(const LAS unsigned char* slot, int vs, int dir, int fr, int q, f32x4 (&S)[4], bf16_t* sst) {
    bf16x8 Sb[2];
    Sb[0] = pack8(S[0], S[1]); Sb[1] = pack8(S[2], S[3]);
    {
        const u32x4 s0 = __builtin_bit_cast(u32x4, Sb[0]), s1 = __builtin_bit_cast(u32x4, Sb[1]);
        *(u32x2*)(sst + 0) = (u32x2){s0.x, s0.y}; *(u32x2*)(sst + 16) = (u32x2){s0.z, s0.w};
        *(u32x2*)(sst + 32) = (u32x2){s1.x, s1.y}; *(u32x2*)(sst + 48) = (u32x2){s1.z, s1.w};
    }
    const LAS unsigned char* ut = slot + 16384 + vs * 2048;
    const LAS float* gcl_p = (const LAS float*)(slot + 24576);
    const float gcl = gcl_p[63]; const float gl = fexp(gcl);
    f32x4 vg[4];
#pragma unroll
    for (int m = 0; m < 4; ++m) {
        const int c = 16 * m + fr;
        const bf16x8 w0 = mk8(lds_piece(slot, c, 4 * q), lds_piece(slot, c, 16 + 4 * q)), w1 = mk8(lds_piece(slot, c, 32 + 4 * q), lds_piece(slot, c, 48 + 4 * q));
        f32x4 acc = {0.f, 0.f, 0.f, 0.f};
        acc = MFMA16(w0, Sb[0], acc); acc = MFMA16(w1, Sb[1], acc);
        const u32x2 uu = lds_piece(ut, fr, 16 * m + 4 * q);
        const f32x4 gcv = *(const LAS f32x4*)(slot + 24576 + (16 * m + 4 * q) * 4);
        vg[m][0] = (bflo(uu.x) - acc[0]) * fexp(gcl - gcv[0]); vg[m][1] = (bfhi(uu.x) - acc[1]) * fexp(gcl - gcv[1]);
        vg[m][2] = (bflo(uu.y) - acc[2]) * fexp(gcl - gcv[2]); vg[m][3] = (bfhi(uu.y) - acc[3]) * fexp(gcl - gcv[3]);
    }
    bf16x8 Vg[2];
    Vg[0] = pack8(vg[0], vg[1]); Vg[1] = pack8(vg[2], vg[3]);
#pragma unroll
    for (int kt = 0; kt < 4; ++kt) {
        const int k = 16 * kt + fr;
        bf16x8 k0, k1;
        if (dir == 0) { k0 = mk8(lds_piece(slot + 8192, k, 4 * q), lds_piece(slot + 8192, k, 16 + 4 * q)); k1 = mk8(lds_piece(slot + 8192, k, 32 + 4 * q), lds_piece(slot + 8192, k, 48 + 4 * q)); }
        else { k0 = mk8rev(lds_piece(slot + 8192, k, 60 - 4 * q), lds_piece(slot + 8192, k, 44 - 4 * q)); k1 = mk8rev(lds_piece(slot + 8192, k, 28 - 4 * q), lds_piece(slot + 8192, k, 12 - 4 * q)); }
        f32x4 acc = S[kt] * gl;
        acc = MFMA16(k0, Vg[0], acc); acc = MFMA16(k1, Vg[1], acc);
        S[kt] = acc;
    }
}
DI void phase_scan(const Params& p, int l, int lane, int wid, unsigned char* shm) {
    unsigned char* ws = p.ws;
    const bf16_t* KTC = (const bf16_t*)(ws + OFF_KTC);
    const bf16_t* U = (const bf16_t*)(ws + OFF_U); const bf16_t* WB = (const bf16_t*)(ws + OFF_WB);
    const float* GC = (const float*)(ws + OFF_GC); bf16_t* SST = (bf16_t*)(ws + OFF_SST);
    const int seq = blockIdx.x, dir = seq & 1, bh = seq >> 1;
    const int fr = lane & 15, q = lane >> 4;
    LAS unsigned char* ring = (LAS unsigned char*)shm;
    if (wid >= 4) {
        const int lw = wid - 4;
        scan_issue(ring, WB, U, KTC, GC, seq, bh, dir, lw, 0, lane);
        scan_issue(ring + SCAN_SLOT, WB, U, KTC, GC, seq, bh, dir, lw, 1, lane);
        scan_issue(ring + 2 * SCAN_SLOT, WB, U, KTC, GC, seq, bh, dir, lw, 2, lane);
        int slot_n = 3;
        for (int i = 0; i < 128; ++i) {
            scan_issue(ring + slot_n * SCAN_SLOT, WB, U, KTC, GC, seq, bh, dir, lw, i + 3 < 128 ? i + 3 : 127, lane);
            asm volatile("s_waitcnt vmcnt(21)" ::: "memory");
            __builtin_amdgcn_s_barrier();
            slot_n = slot_n == 4 ? 0 : slot_n + 1;
        }
        asm volatile("s_waitcnt vmcnt(0)" ::: "memory");
    } else {
        const int vs = wid;
        f32x4 S[4];
#pragma unroll
        for (int i = 0; i < 4; ++i) S[i] = (f32x4){0.f, 0.f, 0.f, 0.f};
        bf16_t* sst = SST + (size_t)seq * 128 * 4096 + (16 * vs + fr) * 64 + 4 * q;
        int slot_c = 0;
        for (int i = 0; i < 128; ++i) {
            __builtin_amdgcn_s_barrier();
            asm volatile("" ::: "memory");
            scan_step(ring + slot_c * SCAN_SLOT, vs, dir, fr, q, S, sst + (size_t)i * 4096);
            slot_c = slot_c == 4 ? 0 : slot_c + 1;
        }
    }
    asm volatile("s_waitcnt vmcnt(0)" ::: "memory");
    __syncthreads();
    if (threadIdx.x == 0) {
        __builtin_amdgcn_fence(__ATOMIC_RELEASE, "agent");
        asm volatile("s_waitcnt vmcnt(0)" ::: "memory");
        __hip_atomic_store((unsigned*)(p.ws + OFF_MISC) + 128 + l * 64 + seq, 1u, __ATOMIC_RELAXED, __HIP_MEMORY_SCOPE_AGENT);
    }
}

DI void phase_outp(const Params& p, int gw, int nw, int lane0) {
    unsigned char* ws = p.ws;
    const bf16_t* QC = (const bf16_t*)(ws + OFF_QC);
    const bf16_t* U = (const bf16_t*)(ws + OFF_U); const bf16_t* WB = (const bf16_t*)(ws + OFF_WB); const bf16_t* QK = (const bf16_t*)(ws + OFF_QK);
    const float* GC = (const float*)(ws + OFF_GC); const bf16_t* SST = (const bf16_t*)(ws + OFF_SST);
    for (int it = gw; it < 6144; it += nw) {
        int lane = lane0; asm volatile("" : "+v"(lane));
        const int fr = lane & 15, q = lane >> 4;
        const int chunk = it & 127, seq = it >> 7, dir = seq & 1, bh = seq >> 1, b = bh / 6, h = bh % 6;
        const int pch = dir ? 127 - chunk : chunk;
        const size_t tb = ((size_t)bh * 128 + pch) * 4096;
        const bf16_t* Wp = WB + (size_t)it * 4096; const bf16_t* Up = U + (size_t)it * 4096; const bf16_t* QKp = QK + (size_t)it * 4096;
        const bf16_t* Sp = SST + (size_t)it * 4096; const float* gcp = GC + (size_t)it * 64;
        bf16_t* OT = (bf16_t*)(ws + OFF_WB) + (size_t)it * 4096;
        bf16x8 wf[4][2], qf[4][2], kf[4][2]; f32x4 eg[4];
#pragma unroll
        for (int m = 0; m < 4; ++m) {
            const int c = 16 * m + fr; const int tr = dir ? 63 - c : c;
            wf[m][0] = *(const bf16x8*)(Wp + c * 64 + 8 * q); wf[m][1] = *(const bf16x8*)(Wp + c * 64 + 32 + 8 * q);
            qf[m][0] = *(const bf16x8*)(QC + tb + tr * 64 + 8 * q); qf[m][1] = *(const bf16x8*)(QC + tb + tr * 64 + 32 + 8 * q);
            const bf16_t* kp = QKp + c * 64 + 4 * q;
            kf[m][0] = ld2x8(kp, kp + 16); kf[m][1] = ld2x8(kp + 32, kp + 48);
            const f32x4 gcv = *(const f32x4*)(gcp + 16 * m + 4 * q);
#pragma unroll
            for (int r = 0; r < 4; ++r) eg[m][r] = fexp(gcv[r]);
        }
#pragma unroll 1
        for (int vs = 0; vs < 4; ++vs) {
            const bf16x8 Sb0 = *(const bf16x8*)(Sp + (16 * vs + fr) * 64 + 8 * q), Sb1 = *(const bf16x8*)(Sp + (16 * vs + fr) * 64 + 32 + 8 * q);
            f32x4 vn[4], o[4];
#pragma unroll
            for (int m = 0; m < 4; ++m) {
                f32x4 acc = {0.f, 0.f, 0.f, 0.f};
                acc = MFMA16(wf[m][0], Sb0, acc); acc = MFMA16(wf[m][1], Sb1, acc);
                const u32x2 uu = *(const u32x2*)(Up + (16 * vs + fr) * 64 + 16 * m + 4 * q);
                vn[m][0] = bflo(uu.x) - acc[0]; vn[m][1] = bfhi(uu.x) - acc[1]; vn[m][2] = bflo(uu.y) - acc[2]; vn[m][3] = bfhi(uu.y) - acc[3];
                f32x4 a2 = {0.f, 0.f, 0.f, 0.f};
                a2 = MFMA16(qf[m][0], Sb0, a2); a2 = MFMA16(qf[m][1], Sb1, a2);
                o[m] = a2 * eg[m];
            }
            const bf16x8 Vb0 = pack8(vn[0], vn[1]), Vb1 = pack8(vn[2], vn[3]);
#pragma unroll
            for (int m = 0; m < 4; ++m) {
                f32x4 acc = o[m];
                acc = MFMA16(kf[m][0], Vb0, acc); acc = MFMA16(kf[m][1], Vb1, acc);
#pragma unroll
                for (int r = 0; r < 4; ++r) { const int c = 16 * m + 4 * q + r; OT[c * 64 + 16 * vs + fr] = f2bf(acc[r]); }
            }
        }
    }
}

DI bf16x8 packpv(const f32x16& pv, int s) {
    u32x4 r = {pk2(pv[8 * s], pv[8 * s + 1]), pk2(pv[8 * s + 2], pv[8 * s + 3]), pk2(pv[8 * s + 4], pv[8 * s + 5]), pk2(pv[8 * s + 6], pv[8 * s + 7])};
    return __builtin_bit_cast(bf16x8, r);
}
DI bf16x8 packp(const float (&pv)[16], int s) {
    u32x4 r = {pk2(pv[8 * s], pv[8 * s + 1]), pk2(pv[8 * s + 2], pv[8 * s + 3]), pk2(pv[8 * s + 4], pv[8 * s + 5]), pk2(pv[8 * s + 6], pv[8 * s + 7])};
    return __builtin_bit_cast(bf16x8, r);
}
#define CRW(reg) ((float)(((reg) & 3) + 8 * ((reg) >> 2)))

DI void phase_win(const Params& p, int l, int gw, int nw, int lane) {
    unsigned char* ws = p.ws;
    const bf16_t* PAB = (const bf16_t*)(ws + OFF_PAB); const bf16_t* VT = (const bf16_t*)(ws + OFF_VT); bf16_t* OB = (bf16_t*)(ws + OFF_OB);
    const int r32 = lane & 31, hh = lane >> 5;
    for (int item = gw; item < 6144; item += nw) {
        const int qt = item & 255, qh = (item >> 8) % 6, b = item / 1536, kvh = qh / 3;
        const int q0 = qt * 32, qi = q0 + r32;
        const bf16_t* qrow = PAB + ((size_t)b * SEQ + qi) * LDAB + qh * 64;
        bf16x8 qf[4];
#pragma unroll
        for (int st = 0; st < 4; ++st) qf[st] = *(const bf16x8*)(qrow + 16 * st + 8 * hh);
        const float slope2 = exp2f(-8.f * (float)(qh + 1) / 6.f) * LOG2E, scale2 = 0.125f * LOG2E;
        float m = p.in[7][l * 6 + qh] * LOG2E, lsum = hh == 0 ? 1.f : 0.f;
        f32x16 O[2];
#pragma unroll
        for (int i = 0; i < 16; ++i) { O[0][i] = 0.f; O[1][i] = 0.f; }
        const int kb0 = q0 - 128 < 0 ? 0 : q0 - 128, kb1 = q0 + 160 > SEQ ? SEQ : q0 + 160;
        for (int kb = kb0; kb < kb1; kb += 32) {
            const bf16_t* krow = PAB + ((size_t)b * SEQ + kb + r32) * LDAB + 384 + kvh * 64;
            f32x16 s;
#pragma unroll
            for (int i = 0; i < 16; ++i) s[i] = 0.f;
#pragma unroll
            for (int st = 0; st < 4; ++st) { const bf16x8 kf = *(const bf16x8*)(krow + 16 * st + 8 * hh); s = MFMA32(kf, qf[st], s); }
            bf16x8 vf[2][2];
#pragma unroll
            for (int dt = 0; dt < 2; ++dt) { const bf16_t* vrow = VT + ((size_t)(b * 6 + kvh) * 64 + 32 * dt + r32) * SEQ + kb + 4 * hh;
                vf[dt][0] = ld2x8(vrow, vrow + 8); vf[dt][1] = ld2x8(vrow + 16, vrow + 24); }
            const float qoff = (float)(kb + 4 * hh - qi);
            float t[16]; float mx = m;
#pragma unroll
            for (int reg = 0; reg < 16; ++reg) { const float ad = fabsf(qoff + CRW(reg)); float tv = s[reg] * scale2 - slope2 * ad; tv = (ad <= 128.f) ? tv : -1e30f; t[reg] = tv; mx = fmaxf(mx, tv); }
            mx = fmaxf(mx, __shfl_xor(mx, 32));
            const float alpha = fexp2(m - mx); m = mx;
            float ps = 0.f;
#pragma unroll
            for (int reg = 0; reg < 16; ++reg) { t[reg] = fexp2(t[reg] - m); ps += t[reg]; }
            lsum = lsum * alpha + ps;
#pragma unroll
            for (int i = 0; i < 16; ++i) { O[0][i] *= alpha; O[1][i] *= alpha; }
            const bf16x8 pf0 = packp(t, 0), pf1 = packp(t, 1);
#pragma unroll
            for (int dt = 0; dt < 2; ++dt) { O[dt] = MFMA32(vf[dt][0], pf0, O[dt]); O[dt] = MFMA32(vf[dt][1], pf1, O[dt]); }
        }
        lsum += __shfl_xor(lsum, 32);
        const float inv = 1.f / lsum;
        bf16_t* orow = OB + ((size_t)b * SEQ + qi) * DM + qh * 64;
#pragma unroll
        for (int dt = 0; dt < 2; ++dt)
#pragma unroll
            for (int g4 = 0; g4 < 4; ++g4) {
                u32x2 w = {pk2(O[dt][4 * g4] * inv, O[dt][4 * g4 + 1] * inv), pk2(O[dt][4 * g4 + 2] * inv, O[dt][4 * g4 + 3] * inv)};
                *(u32x2*)(orow + 32 * dt + 8 * g4 + 4 * hh) = w;
            }
    }
}

DI void win_block(const Params& p, int l, int item, int tid, unsigned char* shm) {
    unsigned char* ws = p.ws;
    const bf16_t* PAB = (const bf16_t*)(ws + OFF_PAB); const bf16_t* VT = (const bf16_t*)(ws + OFF_VT); bf16_t* OB = (bf16_t*)(ws + OFF_OB);
    const int lane = tid & 63, wid = tid >> 6, r32 = lane & 31, hh = lane >> 5;
    const int qblk = item & 31, kvh = (item >> 5) & 1, b = item >> 6;
    const int Q0 = qblk * 256, K0 = Q0 - 128;
    {
        const int srow = tid >> 3, sch = tid & 7;
        const int kwoff = srow * 128 + ((sch ^ (srow & 7)) * 16);
        const int vblk = sch >> 1, vhalf = sch & 1;
        const int vwoff0 = 65536 + srow * 128 + (((2 * vblk) ^ (srow & 7)) * 16) + 8 * vhalf;
        const int vwoff1 = 65536 + srow * 128 + (((2 * vblk + 1) ^ (srow & 7)) * 16) + 8 * vhalf;
        __syncthreads();
#pragma unroll 1
        for (int g0 = 0; g0 < 8; g0 += 4) {
            u32x4 kr[4], vr[4];
#pragma unroll
            for (int gg = 0; gg < 4; ++gg) {
                const int g = g0 + gg;
                int kpos = K0 + g * 64 + srow; kpos = kpos < 0 ? 0 : (kpos > SEQ - 1 ? SEQ - 1 : kpos);
                int key0 = K0 + g * 64; key0 = key0 < 0 ? 0 : (key0 > SEQ - 64 ? SEQ - 64 : key0);
                kr[gg] = *(const u32x4*)(PAB + ((size_t)b * SEQ + kpos) * LDAB + 384 + kvh * 64 + sch * 8);
                vr[gg] = *(const u32x4*)(VT + ((size_t)(b * 6 + kvh) * 64 + srow) * SEQ + key0 + sch * 8);
            }
#pragma unroll
            for (int gg = 0; gg < 4; ++gg) {
                const int g = g0 + gg;
                *(u32x4*)(shm + g * 8192 + kwoff) = kr[gg];
                *(u32x2*)(shm + g * 8192 + vwoff0) = (u32x2){vr[gg].x, vr[gg].y}; *(u32x2*)(shm + g * 8192 + vwoff1) = (u32x2){vr[gg].z, vr[gg].w};
            }
        }
        __syncthreads();
    }
    const int q0 = Q0 + wid * 32, qi = q0 + r32;
    const int kb0 = q0 - 128 < 0 ? 0 : q0 - 128, kb1 = q0 + 160 > SEQ ? SEQ : q0 + 160;
#pragma unroll 1
    for (int g3 = 0; g3 < 3; ++g3) {
        const int qh = kvh * 3 + g3;
        const bf16_t* qrow = PAB + ((size_t)b * SEQ + qi) * LDAB + qh * 64;
        bf16x8 qf[4];
#pragma unroll
        for (int st = 0; st < 4; ++st) qf[st] = *(const bf16x8*)(qrow + 16 * st + 8 * hh);
        const float slope2 = exp2f(-8.f * (float)(qh + 1) / 6.f) * LOG2E, scale2 = 0.125f * LOG2E;
        float m = p.in[7][l * 6 + qh] * LOG2E, lsum = hh == 0 ? 1.f : 0.f;
        f32x16 O[2];
#pragma unroll
        for (int i = 0; i < 16; ++i) { O[0][i] = 0.f; O[1][i] = 0.f; }
        for (int kb = kb0; kb < kb1; kb += 32) {
            const int kl = kb - K0, g = kl >> 6, j = (kl >> 5) & 1;
            const unsigned char* Ks = shm + g * 8192; const unsigned char* Vs = shm + 65536 + g * 8192;
            f32x16 s;
#pragma unroll
            for (int i = 0; i < 16; ++i) s[i] = 0.f;
#pragma unroll
            for (int st = 0; st < 4; ++st) { const bf16x8 kf = *(const bf16x8*)(Ks + (32 * j + r32) * 128 + (((2 * st + hh) ^ (r32 & 7)) * 16)); s = MFMA32(kf, qf[st], s); }
            bf16x8 vf[2][2];
#pragma unroll
            for (int dt = 0; dt < 2; ++dt)
#pragma unroll
                for (int s_ = 0; s_ < 2; ++s_) vf[dt][s_] = *(const bf16x8*)(Vs + (32 * dt + r32) * 128 + (((4 * j + 2 * s_ + hh) ^ (r32 & 7)) * 16));
            float qoff = (float)(kb + 4 * hh - qi); asm volatile("" : "+v"(qoff));
            float t[16]; float mx = m;
#pragma unroll
            for (int reg = 0; reg < 16; ++reg) { const float ad = fabsf(qoff + CRW(reg)); float tv = s[reg] * scale2 - slope2 * ad; tv = (ad <= 128.f) ? tv : -1e30f; t[reg] = tv; mx = fmaxf(mx, tv); }
            mx = fmaxf(mx, __shfl_xor(mx, 32));
            const float alpha = fexp2(m - mx); m = mx;
            float ps = 0.f;
#pragma unroll
            for (int reg = 0; reg < 16; ++reg) { t[reg] = fexp2(t[reg] - m); ps += t[reg]; }
            lsum = lsum * alpha + ps;
#pragma unroll
            for (int i = 0; i < 16; ++i) { O[0][i] *= alpha; O[1][i] *= alpha; }
            const bf16x8 pf0 = packp(t, 0), pf1 = packp(t, 1);
#pragma unroll
            for (int dt = 0; dt < 2; ++dt) { O[dt] = MFMA32(vf[dt][0], pf0, O[dt]); O[dt] = MFMA32(vf[dt][1], pf1, O[dt]); }
        }
        lsum += __shfl_xor(lsum, 32);
        const float inv = 1.f / lsum;
        bf16_t* orow = OB + ((size_t)b * SEQ + qi) * DM + qh * 64;
#pragma unroll
        for (int dt = 0; dt < 2; ++dt)
#pragma unroll
            for (int g4 = 0; g4 < 4; ++g4) {
                u32x2 w = {pk2(O[dt][4 * g4] * inv, O[dt][4 * g4 + 1] * inv), pk2(O[dt][4 * g4 + 2] * inv, O[dt][4 * g4 + 3] * inv)};
                *(u32x2*)(orow + 32 * dt + 8 * g4 + 4 * hh) = w;
            }
    }
}

DI bf16x8 scale_frag(bf16x8 v, float sc) {
    u32x4 u = __builtin_bit_cast(u32x4, v), r;
#pragma unroll
    for (int i = 0; i < 4; ++i) r[i] = pk2(bflo(u[i]) * sc, bfhi(u[i]) * sc);
    return __builtin_bit_cast(bf16x8, r);
}
DI void phase_diff(const Params& p, int l, int tid0, unsigned char* shm) {
    unsigned char* ws = p.ws;
    const bf16_t* PAB = (const bf16_t*)(ws + OFF_PAB); const bf16_t* VT = (const bf16_t*)(ws + OFF_VT); bf16_t* OB = (bf16_t*)(ws + OFF_OB);
    const float lam_init = l == 0 ? 0.2f : (0.8f - 0.6f * 0.7408182206817179f);
    float lam;
    {
        const int lane = tid0 & 63;
        const float* dl = p.in[8] + l * 128;
        float a = 0.f, c = 0.f;
        if (lane < 32) { a = dl[lane] * dl[32 + lane]; c = dl[64 + lane] * dl[96 + lane]; }
        a = wave_sum(a); c = wave_sum(c);
        lam = expf(a) - expf(c) + lam_init;
    }
    const float* dg = p.in[9] + l * 64;
    unsigned* qctr = (unsigned*)(ws + OFF_MISC) + 64 + l;
    const unsigned* kmx = (const unsigned*)(ws + OFF_MISC) + l * 32;
    __shared__ unsigned sq_words[32];
    volatile LAS unsigned* sq = (volatile LAS unsigned*)&sq_words[0];
    int first_win = 1536;
    for (;;) {
        int tid = tid0; asm volatile("" : "+v"(tid));
        __syncthreads();
        if (tid == 0) sq[0] = atomicAdd(qctr, 1u);
        __syncthreads();
        const int idx_item = (int)sq[0];
        if (idx_item >= 512) { first_win = idx_item; break; }
        const int lane = tid & 63, wid = tid >> 6, r32 = lane & 31, hh = lane >> 5;
        const int qb = idx_item & 31, b = (idx_item >> 5) & 3, h = 3 - (idx_item >> 7);
        const int q0 = qb * 256 + wid * 32, qi = q0 + r32;
        const bf16_t* qrow = PAB + ((size_t)b * SEQ + qi) * LDAB + 640 + h * 64;
        const float scale2 = 0.17677669529663687f * LOG2E;
        bf16x8 qf[2][2];
#pragma unroll
        for (int mp = 0; mp < 2; ++mp)
#pragma unroll
            for (int st = 0; st < 2; ++st) qf[mp][st] = scale_frag(*(const bf16x8*)(qrow + mp * 32 + 16 * st + 8 * hh), scale2);
        const float slope2 = exp2f(-2.f * (float)(h + 1)) * LOG2E;
        float mA = -1e30f, mB = -1e30f, lA = 0.f, lB = 0.f;
        f32x16 OA[2], OBb[2];
#pragma unroll
        for (int i = 0; i < 16; ++i) { OA[0][i] = 0.f; OA[1][i] = 0.f; OBb[0][i] = 0.f; OBb[1][i] = 0.f; }
        const int srow = tid >> 3, sch = tid & 7;
        const bf16_t* kg = PAB + ((size_t)b * SEQ + srow) * LDAB + 896 + h * 64 + sch * 8;
        const bf16_t* vg = VT + ((size_t)(b * 6 + 2 + h) * 64 + srow) * SEQ + sch * 8;
        const int kwoff = srow * 128 + ((sch ^ (srow & 7)) * 16);
        const int vblk = sch >> 1, vhalf = sch & 1;
        const int vwoff0 = 16384 + srow * 128 + (((2 * vblk) ^ (srow & 7)) * 16) + 8 * vhalf;
        const int vwoff1 = 16384 + srow * 128 + (((2 * vblk + 1) ^ (srow & 7)) * 16) + 8 * vhalf;
        int lo, hi;
        {
            float qa = 0.f, qbm = 0.f;
#pragma unroll
            for (int st = 0; st < 2; ++st) { const u32x4 va = __builtin_bit_cast(u32x4, qf[0][st]), vb = __builtin_bit_cast(u32x4, qf[1][st]);
#pragma unroll
                for (int e = 0; e < 4; ++e) { qa += bflo(va[e]) * bflo(va[e]) + bfhi(va[e]) * bfhi(va[e]); qbm += bflo(vb[e]) * bflo(vb[e]) + bfhi(vb[e]) * bfhi(vb[e]); } }
            qa += __shfl_xor(qa, 32); qbm += __shfl_xor(qbm, 32);
            const float qaL = qa, qbL = qbm;
#pragma unroll
            for (int o = 16; o > 0; o >>= 1) { qa = fmaxf(qa, __shfl_xor(qa, o)); qbm = fmaxf(qbm, __shfl_xor(qbm, o)); }
            if (lane == 0) { sq[8 + 2 * wid] = __float_as_uint(qa); sq[9 + 2 * wid] = __float_as_uint(qbm); }
            __syncthreads();
            float qA = 0.f, qB = 0.f;
#pragma unroll
            for (int w8 = 0; w8 < 8; ++w8) { qA = fmaxf(qA, __uint_as_float(sq[8 + 2 * w8])); qB = fmaxf(qB, __uint_as_float(sq[9 + 2 * w8])); }
            const float kA = __uint_as_float(kmx[b * 8 + h * 2]), kB = __uint_as_float(kmx[b * 8 + h * 2 + 1]);
            mA = -sqrtf(qaL * kA) - 1.f; mB = -sqrtf(qbL * kB) - 1.f;
            const float bnd = 2.02f * fmaxf(sqrtf(qA * kA), sqrtf(qB * kB)) + 1.f;
            const float dsk = (168.f + bnd) / slope2;
            const int Dsk = dsk > 16384.f ? 16384 : (int)dsk + 1;
            const int Q0 = qb * 256;
            const int x = Q0 - 63 - Dsk; lo = x <= 0 ? 0 : (x + 63) >> 6;
            const int y = (Q0 + 255 + Dsk) >> 6; hi = y > 127 ? 127 : y;
        }
        const int d0 = qb * 4, nright = hi - d0 + 1, nstage = hi - lo + 1;
        u32x4 kreg, vreg;
        { const int kb = d0 * 64; kreg = *(const u32x4*)(kg + (size_t)kb * LDAB); vreg = *(const u32x4*)(vg + kb); }
        __syncthreads();
        *(u32x4*)(shm + kwoff) = kreg;
        *(u32x2*)(shm + vwoff0) = (u32x2){vreg.x, vreg.y}; *(u32x2*)(shm + vwoff1) = (u32x2){vreg.z, vreg.w};
        __syncthreads();
        for (int idx = 0; idx < nstage; ++idx) {
            const int kt = idx < nright ? d0 + idx : d0 - 1 - (idx - nright);
            const int buf = idx & 1;
            if (idx + 1 < nstage) {
                const int idn = idx + 1; const int ktn = idn < nright ? d0 + idn : d0 - 1 - (idn - nright);
                const int kbn = ktn * 64;
                kreg = *(const u32x4*)(kg + (size_t)kbn * LDAB); vreg = *(const u32x4*)(vg + kbn);
            }
            const unsigned char* Ks = shm + buf * 8192; const unsigned char* Vs = shm + 16384 + buf * 8192;
#pragma unroll
            for (int j = 0; j < 2; ++j) {
                const int kb = kt * 64 + 32 * j;
                bf16x8 kf[2][2], vf[2][2];
#pragma unroll
                for (int mp = 0; mp < 2; ++mp)
#pragma unroll
                    for (int st = 0; st < 2; ++st) kf[mp][st] = *(const bf16x8*)(Ks + (32 * j + r32) * 128 + (((mp * 4 + 2 * st + hh) ^ (r32 & 7)) * 16));
#pragma unroll
                for (int dt = 0; dt < 2; ++dt)
#pragma unroll
                    for (int s_ = 0; s_ < 2; ++s_) vf[dt][s_] = *(const bf16x8*)(Vs + (32 * dt + r32) * 128 + (((4 * j + 2 * s_ + hh) ^ (r32 & 7)) * 16));
                float qoff = (float)(kb + 4 * hh - qi); asm volatile("" : "+v"(qoff));
                f32x16 tA, tB;
                if (kb >= q0 + 32 || kb + 32 <= q0) {
                    const bool right = kb >= q0 + 32;
                    const float Lq = right ? -slope2 * qoff : slope2 * qoff;
                    const float LA = Lq - mA, LB = Lq - mB, sl = right ? -slope2 : slope2;
#pragma unroll
                    for (int reg = 0; reg < 16; ++reg) { tA[reg] = __builtin_fmaf(sl, CRW(reg), LA); tB[reg] = __builtin_fmaf(sl, CRW(reg), LB); }
                } else {
#pragma unroll
                    for (int reg = 0; reg < 16; ++reg) { const float bias = -slope2 * fabsf(qoff + CRW(reg)); tA[reg] = bias - mA; tB[reg] = bias - mB; }
                }
                tA = MFMA32(kf[0][0], qf[0][0], tA); tA = MFMA32(kf[0][1], qf[0][1], tA);
                tB = MFMA32(kf[1][0], qf[1][0], tB); tB = MFMA32(kf[1][1], qf[1][1], tB);
                float mxA = 0.f, mxB = 0.f;
#pragma unroll
                for (int reg = 0; reg < 16; ++reg) { mxA = fmaxf(mxA, tA[reg]); mxB = fmaxf(mxB, tB[reg]); }
                mxA = fmaxf(mxA, __shfl_xor(mxA, 32)); mxB = fmaxf(mxB, __shfl_xor(mxB, 32));
                if (__builtin_amdgcn_ballot_w64(mxA > 0.f) != 0ull) {
                    const float alpha = fexp2(-mxA); mA += mxA; lA *= alpha;
#pragma unroll
                    for (int i = 0; i < 16; ++i) { OA[0][i] *= alpha; OA[1][i] *= alpha; tA[i] -= mxA; }
                }
                if (__builtin_amdgcn_ballot_w64(mxB > 0.f) != 0ull) {
                    const float alpha = fexp2(-mxB); mB += mxB; lB *= alpha;
#pragma unroll
                    for (int i = 0; i < 16; ++i) { OBb[0][i] *= alpha; OBb[1][i] *= alpha; tB[i] -= mxB; }
                }
                float psA = 0.f, psB = 0.f;
#pragma unroll
                for (int reg = 0; reg < 16; ++reg) { tA[reg] = fexp2(tA[reg]); psA += tA[reg]; tB[reg] = fexp2(tB[reg]); psB += tB[reg]; }
                lA += psA; lB += psB;
                const bf16x8 pA0 = packpv(tA, 0), pA1 = packpv(tA, 1), pB0 = packpv(tB, 0), pB1 = packpv(tB, 1);
#pragma unroll
                for (int dt = 0; dt < 2; ++dt) {
                    OA[dt] = MFMA32(vf[dt][0], pA0, OA[dt]); OA[dt] = MFMA32(vf[dt][1], pA1, OA[dt]);
                    OBb[dt] = MFMA32(vf[dt][0], pB0, OBb[dt]); OBb[dt] = MFMA32(vf[dt][1], pB1, OBb[dt]);
                }
            }
            if (idx + 1 < nstage) {
                unsigned char* wb = shm + (buf ^ 1) * 8192;
                *(u32x4*)(wb + kwoff) = kreg;
                *(u32x2*)(wb + vwoff0) = (u32x2){vreg.x, vreg.y}; *(u32x2*)(wb + vwoff1) = (u32x2){vreg.z, vreg.w};
            }
            __syncthreads();
        }
        lA += __shfl_xor(lA, 32); lB += __shfl_xor(lB, 32);
        const float iA = 1.f / lA, iB = lam / lB;
        float ss = 0.f;
#pragma unroll
        for (int dt = 0; dt < 2; ++dt)
#pragma unroll
            for (int i = 0; i < 16; ++i) { const float v = OA[dt][i] * iA - OBb[dt][i] * iB; OA[dt][i] = v; ss += v * v; }
        ss += __shfl_xor(ss, 32);
        const float rstd = __builtin_amdgcn_rsqf(ss * (1.f / 64.f) + EPS) * (1.f - lam_init);
        bf16_t* orow = OB + ((size_t)b * SEQ + qi) * DM + 384 + h * 64;
#pragma unroll
        for (int dt = 0; dt < 2; ++dt)
#pragma unroll
            for (int g4 = 0; g4 < 4; ++g4) {
                const int d = 32 * dt + 8 * g4 + 4 * hh;
                const f32x4 gv = *(const f32x4*)(dg + d);
                u32x2 w = {pk2(OA[dt][4 * g4] * rstd * gv[0], OA[dt][4 * g4 + 1] * rstd * gv[1]), pk2(OA[dt][4 * g4 + 2] * rstd * gv[2], OA[dt][4 * g4 + 3] * rstd * gv[3])};
                *(u32x2*)(orow + d) = w;
            }
    }
    for (int item = first_win; item < 1536;) {
        int tid = tid0; asm volatile("" : "+v"(tid));
        if (item < 768) win_block(p, l, item - 512, tid, shm);
        else {
            const int j = item - 768, seq = j >> 4;
            if (tid == 0) {
                unsigned* flag = (unsigned*)(ws + OFF_MISC) + 128 + l * 64 + seq; unsigned sp = 0u;
                while (__hip_atomic_load(flag, __ATOMIC_RELAXED, __HIP_MEMORY_SCOPE_AGENT) == 0u) { __builtin_amdgcn_s_sleep(2); if (++sp > (1u << 22)) break; }
                __builtin_amdgcn_fence(__ATOMIC_ACQUIRE, "agent");
                asm volatile("s_waitcnt vmcnt(0)" ::: "memory");
            }
            __syncthreads();
            phase_outp(p, j * 8 + (tid >> 6), 6144, tid & 63);
        }
        __syncthreads();
        if (tid == 0) sq[0] = atomicAdd(qctr, 1u);
        __syncthreads();
        item = (int)sq[0];
    }
}

DI void phase_post(const Params& p, int l, int gw, int nw, int lane) {
    unsigned char* ws = p.ws;
    const bf16_t* OT = (const bf16_t*)(ws + OFF_WB); const bf16_t* PAB = (const bf16_t*)(ws + OFF_PAB); bf16_t* OB = (bf16_t*)(ws + OFF_OB);
    const float gl = p.in[12][l * 64 + lane];
    for (int u = gw; u < 6144; u += nw) {
        const int half = u & 1, h = (u % 12) >> 1, ck = u / 12, b = ck >> 7, chunk = ck & 127;
        const size_t itf = ((size_t)((b * 6 + h) * 2) * 128 + chunk), itb = ((size_t)((b * 6 + h) * 2 + 1) * 128 + (127 - chunk));
        const size_t tok0 = (size_t)b * SEQ + chunk * 64 + half * 32;
#pragma unroll 1
        for (int g = 0; g < 2; ++g) {
            float av[16], zv[16];
#pragma unroll
            for (int j = 0; j < 16; ++j) {
                const int t = half * 32 + g * 16 + j;
                av[j] = bf2f(OT[itf * 4096 + t * 64 + lane]) + bf2f(OT[itb * 4096 + (63 - t) * 64 + lane]);
                zv[j] = bf2f(PAB[(tok0 + g * 16 + j) * LDAB + 1408 + h * 64 + lane]);
            }
#pragma unroll
            for (int j = 0; j < 16; ++j) {
                const float ss = wave_sum(av[j] * av[j]);
                const float y = av[j] * __builtin_amdgcn_rsqf(ss * (1.f / 64.f) + EPS) * gl;
                OB[(tok0 + g * 16 + j) * DM + 640 + h * 64 + lane] = f2bf(y * silu(zv[j]));
            }
        }
    }
}

#define XB_TMO      128
#define XB_XCNT(j)  (256  + 64 * (j))
#define XB_XSUB(j)  (1280 + 64 * (j))
#define XB_XGEN(j)  (2304 + 64 * (j))
#define XB_TOP      3328
#define XB_TOPGEN   3392
#define XCD_BAR_WORDS 3456
#define XB_SPIN_CAP (1u << 18)
DI unsigned xb_ld(unsigned* p)              { return __hip_atomic_load(p, __ATOMIC_RELAXED, __HIP_MEMORY_SCOPE_AGENT); }
DI unsigned xb_add(unsigned* p, unsigned v) { return __hip_atomic_fetch_add(p, v, __ATOMIC_RELAXED, __HIP_MEMORY_SCOPE_AGENT); }
DI unsigned xb_xcc_id() { return (unsigned)__builtin_amdgcn_s_getreg((3 << 11) | 20) & 0xFu; }
#define XB_SPIN(cond, bar) do { unsigned _sp = 0; while (cond) { __builtin_amdgcn_s_sleep(1); \
    if ((++_sp & 255u) == 0u) { if (xb_ld(&(bar)[XB_TMO])) break; if (_sp > XB_SPIN_CAP) { atomicAdd(&(bar)[XB_TMO], 1u); break; } } } } while (0)
struct XcdBarrier { unsigned* bar; unsigned x; volatile LAS unsigned* st; };
DI XcdBarrier xcd_barrier_post(unsigned* bar, volatile LAS unsigned* st) {
    XcdBarrier b; b.bar = bar; b.x = xb_xcc_id(); b.st = st;
    if (threadIdx.x == 0) (void)xb_add(&bar[XB_XCNT(b.x)], 1u);
    return b;
}
DI void xcd_barrier_complete(unsigned* bar, unsigned x, unsigned& nloc, unsigned& nx) {
    const unsigned G = gridDim.x * gridDim.y * gridDim.z;
    unsigned sum, cnt, mine, sp = 0u;
    for (;;) {
        sum = 0u; cnt = 0u; mine = 0u;
#pragma unroll
        for (unsigned j = 0; j < 16; ++j) { const unsigned c = xb_ld(&bar[XB_XCNT(j)]); sum += c; cnt += (c > 0u) ? 1u : 0u; mine = (j == x) ? c : mine; }
        if (sum == G) break;
        __builtin_amdgcn_s_sleep(1);
        if ((++sp & 255u) == 0u) { if (xb_ld(&bar[XB_TMO])) break; if (sp > XB_SPIN_CAP) { atomicAdd(&bar[XB_TMO], 1u); break; } }
    }
    nloc = mine > 0u ? mine : 1u; nx = cnt > 0u ? cnt : 1u;
}
DI void xcd_barrier(const XcdBarrier& b) {
    asm volatile("s_waitcnt vmcnt(0)" ::: "memory");
    __syncthreads();
    if (threadIdx.x == 0) {
        unsigned* bar = b.bar;
        __builtin_amdgcn_s_waitcnt(0);
        unsigned nloc = b.st[0], nx = b.st[1];
        if (nloc == 0u) { xcd_barrier_complete(bar, b.x, nloc, nx); b.st[0] = nloc; b.st[1] = nx; }
        const unsigned old = xb_add(&bar[XB_XSUB(b.x)], 1u);
        const unsigned gen = old / nloc;
        if (old + 1u == (gen + 1u) * nloc) {
            __builtin_amdgcn_fence(__ATOMIC_RELEASE, "agent");
            asm volatile("s_waitcnt vmcnt(0)" ::: "memory");
            const unsigned og = xb_add(&bar[XB_TOP], 1u);
            const unsigned tg = og / nx;
            if (og + 1u == (tg + 1u) * nx) xb_add(&bar[XB_TOPGEN], 1u);
            else XB_SPIN(xb_ld(&bar[XB_TOPGEN]) == tg, bar);
            __builtin_amdgcn_fence(__ATOMIC_ACQUIRE, "agent");
            xb_add(&bar[XB_XGEN(b.x)], 1u);
            asm volatile("s_waitcnt vmcnt(0)" ::: "memory");
        } else {
            XB_SPIN(xb_ld(&bar[XB_XGEN(b.x)]) == gen, bar);
            __builtin_amdgcn_fence(__ATOMIC_ACQUIRE, "agent");
            asm volatile("s_waitcnt vmcnt(0)" ::: "memory");
        }
    }
    __syncthreads();
}

constexpr int NPHASE = 30;
DI void run_phase(const Params& p, int ph, unsigned char* shm, int tid) {
    const int wid = tid >> 6, lane = tid & 63;
    const int gw = blockIdx.x * 8 + wid, nw = gridDim.x * 8;
    unsigned char* ws = p.ws;
    if (ph == 0) { if (EN(0)) { phase_init(p, gw, nw, lane); phase_convw(p, 0, shm, tid); } return; }
    if (ph == NPHASE - 1) { if (EN(27)) phase_final(p, gw, nw, lane); return; }
    const int l = (ph - 1) / 14, sub = (ph - 1) % 14;
    float* rss = (float*)(ws + OFF_RSS);
    bf16_t* XB = (bf16_t*)(ws + OFF_XB);
    LAS unsigned char* lds = (LAS unsigned char*)shm;
    pg8::StaticOrder S;
    if (sub == 0) { if (EN(0)) if (l > 0) phase_convw(p, l, shm, tid); return; }
    if (EN(1)) if (sub == 1 || sub == 12) {
        const int f = sub == 1 ? 0 : 1;
        pg8::Gemm g{XB, (const bf16_t*)(ws + (f ? OFF_W_FFN2IN : OFF_W_FFN1IN)), MTOK, NFF, DM};
        EpiSwiglu E{(bf16_t*)(ws + OFF_BIG), rss + (size_t)((3 * l + (f ? 2 : 0)) & 1) * MTOK * 16};
        S.init(MTOK, NFF, gridDim.x, blockIdx.x);
        pg8::gemm_phase(tid, lds, g, S, E);
        if ((REPMASK >> 1) & 1) { __syncthreads(); pg8::gemm_phase(tid, lds, g, S, E); }
        return;
    }
    if (EN(2)) if (sub == 2 || sub == 13 || sub == 11) {
        const bf16_t* A; const bf16_t* Bt; int K; float scale; int nn;
        if (sub == 2) { A = (const bf16_t*)(ws + OFF_BIG); Bt = (const bf16_t*)(ws + OFF_W_FFN1OUT); K = DFFP; scale = 0.5f; nn = 3 * l + 1; }
        else if (sub == 13) { A = (const bf16_t*)(ws + OFF_BIG); Bt = (const bf16_t*)(ws + OFF_W_FFN2OUT); K = DFFP; scale = 0.5f; nn = 3 * l + 3; }
        else { A = (const bf16_t*)(ws + OFF_OB); Bt = (const bf16_t*)(ws + OFF_W_MIXOUT); K = DM; scale = 1.f; nn = 3 * l + 2; }
        pg8::Gemm g{A, Bt, MTOK, DM, K};
        EpiResid E{(l == 0 && sub == 2) ? p.in[0] : (const float*)p.out, p.out, XB, rss + (size_t)(nn & 1) * MTOK * 16, scale};
        S.init(MTOK, DM, gridDim.x, blockIdx.x);
        pg8::gemm_phase(tid, lds, g, S, E); return;
    }
    if (EN(3)) if (sub == 3) {
        pg8::Gemm g{XB, (const bf16_t*)(ws + OFF_W_MIXIN), MTOK, NMIX, DM};
        EpiMixIn E{(bf16_t*)(ws + OFF_PAB), (bf16_t*)(ws + OFF_PC), (float*)(ws + OFF_BG), rss + (size_t)((3 * l + 1) & 1) * MTOK * 16};
        S.init(MTOK, NMIX, gridDim.x, blockIdx.x);
        pg8::gemm_phase(tid, lds, g, S, E);
        return;
    }
    if (EN(4)) if (sub == 4) { REP(4) phase_prep(p, l, gw, nw, lane); return; }
    if (EN(5)) if (sub == 5) { REP(5) phase_chunk(p, l, gw, nw, lane, wid, shm); return; }
    if (EN(6)) if (sub == 6) {
        if (blockIdx.x < 48) phase_scan(p, l, lane, wid, shm);
        phase_diff(p, l, tid, shm);
        return;
    }


    if (EN(9)) if (sub == 10) { REP(9) phase_post(p, l, gw, nw, lane); return; }
}

__global__ __launch_bounds__(512, 2) void mega(Params p) {
    extern __shared__ __attribute__((aligned(16))) unsigned char shm[];
    __shared__ uint4 xb_words;
    if (threadIdx.x == 0) xb_words = make_uint4(0u, 0u, 0u, 0u);
    __syncthreads();
    const XcdBarrier xb = xcd_barrier_post((unsigned*)(p.ws + OFF_BAR), (volatile LAS unsigned*)&xb_words);
#ifndef PROBE_DUP
    for (int ph = p.p0; ph < p.p1; ++ph) {
        if (ph == 1 || ph == 8 || ph == 9 || ph == 10 || ph == 22 || ph == 23 || ph == 24) continue;
        int tid = threadIdx.x; asm volatile("" : "+v"(tid));
        Params q = p;
#if defined(__HIP_DEVICE_COMPILE__)
        {
            typedef __attribute__((address_space(1))) unsigned char GUC; typedef __attribute__((address_space(1))) float GF; typedef __attribute__((address_space(1))) const float GCF;
            unsigned long long wsi = (unsigned long long)p.ws, oi = (unsigned long long)p.out; asm volatile("" : "+s"(wsi), "+s"(oi));
            q.ws = (unsigned char*)(GUC*)wsi; q.out = (float*)(GF*)oi;
#pragma unroll
            for (int ii = 0; ii < 18; ++ii) q.in[ii] = (const float*)(GCF*)(unsigned long long)p.in[ii];
        }
#endif
        run_phase(q, ph, shm, tid);
        if (ph + 1 < p.p1) {
            if (ph == 0) cg::this_grid().sync();
            else xcd_barrier(xb);
        }
    }
#else
    for (int st = 0; st < 2 * NPHASE; ++st) {
        const int ph = st >> 1;
        if (ph == 1 || ph == 8 || ph == 9 || ph == 10 || ph == 22 || ph == 23 || ph == 24) continue;
        const int subp = (ph >= 1 && ph <= 28) ? (ph - 1) % 14 : (ph == 0 ? 14 : 15);
        if ((st & 1) && !((PROBE_DUP >> subp) & 1)) continue;
        int tid = threadIdx.x; asm volatile("" : "+v"(tid));
        Params q = p; asm volatile("" : "+s"(q.ws), "+s"(q.out));
        run_phase(q, ph, shm, tid);
        cg::this_grid().sync();
    }
#endif
}

extern "C" void kernel_launch(void* const* d_in, const int* in_sizes, int n_in, void* d_out, int out_size, void* d_ws, size_t ws_size, hipStream_t stream) {
    static int grid = 0;
    if (!grid) {
        hipFuncSetAttribute((const void*)mega, hipFuncAttributeMaxDynamicSharedMemorySize, LDS_BYTES);
        int dev = 0, cus = 0, per = 0;
        hipGetDevice(&dev);
        hipDeviceGetAttribute(&cus, hipDeviceAttributeMultiprocessorCount, dev);
        hipOccupancyMaxActiveBlocksPerMultiprocessor(&per, mega, 512, LDS_BYTES);
        if (per < 1) per = 1;
        grid = cus * per;
        if (grid > 256) grid = 256;
    }
    (void)hipMemsetAsync((unsigned char*)d_ws + OFF_BAR, 0, 3456 * 4, stream);
    Params p{};
    for (int i = 0; i < 18; ++i) p.in[i] = (const float*)d_in[i];
    p.out = (float*)d_out; p.ws = (unsigned char*)d_ws;
#if MULTI
    for (int ph = 0; ph < NPHASE; ++ph) {
        if (ph == 1 || ph == 8 || ph == 9 || ph == 10 || ph == 22 || ph == 23 || ph == 24) continue;
        p.p0 = ph; p.p1 = ph + 1;
        hipLaunchKernelGGL(mega, dim3(grid), dim3(512), LDS_BYTES, stream, p);
    }
#else
    p.p0 = 0; p.p1 = NPHASE;
    void* args[] = {&p};
    hipError_t e = hipLaunchCooperativeKernel((const void*)mega, dim3(grid), dim3(512), args, LDS_BYTES, stream);
    if (e != hipSuccess) fprintf(stderr, "cooperative launch failed: %s (grid %d)\n", hipGetErrorString(e), grid);
#endif
}
```

```cpp
#include <hip/hip_runtime.h>
#include <hip/hip_cooperative_groups.h>
#include <cstdio>
namespace cg = cooperative_groups;


#ifndef REPMASK
#define REPMASK 0
#endif
#define REP(k) for (int rep_ = 0; rep_ < (((REPMASK >> (k)) & 1) ? 2 : 1); ++rep_)
#ifndef MULTI
#define MULTI 0
#endif

#ifdef ONLY
#define EN(k) (ONLY==(k))
#else
#define EN(k) 1
#endif
#define DI __device__ __forceinline__
#define LAS __attribute__((address_space(3)))
typedef unsigned short bf16_t;
typedef short bf16x8 __attribute__((ext_vector_type(8)));
typedef short s16x4 __attribute__((ext_vector_type(4)));
typedef float f32x4 __attribute__((ext_vector_type(4)));
typedef float f32x16 __attribute__((ext_vector_type(16)));
typedef float f32x2 __attribute__((ext_vector_type(2)));
typedef unsigned u32x4 __attribute__((ext_vector_type(4)));
typedef unsigned u32x2 __attribute__((ext_vector_type(2)));
typedef __bf16 bf16v2 __attribute__((ext_vector_type(2)));

constexpr int DM = 1024, NBATCH = 4, SEQ = 8192, MTOK = NBATCH * SEQ, DFF = 2752, DFFP = 2816, NFF = 2 * DFFP, NMIX = 3072;
constexpr int LDAB = 1792, LDC = 1280;
constexpr float EPS = 1e-6f, LOG2E = 1.4426950408889634f;
constexpr int LDS_BYTES = 131072;

constexpr size_t SZ_W_FFNIN = (size_t)NFF * DM * 2, SZ_W_FFNOUT = (size_t)DM * DFFP * 2, SZ_W_MIXIN = (size_t)NMIX * DM * 2, SZ_W_MIXOUT = (size_t)DM * DM * 2;
constexpr size_t OFF_W_FFN1IN = 0;
constexpr size_t OFF_W_FFN1OUT = OFF_W_FFN1IN + SZ_W_FFNIN;
constexpr size_t OFF_W_MIXIN = OFF_W_FFN1OUT + SZ_W_FFNOUT;
constexpr size_t OFF_W_MIXOUT = OFF_W_MIXIN + SZ_W_MIXIN;
constexpr size_t OFF_W_FFN2IN = OFF_W_MIXOUT + SZ_W_MIXOUT;
constexpr size_t OFF_W_FFN2OUT = OFF_W_FFN2IN + SZ_W_FFNIN;
constexpr size_t OFF_XB = OFF_W_FFN2OUT + SZ_W_FFNOUT;
constexpr size_t SZ_TILE = (size_t)3072 * 4096 * 2;
constexpr size_t OFF_QC = OFF_XB, OFF_KTC = OFF_XB + SZ_TILE;
constexpr size_t OFF_OB = OFF_XB + (size_t)MTOK * DM * 2;
constexpr size_t OFF_BIG = OFF_OB + (size_t)MTOK * DM * 2;
constexpr size_t OFF_PAB = OFF_BIG, OFF_PC = OFF_BIG + (size_t)MTOK * LDAB * 2;
constexpr size_t OFF_U = OFF_PC, OFF_WB = OFF_PC + (size_t)6144 * 8192;
constexpr size_t OFF_BG = OFF_WB + (size_t)6144 * 8192;
constexpr size_t OFF_RSS = OFF_BG + (size_t)MTOK * 24 * 4;
constexpr size_t OFF_VT = OFF_RSS + (size_t)2 * MTOK * 16 * 4;
constexpr size_t OFF_KC = OFF_VT + (size_t)NBATCH * 6 * 64 * SEQ * 2;
constexpr size_t OFF_VTC = OFF_KC + SZ_TILE;
constexpr size_t OFF_SST = OFF_KC;
constexpr size_t OFF_QK = OFF_VTC + SZ_TILE;
constexpr size_t OFF_GC = OFF_QK + (size_t)6144 * 8192;
constexpr size_t OFF_MISC = OFF_GC + (size_t)6144 * 64 * 4;
constexpr size_t OFF_BAR = OFF_MISC + 512;
constexpr size_t WS_TOTAL = OFF_BAR + 3456 * 4;
static_assert(WS_TOTAL <= (size_t)536870912, "workspace too large");
static_assert((size_t)MTOK * DFFP * 2 <= OFF_BG - OFF_BIG, "hidden does not fit");

struct Params {
    const float* in[18];
    float* out;
    unsigned char* ws;
    int p0, p1;
};

DI unsigned pk2(float a, float b) { f32x2 v = {a, b}; bf16v2 r = __builtin_convertvector(v, bf16v2); return __builtin_bit_cast(unsigned, r); }
DI bf16_t f2bf(float a) { return (bf16_t)(pk2(a, 0.f) & 0xffffu); }
DI float bf2f(bf16_t v) { return __uint_as_float(((unsigned)v) << 16); }
DI float bflo(unsigned v) { return __uint_as_float(v << 16); }
DI float bfhi(unsigned v) { return __uint_as_float(v & 0xffff0000u); }
DI float wave_sum(float v) {
    v += __builtin_bit_cast(float, __builtin_amdgcn_update_dpp(0, __builtin_bit_cast(int, v), 0xB1, 0xf, 0xf, true));
    v += __builtin_bit_cast(float, __builtin_amdgcn_update_dpp(0, __builtin_bit_cast(int, v), 0x4E, 0xf, 0xf, true));
    v += __builtin_bit_cast(float, __builtin_amdgcn_update_dpp(0, __builtin_bit_cast(int, v), 0x141, 0xf, 0xf, true));
    v += __builtin_bit_cast(float, __builtin_amdgcn_update_dpp(0, __builtin_bit_cast(int, v), 0x140, 0xf, 0xf, true));
    const int iv = __builtin_bit_cast(int, v);
    const float a = __builtin_bit_cast(float, __builtin_amdgcn_readlane(iv, 0)), b = __builtin_bit_cast(float, __builtin_amdgcn_readlane(iv, 16));
    const float c = __builtin_bit_cast(float, __builtin_amdgcn_readlane(iv, 32)), d = __builtin_bit_cast(float, __builtin_amdgcn_readlane(iv, 48));
    return (a + b) + (c + d);
}
DI bf16x8 ld2x8(const bf16_t* a, const bf16_t* b) { u32x2 x = *(const u32x2*)a, y = *(const u32x2*)b; u32x4 r = {x.x, x.y, y.x, y.y}; return __builtin_bit_cast(bf16x8, r); }
DI unsigned rot16(unsigned x) { return (x >> 16) | (x << 16); }
DI bf16x8 ld2x8rev(const bf16_t* a, const bf16_t* b) {
    u32x2 x = *(const u32x2*)a, y = *(const u32x2*)b; u32x4 r = {rot16(x.y), rot16(x.x), rot16(y.y), rot16(y.x)}; return __builtin_bit_cast(bf16x8, r);
}
DI bf16x8 pack8(f32x4 a, f32x4 b) { u32x4 r = {pk2(a[0], a[1]), pk2(a[2], a[3]), pk2(b[0], b[1]), pk2(b[2], b[3])}; return __builtin_bit_cast(bf16x8, r); }
DI float fexp2(float x) { return __builtin_amdgcn_exp2f(x); }
DI float fexp(float x) { return __builtin_amdgcn_exp2f(x * LOG2E); }
DI float silu(float x) { return x * __builtin_amdgcn_rcpf(1.f + fexp(-x)); }
DI float row_rstd(const float* rp, int row) {
    const f32x4 a = *(const f32x4*)(rp + (size_t)row * 16), b = *(const f32x4*)(rp + (size_t)row * 16 + 4), c = *(const f32x4*)(rp + (size_t)row * 16 + 8), d = *(const f32x4*)(rp + (size_t)row * 16 + 12);
    const float s = ((a[0] + a[1]) + (a[2] + a[3])) + ((b[0] + b[1]) + (b[2] + b[3])) + ((c[0] + c[1]) + (c[2] + c[3])) + ((d[0] + d[1]) + (d[2] + d[3]));
    return __builtin_amdgcn_rsqf(s * (1.f / DM) + EPS);
}
#define MFMA16(a, b, c) __builtin_amdgcn_mfma_f32_16x16x32_bf16((a), (b), (c), 0, 0, 0)
#define MFMA32(a, b, c) __builtin_amdgcn_mfma_f32_32x32x16_bf16((a), (b), (c), 0, 0, 0)

namespace pg8 {
constexpr int BM = 256, BK = 64, HALF = 128, HTB = HALF * BK * 2, STAGE_BYTES = 8 * HTB, NXCD = 8, WGM = 8;
DI int lds_byte(int r, int c) { const int st = (r >> 4) * 2 + (c >> 5), rr = r & 15, cc = c & 31, ob = rr * 64 + cc * 2; return st * 1024 + (ob ^ (((ob >> 9) & 1) << 5)); }
DI void stage_rc(int b, int& R, int& C) { const int st = b / 1024, sb = b % 1024, swz = sb ^ (((sb >> 9) & 1) << 5); R = (st >> 1) * 16 + swz / 64; C = (st & 1) * 32 + (swz % 64) / 2; }
DI int perm32(int rho) { const int n = rho >> 4, i = rho & 15; return 8 * (i >> 2) + 4 * n + (i & 3); }
struct Unit { int pm, pn; };
struct Gemm { const bf16_t* A; const bf16_t* Bt; int M, N, K; };
struct StaticOrder {
    int nM, nN, nwg, G, c;
    DI void init(int M, int N, int G_, int c_) { nM = M / BM; nN = N / BM; nwg = nM * nN; G = G_; c = c_; }
    DI bool next(int i, Unit& u) const {
        const long L = (long)i * G + c; if (L >= nwg) return false;
        int wgid = (int)L; { const int q = nwg / NXCD, r = nwg % NXCD, xcd = wgid % NXCD, off = wgid / NXCD; wgid = (xcd < r ? xcd * (q + 1) : r * (q + 1) + (xcd - r) * q) + off; }
        const int nig = WGM * nN, gid = wgid / nig, fm = gid * WGM, gsz = (nM - fm) < WGM ? (nM - fm) : WGM;
        u.pm = fm + ((wgid % nig) % gsz); u.pn = (wgid % nig) / gsz; return true;
    }
};
template <class Epi>
DI void gemm_phase(int tid, LAS unsigned char* lds, const Gemm g, const StaticOrder& S, const Epi& E) {
    const int wid = __builtin_amdgcn_readfirstlane(tid >> 6), lane = tid & 63, wr = wid >> 2, wc = wid & 3, fr = lane & 15, fq = lane >> 4;
    const int K = g.K, nt = K / BK;
    unsigned voffA[2], voffB[2];
#pragma unroll
    for (int i = 0; i < 2; ++i) { int R, C; stage_rc(tid * 16 + i * 8192, R, C); const int Rb = (R & ~31) + perm32(R & 31);
        voffA[i] = (unsigned)(R * K + C) * 2u; voffB[i] = (unsigned)(Rb * K + C) * 2u; }
    const size_t kstep = (size_t)(BK * 2);
    const size_t hstep = (size_t)HALF * K * 2;
    const size_t tstep = 2 * hstep;
    const unsigned ldsw = (unsigned)wid * 1024u;
    const int aoff = lds_byte(wr * 64 + fr, fq * 8), boff = lds_byte(wc * 32 + fr, fq * 8);
#define PG8_SA(b, h) (((b) * 2 + (h)) * HTB)
#define PG8_SB(b, h) ((4 + (b) * 2 + (h)) * HTB)
#define PG8_STAGE(bufoff, gbase, voff) do { _Pragma("unroll") for (int _i = 0; _i < 2; ++_i) \
        __builtin_amdgcn_global_load_lds((const unsigned*)((const char*)(gbase) + (voff)[_i]), (LAS unsigned*)(lds + (bufoff) + ldsw + _i * 8192), 16, 0, 0); } while (0)
#define PG8_LDA(dst, b, h) do { _Pragma("unroll") for (int m = 0; m < 4; ++m) _Pragma("unroll") for (int k = 0; k < 2; ++k) dst[m][k] = *(const LAS bf16x8*)(lds + PG8_SA(b, h) + aoff + m * 2048 + k * 1024); } while (0)
#define PG8_LDB(dst, b, h) do { _Pragma("unroll") for (int n = 0; n < 2; ++n) _Pragma("unroll") for (int k = 0; k < 2; ++k) dst[n][k] = *(const LAS bf16x8*)(lds + PG8_SB(b, h) + boff + n * 2048 + k * 1024); } while (0)
#define PG8_MMA(ai, bj, At, Bt) do { __builtin_amdgcn_s_setprio(1); _Pragma("unroll") for (int m = 0; m < 4; ++m) _Pragma("unroll") for (int n = 0; n < 2; ++n) _Pragma("unroll") for (int k = 0; k < 2; ++k) \
        acc[ai][bj][m][n] = __builtin_amdgcn_mfma_f32_16x16x32_bf16(Bt[n][k], At[m][k], acc[ai][bj][m][n], 0, 0, 0); __builtin_amdgcn_s_setprio(0); } while (0)
#define PG8_WAIT_V(n) asm volatile("s_waitcnt vmcnt(" #n ")" ::: "memory")
#define PG8_WAIT_L(n) asm volatile("s_waitcnt lgkmcnt(" #n ")" ::: "memory")
#define PG8_BAR __builtin_amdgcn_s_barrier()
#define PG8_SCHED __builtin_amdgcn_sched_barrier(0)
    Unit cur, nxt; int ui = 0;
    if (!S.next(0, cur)) return;
    f32x4 acc[2][2][4][2];
#pragma unroll
    for (int a = 0; a < 2; ++a)
#pragma unroll
        for (int b = 0; b < 2; ++b)
#pragma unroll
            for (int m = 0; m < 4; ++m)
#pragma unroll
                for (int n = 0; n < 2; ++n) acc[a][b][m][n] = (f32x4){0.f, 0.f, 0.f, 0.f};
    bf16x8 At[4][2], B0[2][2], B1[2][2];
    const char* cA = (const char*)g.A + (size_t)cur.pm * tstep; const char* cB = (const char*)g.Bt + (size_t)cur.pn * tstep;
    PG8_STAGE(PG8_SB(0, 0), cB, voffB); PG8_STAGE(PG8_SB(0, 1), cB + hstep, voffB); PG8_STAGE(PG8_SA(0, 0), cA, voffA); PG8_STAGE(PG8_SA(0, 1), cA + hstep, voffA);
    if (wr == 1) PG8_BAR;
    PG8_WAIT_V(2); PG8_BAR;
    PG8_STAGE(PG8_SB(1, 0), cB + kstep, voffB); PG8_STAGE(PG8_SA(1, 0), cA + kstep, voffA); PG8_STAGE(PG8_SB(1, 1), cB + hstep + kstep, voffB);
    PG8_WAIT_V(6); PG8_BAR;
    for (;;) {
        const bool has_next = S.next(ui + 1, nxt);
        const char* nA = has_next ? (const char*)g.A + (size_t)nxt.pm * tstep : cA; const char* nB = has_next ? (const char*)g.Bt + (size_t)nxt.pn * tstep : cB;
        for (int t = 0; t < nt; t += 2) {
            const bool last = (t == nt - 2);
            const char* a1 = cA + (size_t)(t + 1) * kstep;
            const char* a2 = last ? nA : cA + (size_t)(t + 2) * kstep; const char* b2 = last ? nB : cB + (size_t)(t + 2) * kstep;
            const char* a3 = a2 + kstep; const char* b3 = b2 + kstep;
            PG8_LDB(B0, 0, 0); PG8_LDB(B1, 0, 1); PG8_SCHED; PG8_LDA(At, 0, 0); PG8_STAGE(PG8_SA(1, 1), a1 + hstep, voffA);
            PG8_WAIT_V(8); PG8_WAIT_L(0); PG8_BAR; PG8_MMA(0, 0, At, B0); PG8_MMA(0, 1, At, B1); PG8_BAR; PG8_SCHED;
            PG8_LDA(At, 0, 1); PG8_STAGE(PG8_SB(0, 0), b2, voffB); PG8_STAGE(PG8_SB(0, 1), b2 + hstep, voffB); PG8_STAGE(PG8_SA(0, 0), a2, voffA);
            PG8_WAIT_V(8); PG8_WAIT_L(0); PG8_BAR; PG8_MMA(1, 0, At, B0); PG8_MMA(1, 1, At, B1); PG8_BAR; PG8_SCHED;
            PG8_LDB(B0, 1, 0); PG8_LDB(B1, 1, 1); PG8_SCHED; PG8_LDA(At, 1, 0); PG8_STAGE(PG8_SA(0, 1), a2 + hstep, voffA);
            PG8_WAIT_V(8); PG8_WAIT_L(0); PG8_BAR; PG8_MMA(0, 0, At, B0); PG8_MMA(0, 1, At, B1); PG8_BAR; PG8_SCHED;
            PG8_LDA(At, 1, 1); PG8_STAGE(PG8_SB(1, 0), b3, voffB); PG8_STAGE(PG8_SB(1, 1), b3 + hstep, voffB); PG8_STAGE(PG8_SA(1, 0), a3, voffA);
            PG8_WAIT_V(8); PG8_WAIT_L(0); PG8_BAR; PG8_MMA(1, 0, At, B0); PG8_MMA(1, 1, At, B1); PG8_BAR; PG8_SCHED;
        }
        if (wr == 0) PG8_BAR;
        E(acc, cur, wr, wc, fr, fq);
        if (!has_next) break;
#pragma unroll
        for (int a = 0; a < 2; ++a)
#pragma unroll
            for (int b = 0; b < 2; ++b)
#pragma unroll
                for (int m = 0; m < 4; ++m)
#pragma unroll
                    for (int n = 0; n < 2; ++n) acc[a][b][m][n] = (f32x4){0.f, 0.f, 0.f, 0.f};
        cur = nxt; cA = nA; cB = nB; ++ui;
        if (wr == 1) PG8_BAR;
    }
    PG8_WAIT_V(0);
    PG8_BAR;
#undef PG8_SA
#undef PG8_SB
#undef PG8_STAGE
#undef PG8_LDA
#undef PG8_LDB
#undef PG8_MMA
#undef PG8_WAIT_V
#undef PG8_WAIT_L
#undef PG8_BAR
#undef PG8_SCHED
}
}
using pg8::Unit;
typedef f32x4 AccT[2][2][4][2];

struct EpiSwiglu {
    bf16_t* H; const float* rss;
    DI void operator()(const AccT& acc, const Unit& u, int wr, int wc, int fr, int fq) const {
        const int row0 = u.pm * 256 + wr * 64 + fr, col0 = u.pn * 128 + wc * 32 + 8 * fq;
#pragma unroll
        for (int ai = 0; ai < 2; ++ai)
#pragma unroll
            for (int m = 0; m < 4; ++m) {
                const int row = row0 + ai * 128 + m * 16;
                const float rstd = row_rstd(rss, row);
                float hv[8];
#pragma unroll
                for (int n = 0; n < 2; ++n)
#pragma unroll
                    for (int j = 0; j < 4; ++j) { const float gg = acc[ai][0][m][n][j] * rstd, uu = acc[ai][1][m][n][j] * rstd; hv[4 * n + j] = silu(gg) * uu; }
                u32x4 w = {pk2(hv[0], hv[1]), pk2(hv[2], hv[3]), pk2(hv[4], hv[5]), pk2(hv[6], hv[7])};
                *(u32x4*)(H + (size_t)row * DFFP + col0) = w;
            }
    }
};
struct EpiResid {
    const float* Xin; float* X; bf16_t* XB; float* rssn; float scale;
    DI void operator()(const AccT& acc, const Unit& u, int wr, int wc, int fr, int fq) const {
        const int row0 = u.pm * 256 + wr * 64 + fr, col0 = u.pn * 256 + wc * 32 + 8 * fq;
#pragma unroll
        for (int ai = 0; ai < 2; ++ai)
#pragma unroll
            for (int m = 0; m < 4; ++m) {
                const int row = row0 + ai * 128 + m * 16; float ss = 0.f;
#pragma unroll
                for (int bj = 0; bj < 2; ++bj) {
                    float* xp = X + (size_t)row * DM + col0 + bj * 128; const float* xi = Xin + (size_t)row * DM + col0 + bj * 128;
                    f32x4 x0 = *(const f32x4*)xi, x1 = *(const f32x4*)(xi + 4);
                    x0 += acc[ai][bj][m][0] * scale; x1 += acc[ai][bj][m][1] * scale;
                    *(f32x4*)xp = x0; *(f32x4*)(xp + 4) = x1;
                    u32x4 w = {pk2(x0[0], x0[1]), pk2(x0[2], x0[3]), pk2(x1[0], x1[1]), pk2(x1[2], x1[3])};
                    *(u32x4*)(XB + (size_t)row * DM + col0 + bj * 128) = w;
#pragma unroll
                    for (int j = 0; j < 4; ++j) ss += x0[j] * x0[j] + x1[j] * x1[j];
                }
                ss += __shfl_xor(ss, 16); ss += __shfl_xor(ss, 32);
                if (fq == 0) rssn[(size_t)row * 16 + u.pn * 4 + wc] = ss;
            }
    }
};
struct EpiMixIn {
    bf16_t* PAB; bf16_t* PC; float* BG; const float* rss;
    DI void operator()(const AccT& acc, const Unit& u, int wr, int wc, int fr, int fq) const {
        const int row0 = u.pm * 256 + wr * 64 + fr;
        bf16_t* base; int ld, ct;
        if (u.pn < 7) { base = PAB; ld = LDAB; ct = u.pn * 256; } else { base = PC; ld = LDC; ct = (u.pn - 7) * 256; }
        const int col0 = ct + wc * 32 + 8 * fq;
        const bool isbg = (u.pn == 11) && (wc == 0) && (fq < 3);
#pragma unroll
        for (int ai = 0; ai < 2; ++ai)
#pragma unroll
            for (int m = 0; m < 4; ++m) {
                const int row = row0 + ai * 128 + m * 16;
                const float rstd = row_rstd(rss, row);
#pragma unroll
                for (int bj = 0; bj < 2; ++bj) {
                    const f32x4 v0 = acc[ai][bj][m][0] * rstd, v1 = acc[ai][bj][m][1] * rstd;
                    u32x4 w = {pk2(v0[0], v0[1]), pk2(v0[2], v0[3]), pk2(v1[0], v1[1]), pk2(v1[2], v1[3])};
                    *(u32x4*)(base + (size_t)row * ld + col0 + bj * 128) = w;
                    if (bj == 1 && isbg) { float* bp = BG + (size_t)row * 24 + 8 * fq; *(f32x4*)bp = v0; *(f32x4*)(bp + 4) = v1; }
                }
            }
    }
};

DI int map_src(int kind, int n) {
    if (kind == 0) return n;
    if (kind == 1) { const int pn = n >> 8, bj = (n >> 7) & 1, i = n & 127; const int hid = pn * 128 + i; return hid < DFF ? hid + bj * DFF : -1; }
    if (n < 1408) return n;
    if (n < 1792) return 2560 + (n - 1408);
    if (n < 2944) return 1408 + (n - 1792);
    if (n < 2968) return n;
    return -1;
}
DI void conv_w(const float* __restrict__ W, int ldw, int Kreal, bf16_t* __restrict__ Bt, int Np, int Kp, const float* __restrict__ gain, int kind, float* tile, int tid) {
    const int tnn = Np >> 8, ntile = tnn * (Kp >> 6);
    for (int t = blockIdx.x; t < ntile; t += gridDim.x) {
        const int n0 = (t % tnn) << 8, k0 = (t / tnn) << 6;
        {
            const int tn = tid & 255, tk = tid >> 8; const int src = map_src(kind, n0 + tn);
            float v[32];
#pragma unroll
            for (int r = 0; r < 32; ++r) { const int k = k0 + tk + 2 * r; v[r] = 0.f;
                if (src >= 0 && k < Kreal) { v[r] = W[(size_t)k * ldw + src]; if (gain) v[r] *= gain[k]; } }
#pragma unroll
            for (int r = 0; r < 32; ++r) tile[(tk + 2 * r) * 257 + tn] = v[r];
        }
        __syncthreads();
#pragma unroll
        for (int i = 0; i < 4; ++i) {
            const int id = tid + i * 512; const int rn = id >> 3, kk = (id & 7) * 8; float a[8];
#pragma unroll
            for (int j = 0; j < 8; ++j) a[j] = tile[(kk + j) * 257 + rn];
            u32x4 w = {pk2(a[0], a[1]), pk2(a[2], a[3]), pk2(a[4], a[5]), pk2(a[6], a[7])};
            *(u32x4*)(Bt + (size_t)(n0 + rn) * Kp + k0 + kk) = w;
        }
        __syncthreads();
    }
}
DI void phase_convw(const Params& p, int l, unsigned char* shm, int tid) {
    float* tile = (float*)shm; unsigned char* ws = p.ws;
    conv_w(p.in[2] + (size_t)l * DM * 2 * DFF, 2 * DFF, DM, (bf16_t*)(ws + OFF_W_FFN1IN), NFF, DM, p.in[1] + l * DM, 1, tile, tid);
    conv_w(p.in[3] + (size_t)l * DFF * DM, DM, DFF, (bf16_t*)(ws + OFF_W_FFN1OUT), DM, DFFP, nullptr, 0, tile, tid);
    conv_w(p.in[5] + (size_t)l * DM * 2968, 2968, DM, (bf16_t*)(ws + OFF_W_MIXIN), NMIX, DM, p.in[4] + l * DM, 2, tile, tid);
    conv_w(p.in[13] + (size_t)l * DM * DM, DM, DM, (bf16_t*)(ws + OFF_W_MIXOUT), DM, DM, nullptr, 0, tile, tid);
    conv_w(p.in[15] + (size_t)l * DM * 2 * DFF, 2 * DFF, DM, (bf16_t*)(ws + OFF_W_FFN2IN), NFF, DM, p.in[14] + l * DM, 1, tile, tid);
    conv_w(p.in[16] + (size_t)l * DFF * DM, DM, DFF, (bf16_t*)(ws + OFF_W_FFN2OUT), DM, DFFP, nullptr, 0, tile, tid);
}

DI void phase_init(const Params& p, int gw, int nw, int lane) {
    const float* x = p.in[0]; float* X = p.out; bf16_t* XB = (bf16_t*)(p.ws + OFF_XB); float* rss = (float*)(p.ws + OFF_RSS);
    for (int row0 = gw * 4; row0 < MTOK; row0 += nw * 4) {
        f32x4 v[4][4];
#pragma unroll
        for (int r = 0; r < 4; ++r)
#pragma unroll
            for (int i = 0; i < 4; ++i) v[r][i] = *(const f32x4*)(x + (size_t)(row0 + r) * DM + i * 256 + lane * 4);
#pragma unroll
        for (int r = 0; r < 4; ++r) {
            float ss = 0.f;
#pragma unroll
            for (int i = 0; i < 4; ++i) {
                const size_t o = (size_t)(row0 + r) * DM + i * 256 + lane * 4;
                u32x2 w = {pk2(v[r][i][0], v[r][i][1]), pk2(v[r][i][2], v[r][i][3])}; *(u32x2*)(XB + o) = w;
                ss += v[r][i][0] * v[r][i][0] + v[r][i][1] * v[r][i][1] + v[r][i][2] * v[r][i][2] + v[r][i][3] * v[r][i][3];
            }
            ss = wave_sum(ss); if (lane < 16) rss[(size_t)(row0 + r) * 16 + lane] = lane == 0 ? ss : 0.f;
        }
    }
    if (gw == 0) { unsigned* misc = (unsigned*)(p.ws + OFF_MISC); misc[lane] = 0u; misc[64 + lane] = 0u; }
}
DI void phase_final(const Params& p, int gw, int nw, int lane) {
    float* X = p.out; const float* rss = (const float*)(p.ws + OFF_RSS); const float* g = p.in[17];
    for (int row0 = gw * 4; row0 < MTOK; row0 += nw * 4) {
        f32x4 v[4][4]; float rstd[4];
#pragma unroll
        for (int r = 0; r < 4; ++r) {
            rstd[r] = row_rstd(rss, row0 + r);
#pragma unroll
            for (int i = 0; i < 4; ++i) v[r][i] = *(const f32x4*)(X + (size_t)(row0 + r) * DM + i * 256 + lane * 4);
        }
#pragma unroll
        for (int r = 0; r < 4; ++r)
#pragma unroll
            for (int i = 0; i < 4; ++i) {
                const int c = i * 256 + lane * 4; const f32x4 gv = *(const f32x4*)(g + c);
                *(f32x4*)(X + (size_t)(row0 + r) * DM + c) = v[r][i] * rstd[r] * gv;
            }
    }
}

DI void store_row64(bf16_t* dst, const float (&val)[64]) {
#pragma unroll
    for (int i = 0; i < 8; ++i) { u32x4 w = {pk2(val[8 * i], val[8 * i + 1]), pk2(val[8 * i + 2], val[8 * i + 3]), pk2(val[8 * i + 4], val[8 * i + 5]), pk2(val[8 * i + 6], val[8 * i + 7])};
        *(u32x4*)(dst + 8 * i) = w; }
}
DI void phase_prep(const Params& p, int l, int gw, int nw, int lane0) {
    unsigned char* ws = p.ws;
    const bf16_t* PAB = (const bf16_t*)(ws + OFF_PAB); const bf16_t* PC = (const bf16_t*)(ws + OFF_PC);
    bf16_t* QC = (bf16_t*)(ws + OFF_QC); bf16_t* KC = (bf16_t*)(ws + OFF_KC); bf16_t* KTC = (bf16_t*)(ws + OFF_KTC); bf16_t* VTC = (bf16_t*)(ws + OFF_VTC);
    bf16_t* VT = (bf16_t*)(ws + OFF_VT);
    const float* cw = p.in[6] + (size_t)l * 5 * 1152;
    for (int u = gw; u < 512 * 25; u += nw) {
        int lane = lane0; asm volatile("" : "+v"(lane));
        const int grp = u % 25, ck = u / 25, b = ck >> 7, chunk = ck & 127;
        if (grp == 24) {
            const bf16_t* kr = PAB + ((size_t)b * SEQ + chunk * 64 + lane) * LDAB + 896;
            unsigned* kmx = (unsigned*)(ws + OFF_MISC) + l * 32 + b * 8;
#pragma unroll
            for (int hm = 0; hm < 8; ++hm) {
                float ss = 0.f;
#pragma unroll
                for (int c4 = 0; c4 < 4; ++c4) { const u32x4 v = *(const u32x4*)(kr + hm * 32 + c4 * 8);
#pragma unroll
                    for (int e = 0; e < 4; ++e) { const float a = bflo(v[e]), bb = bfhi(v[e]); ss += a * a + bb * bb; } }
#pragma unroll
                for (int o = 32; o > 0; o >>= 1) ss = fmaxf(ss, __shfl_xor(ss, o));
                if (lane == 0) atomicMax(kmx + hm, __float_as_uint(ss));
            }
            continue;
        }
        float val[64];
        if (grp < 18) {
            const int type = grp / 6, h = grp % 6, col = type * 384 + h * 64 + lane;
            const float w0 = cw[col], w1 = cw[1152 + col], w2 = cw[2 * 1152 + col], w3 = cw[3 * 1152 + col], w4 = cw[4 * 1152 + col];
            float xv[68];
#pragma unroll
            for (int i = 0; i < 68; ++i) { const int pos = chunk * 64 - 2 + i;
                xv[i] = (pos >= 0 && pos < SEQ) ? bf2f(PC[((size_t)b * SEQ + pos) * LDC + col]) : 0.f; }
#pragma unroll
            for (int t = 0; t < 64; ++t) { const float v = w0 * xv[t] + w1 * xv[t + 1] + w2 * xv[t + 2] + w3 * xv[t + 3] + w4 * xv[t + 4]; val[t] = silu(v); }
            if (type < 2) {
                const float sc = type == 0 ? 0.125f : 1.f;
#pragma unroll
                for (int t = 0; t < 64; ++t) { const float ss = wave_sum(val[t] * val[t]); val[t] *= __builtin_amdgcn_rsqf(ss + EPS) * sc; }
            }
            const size_t tb = ((size_t)(b * 6 + h) * 128 + chunk) * 4096;
            if (type == 0) {
#pragma unroll
                for (int t = 0; t < 64; ++t) QC[tb + t * 64 + lane] = f2bf(val[t]);
            } else if (type == 1) {
#pragma unroll
                for (int t = 0; t < 64; ++t) KC[tb + t * 64 + lane] = f2bf(val[t]);
                store_row64(KTC + tb + lane * 64, val);
            } else {
                store_row64(VTC + tb + lane * 64, val);
            }
        } else {
            const int vh = grp - 18; const int col = (vh < 2 ? 512 + vh * 64 : 1152 + (vh - 2) * 64) + lane;
            const size_t tok0 = (size_t)b * SEQ + chunk * 64;
#pragma unroll
            for (int t = 0; t < 64; ++t) val[t] = bf2f(PAB[(tok0 + t) * LDAB + col]);
            store_row64(VT + ((size_t)(b * 6 + vh) * 64 + lane) * SEQ + chunk * 64, val);
        }
    }
}

DI void phase_chunk(const Params& p, int l, int gw, int nw, int lane0, int wid, unsigned char* shm) {
    unsigned char* ws = p.ws;
    float* Mf = (float*)(shm + wid * 16384); bf16_t* AB = (bf16_t*)Mf; bf16_t* ABG = AB + 4096;
    const bf16_t* QC = (const bf16_t*)(ws + OFF_QC); const bf16_t* KC = (const bf16_t*)(ws + OFF_KC);
    const bf16_t* KTC = (const bf16_t*)(ws + OFF_KTC); const bf16_t* VTC = (const bf16_t*)(ws + OFF_VTC);
    const float* BG = (const float*)(ws + OFF_BG);
    bf16_t* U = (bf16_t*)(ws + OFF_U); bf16_t* WB = (bf16_t*)(ws + OFF_WB); bf16_t* QK = (bf16_t*)(ws + OFF_QK); float* GC = (float*)(ws + OFF_GC);
    for (int it = gw; it < 6144; it += nw) {
        int lane = lane0; asm volatile("" : "+v"(lane));
        const int fr = lane & 15, q = lane >> 4;
        const int chunk = it & 127, seq = it >> 7, dir = seq & 1, bh = seq >> 1, b = bh / 6, h = bh % 6;
        const int pch = dir ? 127 - chunk : chunk;
        const size_t tb = ((size_t)bh * 128 + pch) * 4096;
        const int tkl = dir ? 63 - lane : lane;
        const size_t tok = (size_t)b * SEQ + pch * 64 + tkl;
        const float braw = BG[tok * 24 + dir * 6 + h], araw = BG[tok * 24 + 12 + dir * 6 + h];
        const float beta = 1.f / (1.f + expf(-braw));
        const float Aa = expf(p.in[10][l * 12 + dir * 6 + h]); const float xx = araw + p.in[11][l * 12 + dir * 6 + h];
        const float sp = fmaxf(xx, 0.f) + log1pf(expf(-fabsf(xx)));
        const float g = -Aa * sp;
        float gc = g;
#pragma unroll
        for (int o = 1; o < 64; o <<= 1) { const float t = __shfl_up(gc, o); if (lane >= o) gc += t; }
        GC[(size_t)it * 64 + lane] = gc;
        bf16x8 kf[4][2], qf[4][2];
#pragma unroll
        for (int m = 0; m < 4; ++m)
#pragma unroll
            for (int s = 0; s < 2; ++s) { const int row = 16 * m + fr; const int tr = dir ? 63 - row : row;
                kf[m][s] = *(const bf16x8*)(KC + tb + tr * 64 + 32 * s + 8 * q); qf[m][s] = *(const bf16x8*)(QC + tb + tr * 64 + 32 * s + 8 * q); }
#pragma unroll
        for (int m = 0; m < 4; ++m)
#pragma unroll
            for (int n = 0; n <= m; ++n) {
                f32x4 acc = {0.f, 0.f, 0.f, 0.f};
                acc = MFMA16(kf[m][0], kf[n][0], acc); acc = MFMA16(kf[m][1], kf[n][1], acc);
                const int s_ = 16 * n + fr; const float gcs = __shfl(gc, s_);
#pragma unroll
                for (int r = 0; r < 4; ++r) { const int c = 16 * m + 4 * q + r; const float gcc = __shfl(gc, c), bc = __shfl(beta, c);
                    Mf[c * 64 + s_] = (s_ < c) ? bc * acc[r] * fexp(gcc - gcs) : 0.f; }
                __builtin_amdgcn_sched_barrier(0);
            }
#pragma unroll
        for (int n = 0; n < 4; ++n)
#pragma unroll
            for (int m = 0; m < 4; ++m) {
                f32x4 v = {0.f, 0.f, 0.f, 0.f};
                const int c = 16 * n + fr;
                if (m <= n) {
                    f32x4 acc = {0.f, 0.f, 0.f, 0.f};
                    acc = MFMA16(kf[m][0], qf[n][0], acc); acc = MFMA16(kf[m][1], qf[n][1], acc);
                    const float gcc = __shfl(gc, c);
#pragma unroll
                    for (int r = 0; r < 4; ++r) { const int s_ = 16 * m + 4 * q + r; const float gcs = __shfl(gc, s_); v[r] = (s_ <= c) ? acc[r] * fexp(gcc - gcs) : 0.f; }
                }
                u32x2 w = {pk2(v[0], v[1]), pk2(v[2], v[3])};
                *(u32x2*)(QK + (size_t)it * 4096 + c * 64 + 16 * m + 4 * q) = w;
                __builtin_amdgcn_sched_barrier(0);
            }
        __builtin_amdgcn_sched_barrier(0);
        bf16x8 vfr[4][2], ktf[4][2];
#pragma unroll
        for (int n = 0; n < 4; ++n) {
            const bf16_t* vp = VTC + tb + (16 * n + fr) * 64 + 8 * q; vfr[n][0] = *(const bf16x8*)vp; vfr[n][1] = *(const bf16x8*)(vp + 32);
            const bf16_t* kp = KTC + tb + (16 * n + fr) * 64 + 8 * q; ktf[n][0] = *(const bf16x8*)kp; ktf[n][1] = *(const bf16x8*)(kp + 32);
        }
        float x[64];
#pragma unroll
        for (int i = 0; i < 64; ++i) {
            float a = (i == lane) ? 1.f : 0.f;
#pragma unroll
            for (int m = 0; m < i; ++m) a -= Mf[i * 64 + m] * x[m];
            x[i] = a;
            __builtin_amdgcn_sched_barrier(0);
        }
        {
            const float bj = beta, bgj = beta * fexp(gc);
#pragma unroll
            for (int i = 0; i < 64; ++i) { AB[i * 64 + tkl] = f2bf(x[i] * bj); ABG[i * 64 + tkl] = f2bf(x[i] * bgj); }
        }
        __builtin_amdgcn_sched_barrier(0);
#pragma unroll
        for (int m = 0; m < 4; ++m) {
            const bf16x8 a0 = *(const bf16x8*)(AB + (16 * m + fr) * 64 + 8 * q), a1 = *(const bf16x8*)(AB + (16 * m + fr) * 64 + 32 + 8 * q);
#pragma unroll
            for (int n = 0; n < 4; ++n) {
                const bf16x8 b0 = vfr[n][0], b1 = vfr[n][1];
                f32x4 acc = {0.f, 0.f, 0.f, 0.f};
                acc = MFMA16(a0, b0, acc); acc = MFMA16(a1, b1, acc);
                u32x2 w = {pk2(acc[0], acc[1]), pk2(acc[2], acc[3])};
                *(u32x2*)(U + (size_t)it * 4096 + (16 * n + fr) * 64 + 16 * m + 4 * q) = w;
            }
        }
        __builtin_amdgcn_sched_barrier(0);
#pragma unroll
        for (int n = 0; n < 4; ++n) {
            const bf16x8 b0 = *(const bf16x8*)(ABG + (16 * n + fr) * 64 + 8 * q), b1 = *(const bf16x8*)(ABG + (16 * n + fr) * 64 + 32 + 8 * q);
#pragma unroll
            for (int m = 0; m < 4; ++m) {
                const bf16x8 a0 = ktf[m][0], a1 = ktf[m][1];
                f32x4 acc = {0.f, 0.f, 0.f, 0.f};
                acc = MFMA16(a0, b0, acc); acc = MFMA16(a1, b1, acc);
                u32x2 w = {pk2(acc[0], acc[1]), pk2(acc[2], acc[3])};
                *(u32x2*)(WB + (size_t)it * 4096 + (16 * n + fr) * 64 + 16 * m + 4 * q) = w;
            }
        }
    }
}

constexpr int SCAN_SLOT = 25600;
DI void scan_issue(LAS unsigned char* slot, const bf16_t* WB, const bf16_t* U, const bf16_t* KTC, const float* GC, int seq, int bh, int dir, int lw, int i, int lane) {
    const int it = seq * 128 + i; const int pch = dir ? 127 - i : i;
    const bf16_t* Wp = WB + (size_t)it * 4096; const bf16_t* Kp = KTC + ((size_t)bh * 128 + pch) * 4096;
    const bf16_t* Up = U + (size_t)it * 4096 + (16 * lw) * 64; const float* gcp = GC + (size_t)it * 64;
    const int r8 = lane >> 3, c8 = lane & 7;
#pragma unroll
    for (int jj = 0; jj < 2; ++jj) {
        const int j = 2 * lw + jj;
        const int row = 8 * j + r8; const int cid = c8 ^ (row & 7);
        __builtin_amdgcn_global_load_lds((const unsigned*)(Wp + row * 64 + cid * 8), (LAS unsigned*)(slot + j * 1024), 16, 0, 0);
        __builtin_amdgcn_global_load_lds((const unsigned*)(Kp + row * 64 + cid * 8), (LAS unsigned*)(slot + 8192 + j * 1024), 16, 0, 0);
    }
#pragma unroll
    for (int j = 0; j < 2; ++j) {
        const int row = 8 * j + r8; const int cid = c8 ^ (row & 7);
        __builtin_amdgcn_global_load_lds((const unsigned*)(Up + row * 64 + cid * 8), (LAS unsigned*)(slot + 16384 + lw * 2048 + j * 1024), 16, 0, 0);
    }
    __builtin_amdgcn_global_load_lds((const unsigned*)(gcp + (lane & 15) * 4), (LAS unsigned*)(slot + 24576), 16, 0, 0);
}
DI u32x2 lds_piece(const LAS unsigned char* tile, int row, int e) {
    return *(const LAS u32x2*)(tile + row * 128 + ((((e >> 3) ^ (row & 7))) << 4) + ((e & 4) << 1));
}
DI bf16x8 mk8(u32x2 x, u32x2 y) { u32x4 r = {x.x, x.y, y.x, y.y}; return __builtin_bit_cast(bf16x8, r); }
DI bf16x8 mk8rev(u32x2 x, u32x2 y) { u32x4 r = {rot16(x.y), rot16(x.x), rot16(y.y), rot16(y.x)}; return __builtin_bit_cast(bf16x8, r); }
DI void scan_step(const LAS unsigned char* slot, int vs, int dir, int fr, int q, f32x4 (&S)[4], bf16_t* sst) {
    bf16x8 Sb[2];
    Sb[0] = pack8(S[0], S[1]); Sb[1] = pack8(S[2], S[3]);
    {
        const u32x4 s0 = __builtin_bit_cast(u32x4, Sb[0]), s1 = __builtin_bit_cast(u32x4, Sb[1]);
        *(u32x2*)(sst + 0) = (u32x2){s0.x, s0.y}; *(u32x2*)(sst + 16) = (u32x2){s0.z, s0.w};
        *(u32x2*)(sst + 32) = (u32x2){s1.x, s1.y}; *(u32x2*)(sst + 48) = (u32x2){s1.z, s1.w};
    }
    const LAS unsigned char* ut = slot + 16384 + vs * 2048;
    const LAS float* gcl_p = (const LAS float*)(slot + 24576);
    const float gcl = gcl_p[63]; const float gl = fexp(gcl);
    f32x4 vg[4];
#pragma unroll
    for (int m = 0; m < 4; ++m) {
        const int c = 16 * m + fr;
        const bf16x8 w0 = mk8(lds_piece(slot, c, 4 * q), lds_piece(slot, c, 16 + 4 * q)), w1 = mk8(lds_piece(slot, c, 32 + 4 * q), lds_piece(slot, c, 48 + 4 * q));
        f32x4 acc = {0.f, 0.f, 0.f, 0.f};
        acc = MFMA16(w0, Sb[0], acc); acc = MFMA16(w1, Sb[1], acc);
        const u32x2 uu = lds_piece(ut, fr, 16 * m + 4 * q);
        const f32x4 gcv = *(const LAS f32x4*)(slot + 24576 + (16 * m + 4 * q) * 4);
        vg[m][0] = (bflo(uu.x) - acc[0]) * fexp(gcl - gcv[0]); vg[m][1] = (bfhi(uu.x) - acc[1]) * fexp(gcl - gcv[1]);
        vg[m][2] = (bflo(uu.y) - acc[2]) * fexp(gcl - gcv[2]); vg[m][3] = (bfhi(uu.y) - acc[3]) * fexp(gcl - gcv[3]);
    }
    bf16x8 Vg[2];
    Vg[0] = pack8(vg[0], vg[1]); Vg[1] = pack8(vg[2], vg[3]);
#pragma unroll
    for (int kt = 0; kt < 4; ++kt) {
        const int k = 16 * kt + fr;
        bf16x8 k0, k1;
        if (dir == 0) { k0 = mk8(lds_piece(slot + 8192, k, 4 * q), lds_piece(slot + 8192, k, 16 + 4 * q)); k1 = mk8(lds_piece(slot + 8192, k, 32 + 4 * q), lds_piece(slot + 8192, k, 48 + 4 * q)); }
        else { k0 = mk8rev(lds_piece(slot + 8192, k, 60 - 4 * q), lds_piece(slot + 8192, k, 44 - 4 * q)); k1 = mk8rev(lds_piece(slot + 8192, k, 28 - 4 * q), lds_piece(slot + 8192, k, 12 - 4 * q)); }
        f32x4 acc = S[kt] * gl;
        acc = MFMA16(k0, Vg[0], acc); acc = MFMA16(k1, Vg[1], acc);
        S[kt] = acc;
    }
}
DI void phase_scan(const Params& p, int lane, int wid, unsigned char* shm) {
    unsigned char* ws = p.ws;
    const bf16_t* KTC = (const bf16_t*)(ws + OFF_KTC);
    const bf16_t* U = (const bf16_t*)(ws + OFF_U); const bf16_t* WB = (const bf16_t*)(ws + OFF_WB);
    const float* GC = (const float*)(ws + OFF_GC); bf16_t* SST = (bf16_t*)(ws + OFF_SST);
    const int seq = blockIdx.x, dir = seq & 1, bh = seq >> 1;
    const int fr = lane & 15, q = lane >> 4;
    LAS unsigned char* ring = (LAS unsigned char*)shm;
    if (wid >= 4) {
        const int lw = wid - 4;
        scan_issue(ring, WB, U, KTC, GC, seq, bh, dir, lw, 0, lane);
        scan_issue(ring + SCAN_SLOT, WB, U, KTC, GC, seq, bh, dir, lw, 1, lane);
        scan_issue(ring + 2 * SCAN_SLOT, WB, U, KTC, GC, seq, bh, dir, lw, 2, lane);
        int slot_n = 3;
        for (int i = 0; i < 128; ++i) {
            scan_issue(ring + slot_n * SCAN_SLOT, WB, U, KTC, GC, seq, bh, dir, lw, i + 3 < 128 ? i + 3 : 127, lane);
            asm volatile("s_waitcnt vmcnt(21)" ::: "memory");
            __builtin_amdgcn_s_barrier();
            slot_n = slot_n == 4 ? 0 : slot_n + 1;
        }
        asm volatile("s_waitcnt vmcnt(0)" ::: "memory");
    } else {
        const int vs = wid;
        f32x4 S[4];
#pragma unroll
        for (int i = 0; i < 4; ++i) S[i] = (f32x4){0.f, 0.f, 0.f, 0.f};
        bf16_t* sst = SST + (size_t)seq * 128 * 4096 + (16 * vs + fr) * 64 + 4 * q;
        int slot_c = 0;
        for (int i = 0; i < 128; ++i) {
            __builtin_amdgcn_s_barrier();
            asm volatile("" ::: "memory");
            scan_step(ring + slot_c * SCAN_SLOT, vs, dir, fr, q, S, sst + (size_t)i * 4096);
            slot_c = slot_c == 4 ? 0 : slot_c + 1;
        }
    }
}
DI void phase_outp(const Params& p, int gw, int nw, int lane0) {
    unsigned char* ws = p.ws;
    const bf16_t* QC = (const bf16_t*)(ws + OFF_QC);
    const bf16_t* U = (const bf16_t*)(ws + OFF_U); const bf16_t* WB = (const bf16_t*)(ws + OFF_WB); const bf16_t* QK = (const bf16_t*)(ws + OFF_QK);
    const float* GC = (const float*)(ws + OFF_GC); const bf16_t* SST = (const bf16_t*)(ws + OFF_SST);
    for (int it = gw; it < 6144; it += nw) {
        int lane = lane0; asm volatile("" : "+v"(lane));
        const int fr = lane & 15, q = lane >> 4;
        const int chunk = it & 127, seq = it >> 7, dir = seq & 1, bh = seq >> 1, b = bh / 6, h = bh % 6;
        const int pch = dir ? 127 - chunk : chunk;
        const size_t tb = ((size_t)bh * 128 + pch) * 4096;
        const bf16_t* Wp = WB + (size_t)it * 4096; const bf16_t* Up = U + (size_t)it * 4096; const bf16_t* QKp = QK + (size_t)it * 4096;
        const bf16_t* Sp = SST + (size_t)it * 4096; const float* gcp = GC + (size_t)it * 64;
        bf16_t* OT = (bf16_t*)(ws + OFF_WB) + (size_t)it * 4096;
        bf16x8 wf[4][2], qf[4][2], kf[4][2]; f32x4 eg[4];
#pragma unroll
        for (int m = 0; m < 4; ++m) {
            const int c = 16 * m + fr; const int tr = dir ? 63 - c : c;
            wf[m][0] = *(const bf16x8*)(Wp + c * 64 + 8 * q); wf[m][1] = *(const bf16x8*)(Wp + c * 64 + 32 + 8 * q);
            qf[m][0] = *(const bf16x8*)(QC + tb + tr * 64 + 8 * q); qf[m][1] = *(const bf16x8*)(QC + tb + tr * 64 + 32 + 8 * q);
            const bf16_t* kp = QKp + c * 64 + 4 * q;
            kf[m][0] = ld2x8(kp, kp + 16); kf[m][1] = ld2x8(kp + 32, kp + 48);
            const f32x4 gcv = *(const f32x4*)(gcp + 16 * m + 4 * q);
#pragma unroll
            for (int r = 0; r < 4; ++r) eg[m][r] = fexp(gcv[r]);
        }
#pragma unroll 1
        for (int vs = 0; vs < 4; ++vs) {
            const bf16x8 Sb0 = *(const bf16x8*)(Sp + (16 * vs + fr) * 64 + 8 * q), Sb1 = *(const bf16x8*)(Sp + (16 * vs + fr) * 64 + 32 + 8 * q);
            f32x4 vn[4], o[4];
#pragma unroll
            for (int m = 0; m < 4; ++m) {
                f32x4 acc = {0.f, 0.f, 0.f, 0.f};
                acc = MFMA16(wf[m][0], Sb0, acc); acc = MFMA16(wf[m][1], Sb1, acc);
                const u32x2 uu = *(const u32x2*)(Up + (16 * vs + fr) * 64 + 16 * m + 4 * q);
                vn[m][0] = bflo(uu.x) - acc[0]; vn[m][1] = bfhi(uu.x) - acc[1]; vn[m][2] = bflo(uu.y) - acc[2]; vn[m][3] = bfhi(uu.y) - acc[3];
                f32x4 a2 = {0.f, 0.f, 0.f, 0.f};
                a2 = MFMA16(qf[m][0], Sb0, a2); a2 = MFMA16(qf[m][1], Sb1, a2);
                o[m] = a2 * eg[m];
            }
            const bf16x8 Vb0 = pack8(vn[0], vn[1]), Vb1 = pack8(vn[2], vn[3]);
#pragma unroll
            for (int m = 0; m < 4; ++m) {
                f32x4 acc = o[m];
                acc = MFMA16(kf[m][0], Vb0, acc); acc = MFMA16(kf[m][1], Vb1, acc);
#pragma unroll
                for (int r = 0; r < 4; ++r) { const int c = 16 * m + 4 * q + r; OT[c * 64 + 16 * vs + fr] = f2bf(acc[r]); }
            }
        }
    }
}

DI bf16x8 packpv(const f32x16& pv, int s) {
    u32x4 r = {pk2(pv[8 * s], pv[8 * s + 1]), pk2(pv[8 * s + 2], pv[8 * s + 3]), pk2(pv[8 * s + 4], pv[8 * s + 5]), pk2(pv[8 * s + 6], pv[8 * s + 7])};
    return __builtin_bit_cast(bf16x8, r);
}
DI bf16x8 packp(const float (&pv)[16], int s) {
    u32x4 r = {pk2(pv[8 * s], pv[8 * s + 1]), pk2(pv[8 * s + 2], pv[8 * s + 3]), pk2(pv[8 * s + 4], pv[8 * s + 5]), pk2(pv[8 * s + 6], pv[8 * s + 7])};
    return __builtin_bit_cast(bf16x8, r);
}
#define CRW(reg) ((float)(((reg) & 3) + 8 * ((reg) >> 2)))

DI void phase_win(const Params& p, int l, int gw, int nw, int lane) {
    unsigned char* ws = p.ws;
    const bf16_t* PAB = (const bf16_t*)(ws + OFF_PAB); const bf16_t* VT = (const bf16_t*)(ws + OFF_VT); bf16_t* OB = (bf16_t*)(ws + OFF_OB);
    const int r32 = lane & 31, hh = lane >> 5;
    for (int item = gw; item < 6144; item += nw) {
        const int qt = item & 255, qh = (item >> 8) % 6, b = item / 1536, kvh = qh / 3;
        const int q0 = qt * 32, qi = q0 + r32;
        const bf16_t* qrow = PAB + ((size_t)b * SEQ + qi) * LDAB + qh * 64;
        bf16x8 qf[4];
#pragma unroll
        for (int st = 0; st < 4; ++st) qf[st] = *(const bf16x8*)(qrow + 16 * st + 8 * hh);
        const float slope2 = exp2f(-8.f * (float)(qh + 1) / 6.f) * LOG2E, scale2 = 0.125f * LOG2E;
        float m = p.in[7][l * 6 + qh] * LOG2E, lsum = hh == 0 ? 1.f : 0.f;
        f32x16 O[2];
#pragma unroll
        for (int i = 0; i < 16; ++i) { O[0][i] = 0.f; O[1][i] = 0.f; }
        const int kb0 = q0 - 128 < 0 ? 0 : q0 - 128, kb1 = q0 + 160 > SEQ ? SEQ : q0 + 160;
        for (int kb = kb0; kb < kb1; kb += 32) {
            const bf16_t* krow = PAB + ((size_t)b * SEQ + kb + r32) * LDAB + 384 + kvh * 64;
            f32x16 s;
#pragma unroll
            for (int i = 0; i < 16; ++i) s[i] = 0.f;
#pragma unroll
            for (int st = 0; st < 4; ++st) { const bf16x8 kf = *(const bf16x8*)(krow + 16 * st + 8 * hh); s = MFMA32(kf, qf[st], s); }
            bf16x8 vf[2][2];
#pragma unroll
            for (int dt = 0; dt < 2; ++dt) { const bf16_t* vrow = VT + ((size_t)(b * 6 + kvh) * 64 + 32 * dt + r32) * SEQ + kb + 4 * hh;
                vf[dt][0] = ld2x8(vrow, vrow + 8); vf[dt][1] = ld2x8(vrow + 16, vrow + 24); }
            const float qoff = (float)(kb + 4 * hh - qi);
            float t[16]; float mx = m;
#pragma unroll
            for (int reg = 0; reg < 16; ++reg) { const float ad = fabsf(qoff + CRW(reg)); float tv = s[reg] * scale2 - slope2 * ad; tv = (ad <= 128.f) ? tv : -1e30f; t[reg] = tv; mx = fmaxf(mx, tv); }
            mx = fmaxf(mx, __shfl_xor(mx, 32));
            const float alpha = fexp2(m - mx); m = mx;
            float ps = 0.f;
#pragma unroll
            for (int reg = 0; reg < 16; ++reg) { t[reg] = fexp2(t[reg] - m); ps += t[reg]; }
            lsum = lsum * alpha + ps;
#pragma unroll
            for (int i = 0; i < 16; ++i) { O[0][i] *= alpha; O[1][i] *= alpha; }
            const bf16x8 pf0 = packp(t, 0), pf1 = packp(t, 1);
#pragma unroll
            for (int dt = 0; dt < 2; ++dt) { O[dt] = MFMA32(vf[dt][0], pf0, O[dt]); O[dt] = MFMA32(vf[dt][1], pf1, O[dt]); }
        }
        lsum += __shfl_xor(lsum, 32);
        const float inv = 1.f / lsum;
        bf16_t* orow = OB + ((size_t)b * SEQ + qi) * DM + qh * 64;
#pragma unroll
        for (int dt = 0; dt < 2; ++dt)
#pragma unroll
            for (int g4 = 0; g4 < 4; ++g4) {
                u32x2 w = {pk2(O[dt][4 * g4] * inv, O[dt][4 * g4 + 1] * inv), pk2(O[dt][4 * g4 + 2] * inv, O[dt][4 * g4 + 3] * inv)};
                *(u32x2*)(orow + 32 * dt + 8 * g4 + 4 * hh) = w;
            }
    }
}

DI void win_block(const Params& p, int l, int item, int tid, unsigned char* shm) {
    unsigned char* ws = p.ws;
    const bf16_t* PAB = (const bf16_t*)(ws + OFF_PAB); const bf16_t* VT = (const bf16_t*)(ws + OFF_VT); bf16_t* OB = (bf16_t*)(ws + OFF_OB);
    const int lane = tid & 63, wid = tid >> 6, r32 = lane & 31, hh = lane >> 5;
    const int qblk = item & 31, kvh = (item >> 5) & 1, b = item >> 6;
    const int Q0 = qblk * 256, K0 = Q0 - 128;
    {
        const int srow = tid >> 3, sch = tid & 7;
        const int kwoff = srow * 128 + ((sch ^ (srow & 7)) * 16);
        const int vblk = sch >> 1, vhalf = sch & 1;
        const int vwoff0 = 65536 + srow * 128 + (((2 * vblk) ^ (srow & 7)) * 16) + 8 * vhalf;
        const int vwoff1 = 65536 + srow * 128 + (((2 * vblk + 1) ^ (srow & 7)) * 16) + 8 * vhalf;
        __syncthreads();
#pragma unroll 1
        for (int g0 = 0; g0 < 8; g0 += 4) {
            u32x4 kr[4], vr[4];
#pragma unroll
            for (int gg = 0; gg < 4; ++gg) {
                const int g = g0 + gg;
                int kpos = K0 + g * 64 + srow; kpos = kpos < 0 ? 0 : (kpos > SEQ - 1 ? SEQ - 1 : kpos);
                int key0 = K0 + g * 64; key0 = key0 < 0 ? 0 : (key0 > SEQ - 64 ? SEQ - 64 : key0);
                kr[gg] = *(const u32x4*)(PAB + ((size_t)b * SEQ + kpos) * LDAB + 384 + kvh * 64 + sch * 8);
                vr[gg] = *(const u32x4*)(VT + ((size_t)(b * 6 + kvh) * 64 + srow) * SEQ + key0 + sch * 8);
            }
#pragma unroll
            for (int gg = 0; gg < 4; ++gg) {
                const int g = g0 + gg;
                *(u32x4*)(shm + g * 8192 + kwoff) = kr[gg];
                *(u32x2*)(shm + g * 8192 + vwoff0) = (u32x2){vr[gg].x, vr[gg].y}; *(u32x2*)(shm + g * 8192 + vwoff1) = (u32x2){vr[gg].z, vr[gg].w};
            }
        }
        __syncthreads();
    }
    const int q0 = Q0 + wid * 32, qi = q0 + r32;
    const int kb0 = q0 - 128 < 0 ? 0 : q0 - 128, kb1 = q0 + 160 > SEQ ? SEQ : q0 + 160;
#pragma unroll 1
    for (int g3 = 0; g3 < 3; ++g3) {
        const int qh = kvh * 3 + g3;
        const bf16_t* qrow = PAB + ((size_t)b * SEQ + qi) * LDAB + qh * 64;
        bf16x8 qf[4];
#pragma unroll
        for (int st = 0; st < 4; ++st) qf[st] = *(const bf16x8*)(qrow + 16 * st + 8 * hh);
        const float slope2 = exp2f(-8.f * (float)(qh + 1) / 6.f) * LOG2E, scale2 = 0.125f * LOG2E;
        float m = p.in[7][l * 6 + qh] * LOG2E, lsum = hh == 0 ? 1.f : 0.f;
        f32x16 O[2];
#pragma unroll
        for (int i = 0; i < 16; ++i) { O[0][i] = 0.f; O[1][i] = 0.f; }
        for (int kb = kb0; kb < kb1; kb += 32) {
            const int kl = kb - K0, g = kl >> 6, j = (kl >> 5) & 1;
            const unsigned char* Ks = shm + g * 8192; const unsigned char* Vs = shm + 65536 + g * 8192;
            f32x16 s;
#pragma unroll
            for (int i = 0; i < 16; ++i) s[i] = 0.f;
#pragma unroll
            for (int st = 0; st < 4; ++st) { const bf16x8 kf = *(const bf16x8*)(Ks + (32 * j + r32) * 128 + (((2 * st + hh) ^ (r32 & 7)) * 16)); s = MFMA32(kf, qf[st], s); }
            bf16x8 vf[2][2];
#pragma unroll
            for (int dt = 0; dt < 2; ++dt)
#pragma unroll
                for (int s_ = 0; s_ < 2; ++s_) vf[dt][s_] = *(const bf16x8*)(Vs + (32 * dt + r32) * 128 + (((4 * j + 2 * s_ + hh) ^ (r32 & 7)) * 16));
            float qoff = (float)(kb + 4 * hh - qi); asm volatile("" : "+v"(qoff));
            float t[16]; float mx = m;
#pragma unroll
            for (int reg = 0; reg < 16; ++reg) { const float ad = fabsf(qoff + CRW(reg)); float tv = s[reg] * scale2 - slope2 * ad; tv = (ad <= 128.f) ? tv : -1e30f; t[reg] = tv; mx = fmaxf(mx, tv); }
            mx = fmaxf(mx, __shfl_xor(mx, 32));
            const float alpha = fexp2(m - mx); m = mx;
            float ps = 0.f;
#pragma unroll
            for (int reg = 0; reg < 16; ++reg) { t[reg] = fexp2(t[reg] - m); ps += t[reg]; }
            lsum = lsum * alpha + ps;
#pragma unroll
            for (int i = 0; i < 16; ++i) { O[0][i] *= alpha; O[1][i] *= alpha; }
            const bf16x8 pf0 = packp(t, 0), pf1 = packp(t, 1);
#pragma unroll
            for (int dt = 0; dt < 2; ++dt) { O[dt] = MFMA32(vf[dt][0], pf0, O[dt]); O[dt] = MFMA32(vf[dt][1], pf1, O[dt]); }
        }
        lsum += __shfl_xor(lsum, 32);
        const float inv = 1.f / lsum;
        bf16_t* orow = OB + ((size_t)b * SEQ + qi) * DM + qh * 64;
#pragma unroll
        for (int dt = 0; dt < 2; ++dt)
#pragma unroll
            for (int g4 = 0; g4 < 4; ++g4) {
                u32x2 w = {pk2(O[dt][4 * g4] * inv, O[dt][4 * g4 + 1] * inv), pk2(O[dt][4 * g4 + 2] * inv, O[dt][4 * g4 + 3] * inv)};
                *(u32x2*)(orow + 32 * dt + 8 * g4 + 4 * hh) = w;
            }
    }
}

DI bf16x8 scale_frag(bf16x8 v, float sc) {
    u32x4 u = __builtin_bit_cast(u32x4, v), r;
#pragma unroll
    for (int i = 0; i < 4; ++i) r[i] = pk2(bflo(u[i]) * sc, bfhi(u[i]) * sc);
    return __builtin_bit_cast(bf16x8, r);
}
DI void phase_diff(const Params& p, int l, int tid0, unsigned char* shm) {
    unsigned char* ws = p.ws;
    const bf16_t* PAB = (const bf16_t*)(ws + OFF_PAB); const bf16_t* VT = (const bf16_t*)(ws + OFF_VT); bf16_t* OB = (bf16_t*)(ws + OFF_OB);
    const float lam_init = l == 0 ? 0.2f : (0.8f - 0.6f * 0.7408182206817179f);
    float lam;
    {
        const int lane = tid0 & 63;
        const float* dl = p.in[8] + l * 128;
        float a = 0.f, c = 0.f;
        if (lane < 32) { a = dl[lane] * dl[32 + lane]; c = dl[64 + lane] * dl[96 + lane]; }
        a = wave_sum(a); c = wave_sum(c);
        lam = expf(a) - expf(c) + lam_init;
    }
    const float* dg = p.in[9] + l * 64;
    unsigned* qctr = (unsigned*)(ws + OFF_MISC) + 64 + l;
    const unsigned* kmx = (const unsigned*)(ws + OFF_MISC) + l * 32;
    __shared__ unsigned sq_words[32];
    volatile LAS unsigned* sq = (volatile LAS unsigned*)&sq_words[0];
    int first_win = 768;
    for (;;) {
        int tid = tid0; asm volatile("" : "+v"(tid));
        __syncthreads();
        if (tid == 0) sq[0] = atomicAdd(qctr, 1u);
        __syncthreads();
        const int idx_item = (int)sq[0];
        if (idx_item >= 512) { first_win = idx_item; break; }
        const int lane = tid & 63, wid = tid >> 6, r32 = lane & 31, hh = lane >> 5;
        const int qb = idx_item & 31, b = (idx_item >> 5) & 3, h = 3 - (idx_item >> 7);
        const int q0 = qb * 256 + wid * 32, qi = q0 + r32;
        const bf16_t* qrow = PAB + ((size_t)b * SEQ + qi) * LDAB + 640 + h * 64;
        const float scale2 = 0.17677669529663687f * LOG2E;
        bf16x8 qf[2][2];
#pragma unroll
        for (int mp = 0; mp < 2; ++mp)
#pragma unroll
            for (int st = 0; st < 2; ++st) qf[mp][st] = scale_frag(*(const bf16x8*)(qrow + mp * 32 + 16 * st + 8 * hh), scale2);
        const float slope2 = exp2f(-2.f * (float)(h + 1)) * LOG2E;
        float mA = -1e30f, mB = -1e30f, lA = 0.f, lB = 0.f;
        f32x16 OA[2], OBb[2];
#pragma unroll
        for (int i = 0; i < 16; ++i) { OA[0][i] = 0.f; OA[1][i] = 0.f; OBb[0][i] = 0.f; OBb[1][i] = 0.f; }
        const int srow = tid >> 3, sch = tid & 7;
        const bf16_t* kg = PAB + ((size_t)b * SEQ + srow) * LDAB + 896 + h * 64 + sch * 8;
        const bf16_t* vg = VT + ((size_t)(b * 6 + 2 + h) * 64 + srow) * SEQ + sch * 8;
        const int kwoff = srow * 128 + ((sch ^ (srow & 7)) * 16);
        const int vblk = sch >> 1, vhalf = sch & 1;
        const int vwoff0 = 16384 + srow * 128 + (((2 * vblk) ^ (srow & 7)) * 16) + 8 * vhalf;
        const int vwoff1 = 16384 + srow * 128 + (((2 * vblk + 1) ^ (srow & 7)) * 16) + 8 * vhalf;
        int lo, hi;
        {
            float qa = 0.f, qbm = 0.f;
#pragma unroll
            for (int st = 0; st < 2; ++st) { const u32x4 va = __builtin_bit_cast(u32x4, qf[0][st]), vb = __builtin_bit_cast(u32x4, qf[1][st]);
#pragma unroll
                for (int e = 0; e < 4; ++e) { qa += bflo(va[e]) * bflo(va[e]) + bfhi(va[e]) * bfhi(va[e]); qbm += bflo(vb[e]) * bflo(vb[e]) + bfhi(vb[e]) * bfhi(vb[e]); } }
            qa += __shfl_xor(qa, 32); qbm += __shfl_xor(qbm, 32);
            const float qaL = qa, qbL = qbm;
#pragma unroll
            for (int o = 16; o > 0; o >>= 1) { qa = fmaxf(qa, __shfl_xor(qa, o)); qbm = fmaxf(qbm, __shfl_xor(qbm, o)); }
            if (lane == 0) { sq[8 + 2 * wid] = __float_as_uint(qa); sq[9 + 2 * wid] = __float_as_uint(qbm); }
            __syncthreads();
            float qA = 0.f, qB = 0.f;
#pragma unroll
            for (int w8 = 0; w8 < 8; ++w8) { qA = fmaxf(qA, __uint_as_float(sq[8 + 2 * w8])); qB = fmaxf(qB, __uint_as_float(sq[9 + 2 * w8])); }
            const float kA = __uint_as_float(kmx[b * 8 + h * 2]), kB = __uint_as_float(kmx[b * 8 + h * 2 + 1]);
            mA = -sqrtf(qaL * kA) - 1.f; mB = -sqrtf(qbL * kB) - 1.f;
            const float bnd = 2.02f * fmaxf(sqrtf(qA * kA), sqrtf(qB * kB)) + 1.f;
            const float dsk = (168.f + bnd) / slope2;
            const int Dsk = dsk > 16384.f ? 16384 : (int)dsk + 1;
            const int Q0 = qb * 256;
            const int x = Q0 - 63 - Dsk; lo = x <= 0 ? 0 : (x + 63) >> 6;
            const int y = (Q0 + 255 + Dsk) >> 6; hi = y > 127 ? 127 : y;
        }
        const int d0 = qb * 4, nright = hi - d0 + 1, nstage = hi - lo + 1;
        u32x4 kreg, vreg;
        { const int kb = d0 * 64; kreg = *(const u32x4*)(kg + (size_t)kb * LDAB); vreg = *(const u32x4*)(vg + kb); }
        __syncthreads();
        *(u32x4*)(shm + kwoff) = kreg;
        *(u32x2*)(shm + vwoff0) = (u32x2){vreg.x, vreg.y}; *(u32x2*)(shm + vwoff1) = (u32x2){vreg.z, vreg.w};
        __syncthreads();
        for (int idx = 0; idx < nstage; ++idx) {
            const int kt = idx < nright ? d0 + idx : d0 - 1 - (idx - nright);
            const int buf = idx & 1;
            if (idx + 1 < nstage) {
                const int idn = idx + 1; const int ktn = idn < nright ? d0 + idn : d0 - 1 - (idn - nright);
                const int kbn = ktn * 64;
                kreg = *(const u32x4*)(kg + (size_t)kbn * LDAB); vreg = *(const u32x4*)(vg + kbn);
            }
            const unsigned char* Ks = shm + buf * 8192; const unsigned char* Vs = shm + 16384 + buf * 8192;
#pragma unroll
            for (int j = 0; j < 2; ++j) {
                const int kb = kt * 64 + 32 * j;
                bf16x8 kf[2][2], vf[2][2];
#pragma unroll
                for (int mp = 0; mp < 2; ++mp)
#pragma unroll
                    for (int st = 0; st < 2; ++st) kf[mp][st] = *(const bf16x8*)(Ks + (32 * j + r32) * 128 + (((mp * 4 + 2 * st + hh) ^ (r32 & 7)) * 16));
#pragma unroll
                for (int dt = 0; dt < 2; ++dt)
#pragma unroll
                    for (int s_ = 0; s_ < 2; ++s_) vf[dt][s_] = *(const bf16x8*)(Vs + (32 * dt + r32) * 128 + (((4 * j + 2 * s_ + hh) ^ (r32 & 7)) * 16));
                float qoff = (float)(kb + 4 * hh - qi); asm volatile("" : "+v"(qoff));
                f32x16 tA, tB;
                if (kb >= q0 + 32 || kb + 32 <= q0) {
                    const bool right = kb >= q0 + 32;
                    const float Lq = right ? -slope2 * qoff : slope2 * qoff;
                    const float LA = Lq - mA, LB = Lq - mB, sl = right ? -slope2 : slope2;
#pragma unroll
                    for (int reg = 0; reg < 16; ++reg) { tA[reg] = __builtin_fmaf(sl, CRW(reg), LA); tB[reg] = __builtin_fmaf(sl, CRW(reg), LB); }
                } else {
#pragma unroll
                    for (int reg = 0; reg < 16; ++reg) { const float bias = -slope2 * fabsf(qoff + CRW(reg)); tA[reg] = bias - mA; tB[reg] = bias - mB; }
                }
                tA = MFMA32(kf[0][0], qf[0][0], tA); tA = MFMA32(kf[0][1], qf[0][1], tA);
                tB = MFMA32(kf[1][0], qf[1][0], tB); tB = MFMA32(kf[1][1], qf[1][1], tB);
                float mxA = 0.f, mxB = 0.f;
#pragma unroll
                for (int reg = 0; reg < 16; ++reg) { mxA = fmaxf(mxA, tA[reg]); mxB = fmaxf(mxB, tB[reg]); }
                mxA = fmaxf(mxA, __shfl_xor(mxA, 32)); mxB = fmaxf(mxB, __shfl_xor(mxB, 32));
                if (__builtin_amdgcn_ballot_w64(mxA > 0.f) != 0ull) {
                    const float alpha = fexp2(-mxA); mA += mxA; lA *= alpha;
#pragma unroll
                    for (int i = 0; i < 16; ++i) { OA[0][i] *= alpha; OA[1][i] *= alpha; tA[i] -= mxA; }
                }
                if (__builtin_amdgcn_ballot_w64(mxB > 0.f) != 0ull) {
                    const float alpha = fexp2(-mxB); mB += mxB; lB *= alpha;
#pragma unroll
                    for (int i = 0; i < 16; ++i) { OBb[0][i] *= alpha; OBb[1][i] *= alpha; tB[i] -= mxB; }
                }
                float psA = 0.f, psB = 0.f;
#pragma unroll
                for (int reg = 0; reg < 16; ++reg) { tA[reg] = fexp2(tA[reg]); psA += tA[reg]; tB[reg] = fexp2(tB[reg]); psB += tB[reg]; }
                lA += psA; lB += psB;
                const bf16x8 pA0 = packpv(tA, 0), pA1 = packpv(tA, 1), pB0 = packpv(tB, 0), pB1 = packpv(tB, 1);
#pragma unroll
                for (int dt = 0; dt < 2; ++dt) {
                    OA[dt] = MFMA32(vf[dt][0], pA0, OA[dt]); OA[dt] = MFMA32(vf[dt][1], pA1, OA[dt]);
                    OBb[dt] = MFMA32(vf[dt][0], pB0, OBb[dt]); OBb[dt] = MFMA32(vf[dt][1], pB1, OBb[dt]);
                }
            }
            if (idx + 1 < nstage) {
                unsigned char* wb = shm + (buf ^ 1) * 8192;
                *(u32x4*)(wb + kwoff) = kreg;
                *(u32x2*)(wb + vwoff0) = (u32x2){vreg.x, vreg.y}; *(u32x2*)(wb + vwoff1) = (u32x2){vreg.z, vreg.w};
            }
            __syncthreads();
        }
        lA += __shfl_xor(lA, 32); lB += __shfl_xor(lB, 32);
        const float iA = 1.f / lA, iB = lam / lB;
        float ss = 0.f;
#pragma unroll
        for (int dt = 0; dt < 2; ++dt)
#pragma unroll
            for (int i = 0; i < 16; ++i) { const float v = OA[dt][i] * iA - OBb[dt][i] * iB; OA[dt][i] = v; ss += v * v; }
        ss += __shfl_xor(ss, 32);
        const float rstd = __builtin_amdgcn_rsqf(ss * (1.f / 64.f) + EPS) * (1.f - lam_init);
        bf16_t* orow = OB + ((size_t)b * SEQ + qi) * DM + 384 + h * 64;
#pragma unroll
        for (int dt = 0; dt < 2; ++dt)
#pragma unroll
            for (int g4 = 0; g4 < 4; ++g4) {
                const int d = 32 * dt + 8 * g4 + 4 * hh;
                const f32x4 gv = *(const f32x4*)(dg + d);
                u32x2 w = {pk2(OA[dt][4 * g4] * rstd * gv[0], OA[dt][4 * g4 + 1] * rstd * gv[1]), pk2(OA[dt][4 * g4 + 2] * rstd * gv[2], OA[dt][4 * g4 + 3] * rstd * gv[3])};
                *(u32x2*)(orow + d) = w;
            }
    }
    for (int item = first_win; item < 768;) {
        int tid = tid0; asm volatile("" : "+v"(tid));
        win_block(p, l, item - 512, tid, shm);
        __syncthreads();
        if (tid == 0) sq[0] = atomicAdd(qctr, 1u);
        __syncthreads();
        item = (int)sq[0];
    }
}

DI void phase_post(const Params& p, int l, int gw, int nw, int lane) {
    unsigned char* ws = p.ws;
    const bf16_t* OT = (const bf16_t*)(ws + OFF_WB); const bf16_t* PAB = (const bf16_t*)(ws + OFF_PAB); bf16_t* OB = (bf16_t*)(ws + OFF_OB);
    const float gl = p.in[12][l * 64 + lane];
    for (int u = gw; u < 6144; u += nw) {
        const int half = u & 1, h = (u % 12) >> 1, ck = u / 12, b = ck >> 7, chunk = ck & 127;
        const size_t itf = ((size_t)((b * 6 + h) * 2) * 128 + chunk), itb = ((size_t)((b * 6 + h) * 2 + 1) * 128 + (127 - chunk));
        const size_t tok0 = (size_t)b * SEQ + chunk * 64 + half * 32;
#pragma unroll 1
        for (int g = 0; g < 2; ++g) {
            float av[16], zv[16];
#pragma unroll
            for (int j = 0; j < 16; ++j) {
                const int t = half * 32 + g * 16 + j;
                av[j] = bf2f(OT[itf * 4096 + t * 64 + lane]) + bf2f(OT[itb * 4096 + (63 - t) * 64 + lane]);
                zv[j] = bf2f(PAB[(tok0 + g * 16 + j) * LDAB + 1408 + h * 64 + lane]);
            }
#pragma unroll
            for (int j = 0; j < 16; ++j) {
                const float ss = wave_sum(av[j] * av[j]);
                const float y = av[j] * __builtin_amdgcn_rsqf(ss * (1.f / 64.f) + EPS) * gl;
                OB[(tok0 + g * 16 + j) * DM + 640 + h * 64 + lane] = f2bf(y * silu(zv[j]));
            }
        }
    }
}

#define XB_TMO      128
#define XB_XCNT(j)  (256  + 64 * (j))
#define XB_XSUB(j)  (1280 + 64 * (j))
#define XB_XGEN(j)  (2304 + 64 * (j))
#define XB_TOP      3328
#define XB_TOPGEN   3392
#define XCD_BAR_WORDS 3456
#define XB_SPIN_CAP (1u << 18)
DI unsigned xb_ld(unsigned* p)              { return __hip_atomic_load(p, __ATOMIC_RELAXED, __HIP_MEMORY_SCOPE_AGENT); }
DI unsigned xb_add(unsigned* p, unsigned v) { return __hip_atomic_fetch_add(p, v, __ATOMIC_RELAXED, __HIP_MEMORY_SCOPE_AGENT); }
DI unsigned xb_xcc_id() { return (unsigned)__builtin_amdgcn_s_getreg((3 << 11) | 20) & 0xFu; }
#define XB_SPIN(cond, bar) do { unsigned _sp = 0; while (cond) { __builtin_amdgcn_s_sleep(1); \
    if ((++_sp & 255u) == 0u) { if (xb_ld(&(bar)[XB_TMO])) break; if (_sp > XB_SPIN_CAP) { atomicAdd(&(bar)[XB_TMO], 1u); break; } } } } while (0)
struct XcdBarrier { unsigned* bar; unsigned x; volatile LAS unsigned* st; };
DI XcdBarrier xcd_barrier_post(unsigned* bar, volatile LAS unsigned* st) {
    XcdBarrier b; b.bar = bar; b.x = xb_xcc_id(); b.st = st;
    if (threadIdx.x == 0) (void)xb_add(&bar[XB_XCNT(b.x)], 1u);
    return b;
}
DI void xcd_barrier_complete(unsigned* bar, unsigned x, unsigned& nloc, unsigned& nx) {
    const unsigned G = gridDim.x * gridDim.y * gridDim.z;
    unsigned sum, cnt, mine, sp = 0u;
    for (;;) {
        sum = 0u; cnt = 0u; mine = 0u;
#pragma unroll
        for (unsigned j = 0; j < 16; ++j) { const unsigned c = xb_ld(&bar[XB_XCNT(j)]); sum += c; cnt += (c > 0u) ? 1u : 0u; mine = (j == x) ? c : mine; }
        if (sum == G) break;
        __builtin_amdgcn_s_sleep(1);
        if ((++sp & 255u) == 0u) { if (xb_ld(&bar[XB_TMO])) break; if (sp > XB_SPIN_CAP) { atomicAdd(&bar[XB_TMO], 1u); break; } }
    }
    nloc = mine > 0u ? mine : 1u; nx = cnt > 0u ? cnt : 1u;
}
DI void xcd_barrier(const XcdBarrier& b) {
    asm volatile("s_waitcnt vmcnt(0)" ::: "memory");
    __syncthreads();
    if (threadIdx.x == 0) {
        unsigned* bar = b.bar;
        __builtin_amdgcn_s_waitcnt(0);
        unsigned nloc = b.st[0], nx = b.st[1];
        if (nloc == 0u) { xcd_barrier_complete(bar, b.x, nloc, nx); b.st[0] = nloc; b.st[1] = nx; }
        const unsigned old = xb_add(&bar[XB_XSUB(b.x)], 1u);
        const unsigned gen = old / nloc;
        if (old + 1u == (gen + 1u) * nloc) {
            __builtin_amdgcn_fence(__ATOMIC_RELEASE, "agent");
            asm volatile("s_waitcnt vmcnt(0)" ::: "memory");
            const unsigned og = xb_add(&bar[XB_TOP], 1u);
            const unsigned tg = og / nx;
            if (og + 1u == (tg + 1u) * nx) xb_add(&bar[XB_TOPGEN], 1u);
            else XB_SPIN(xb_ld(&bar[XB_TOPGEN]) == tg, bar);
            __builtin_amdgcn_fence(__ATOMIC_ACQUIRE, "agent");
            xb_add(&bar[XB_XGEN(b.x)], 1u);
            asm volatile("s_waitcnt vmcnt(0)" ::: "memory");
        } else {
            XB_SPIN(xb_ld(&bar[XB_XGEN(b.x)]) == gen, bar);
            __builtin_amdgcn_fence(__ATOMIC_ACQUIRE, "agent");
            asm volatile("s_waitcnt vmcnt(0)" ::: "memory");
        }
    }
    __syncthreads();
}

constexpr int NPHASE = 30;
DI void run_phase(const Params& p, int ph, unsigned char* shm, int tid) {
    const int wid = tid >> 6, lane = tid & 63;
    const int gw = blockIdx.x * 8 + wid, nw = gridDim.x * 8;
    unsigned char* ws = p.ws;
    if (ph == 0) { if (EN(0)) { phase_init(p, gw, nw, lane); phase_convw(p, 0, shm, tid); } return; }
    if (ph == NPHASE - 1) { if (EN(27)) phase_final(p, gw, nw, lane); return; }
    const int l = (ph - 1) / 14, sub = (ph - 1) % 14;
    float* rss = (float*)(ws + OFF_RSS);
    bf16_t* XB = (bf16_t*)(ws + OFF_XB);
    LAS unsigned char* lds = (LAS unsigned char*)shm;
    pg8::StaticOrder S;
    if (sub == 0) { if (EN(0)) if (l > 0) phase_convw(p, l, shm, tid); return; }
    if (EN(1)) if (sub == 1 || sub == 12) {
        const int f = sub == 1 ? 0 : 1;
        pg8::Gemm g{XB, (const bf16_t*)(ws + (f ? OFF_W_FFN2IN : OFF_W_FFN1IN)), MTOK, NFF, DM};
        EpiSwiglu E{(bf16_t*)(ws + OFF_BIG), rss + (size_t)((3 * l + (f ? 2 : 0)) & 1) * MTOK * 16};
        S.init(MTOK, NFF, gridDim.x, blockIdx.x);
        pg8::gemm_phase(tid, lds, g, S, E);
        if ((REPMASK >> 1) & 1) { __syncthreads(); pg8::gemm_phase(tid, lds, g, S, E); }
        return;
    }
    if (EN(2)) if (sub == 2 || sub == 13 || sub == 11) {
        const bf16_t* A; const bf16_t* Bt; int K; float scale; int nn;
        if (sub == 2) { A = (const bf16_t*)(ws + OFF_BIG); Bt = (const bf16_t*)(ws + OFF_W_FFN1OUT); K = DFFP; scale = 0.5f; nn = 3 * l + 1; }
        else if (sub == 13) { A = (const bf16_t*)(ws + OFF_BIG); Bt = (const bf16_t*)(ws + OFF_W_FFN2OUT); K = DFFP; scale = 0.5f; nn = 3 * l + 3; }
        else { A = (const bf16_t*)(ws + OFF_OB); Bt = (const bf16_t*)(ws + OFF_W_MIXOUT); K = DM; scale = 1.f; nn = 3 * l + 2; }
        pg8::Gemm g{A, Bt, MTOK, DM, K};
        EpiResid E{(l == 0 && sub == 2) ? p.in[0] : (const float*)p.out, p.out, XB, rss + (size_t)(nn & 1) * MTOK * 16, scale};
        S.init(MTOK, DM, gridDim.x, blockIdx.x);
        pg8::gemm_phase(tid, lds, g, S, E); return;
    }
    if (EN(3)) if (sub == 3) {
        pg8::Gemm g{XB, (const bf16_t*)(ws + OFF_W_MIXIN), MTOK, NMIX, DM};
        EpiMixIn E{(bf16_t*)(ws + OFF_PAB), (bf16_t*)(ws + OFF_PC), (float*)(ws + OFF_BG), rss + (size_t)((3 * l + 1) & 1) * MTOK * 16};
        S.init(MTOK, NMIX, gridDim.x, blockIdx.x);
        pg8::gemm_phase(tid, lds, g, S, E);
        return;
    }
    if (EN(4)) if (sub == 4) { REP(4) phase_prep(p, l, gw, nw, lane); return; }
    if (EN(5)) if (sub == 5) { REP(5) phase_chunk(p, l, gw, nw, lane, wid, shm); return; }
    if (EN(6)) if (sub == 6) {
        if (blockIdx.x < 48) phase_scan(p, lane, wid, shm);
        phase_diff(p, l, tid, shm);
        return;
    }
    if (EN(10)) if (sub == 7) { phase_outp(p, gw, nw, lane); return; }


    if (EN(9)) if (sub == 10) { REP(9) phase_post(p, l, gw, nw, lane); return; }
}

__global__ __launch_bounds__(512, 2) void mega(Params p) {
    extern __shared__ __attribute__((aligned(16))) unsigned char shm[];
    __shared__ uint4 xb_words;
    if (threadIdx.x == 0) xb_words = make_uint4(0u, 0u, 0u, 0u);
    __syncthreads();
    const XcdBarrier xb = xcd_barrier_post((unsigned*)(p.ws + OFF_BAR), (volatile LAS unsigned*)&xb_words);
#ifndef PROBE_DUP
    for (int ph = p.p0; ph < p.p1; ++ph) {
        if (ph == 1 || ph == 9 || ph == 10 || ph == 23 || ph == 24) continue;
        int tid = threadIdx.x; asm volatile("" : "+v"(tid));
        Params q = p;
#if defined(__HIP_DEVICE_COMPILE__)
        {
            typedef __attribute__((address_space(1))) unsigned char GUC; typedef __attribute__((address_space(1))) float GF; typedef __attribute__((address_space(1))) const float GCF;
            unsigned long long wsi = (unsigned long long)p.ws, oi = (unsigned long long)p.out; asm volatile("" : "+s"(wsi), "+s"(oi));
            q.ws = (unsigned char*)(GUC*)wsi; q.out = (float*)(GF*)oi;
#pragma unroll
            for (int ii = 0; ii < 18; ++ii) q.in[ii] = (const float*)(GCF*)(unsigned long long)p.in[ii];
        }
#endif
        run_phase(q, ph, shm, tid);
        if (ph + 1 < p.p1) {
            if (ph == 0) cg::this_grid().sync();
            else xcd_barrier(xb);
        }
    }
#else
    for (int st = 0; st < 2 * NPHASE; ++st) {
        const int ph = st >> 1;
        if (ph == 1 || ph == 9 || ph == 10 || ph == 23 || ph == 24) continue;
        const int subp = (ph >= 1 && ph <= 28) ? (ph - 1) % 14 : (ph == 0 ? 14 : 15);
        if ((st & 1) && !((PROBE_DUP >> subp) & 1)) continue;
        int tid = threadIdx.x; asm volatile("" : "+v"(tid));
        Params q = p; asm volatile("" : "+s"(q.ws), "+s"(q.out));
        run_phase(q, ph, shm, tid);
        cg::this_grid().sync();
    }
#endif
}

extern "C" void kernel_launch(void* const* d_in, const int* in_sizes, int n_in, void* d_out, int out_size, void* d_ws, size_t ws_size, hipStream_t stream) {
    static int grid = 0;
    if (!grid) {
        hipFuncSetAttribute((const void*)mega, hipFuncAttributeMaxDynamicSharedMemorySize, LDS_BYTES);
        int dev = 0, cus = 0, per = 0;
        hipGetDevice(&dev);
        hipDeviceGetAttribute(&cus, hipDeviceAttributeMultiprocessorCount, dev);
        hipOccupancyMaxActiveBlocksPerMultiprocessor(&per, mega, 512, LDS_BYTES);
        if (per < 1) per = 1;
        grid = cus * per;
        if (grid > 256) grid = 256;
    }
    (void)hipMemsetAsync((unsigned char*)d_ws + OFF_BAR, 0, 3456 * 4, stream);
    Params p{};
    for (int i = 0; i < 18; ++i) p.in[i] = (const float*)d_in[i];
    p.out = (float*)d_out; p.ws = (unsigned char*)d_ws;
#if MULTI
    for (int ph = 0; ph < NPHASE; ++ph) {
        if (ph == 1 || ph == 9 || ph == 10 || ph == 23 || ph == 24) continue;
        p.p0 = ph; p.p1 = ph + 1;
        hipLaunchKernelGGL(mega, dim3(grid), dim3(512), LDS_BYTES, stream, p);
    }
#else
    p.p0 = 0; p.p1 = NPHASE;
    void* args[] = {&p};
    hipError_t e = hipLaunchCooperativeKernel((const void*)mega, dim3(grid), dim3(512), args, LDS_BYTES, stream);
    if (e != hipSuccess) fprintf(stderr, "cooperative launch failed: %s (grid %d)\n", hipGetErrorString(e), grid);
#endif
}
```

```cpp
#include <hip/hip_runtime.h>
#include <hip/hip_cooperative_groups.h>
#include <cstdio>
namespace cg = cooperative_groups;


#ifndef REPMASK
#define REPMASK 0
#endif
#define REP(k) for (int rep_ = 0; rep_ < (((REPMASK >> (k)) & 1) ? 2 : 1); ++rep_)
#ifndef MULTI
#define MULTI 0
#endif

#ifdef ONLY
#define EN(k) (ONLY==(k))
#else
#define EN(k) 1
#endif
#define DI __device__ __forceinline__
#define LAS __attribute__((address_space(3)))
typedef unsigned short bf16_t;
typedef short bf16x8 __attribute__((ext_vector_type(8)));
typedef short s16x4 __attribute__((ext_vector_type(4)));
typedef float f32x4 __attribute__((ext_vector_type(4)));
typedef float f32x16 __attribute__((ext_vector_type(16)));
typedef float f32x2 __attribute__((ext_vector_type(2)));
typedef unsigned u32x4 __attribute__((ext_vector_type(4)));
typedef unsigned u32x2 __attribute__((ext_vector_type(2)));
typedef __bf16 bf16v2 __attribute__((ext_vector_type(2)));

constexpr int DM = 1024, NBATCH = 4, SEQ = 8192, MTOK = NBATCH * SEQ, DFF = 2752, DFFP = 2816, NFF = 2 * DFFP, NMIX = 3072;
constexpr int LDAB = 1792, LDC = 1280;
constexpr float EPS = 1e-6f, LOG2E = 1.4426950408889634f;
constexpr int LDS_BYTES = 131072;

constexpr size_t SZ_W_FFNIN = (size_t)NFF * DM * 2, SZ_W_FFNOUT = (size_t)DM * DFFP * 2, SZ_W_MIXIN = (size_t)NMIX * DM * 2, SZ_W_MIXOUT = (size_t)DM * DM * 2;
constexpr size_t OFF_W_FFN1IN = 0;
constexpr size_t OFF_W_FFN1OUT = OFF_W_FFN1IN + SZ_W_FFNIN;
constexpr size_t OFF_W_MIXIN = OFF_W_FFN1OUT + SZ_W_FFNOUT;
constexpr size_t OFF_W_MIXOUT = OFF_W_MIXIN + SZ_W_MIXIN;
constexpr size_t OFF_W_FFN2IN = OFF_W_MIXOUT + SZ_W_MIXOUT;
constexpr size_t OFF_W_FFN2OUT = OFF_W_FFN2IN + SZ_W_FFNIN;
constexpr size_t OFF_XB = OFF_W_FFN2OUT + SZ_W_FFNOUT;
constexpr size_t SZ_TILE = (size_t)3072 * 4096 * 2;
constexpr size_t OFF_QC = OFF_XB, OFF_KTC = OFF_XB + SZ_TILE;
constexpr size_t OFF_OB = OFF_XB + (size_t)MTOK * DM * 2;
constexpr size_t OFF_BIG = OFF_OB + (size_t)MTOK * DM * 2;
constexpr size_t OFF_PAB = OFF_BIG, OFF_PC = OFF_BIG + (size_t)MTOK * LDAB * 2;
constexpr size_t OFF_U = OFF_PC, OFF_WB = OFF_PC + (size_t)6144 * 8192;
constexpr size_t OFF_BG = OFF_WB + (size_t)6144 * 8192;
constexpr size_t OFF_RSS = OFF_BG + (size_t)MTOK * 24 * 4;
constexpr size_t OFF_VT = OFF_RSS + (size_t)2 * MTOK * 16 * 4;
constexpr size_t OFF_KC = OFF_VT + (size_t)NBATCH * 6 * 64 * SEQ * 2;
constexpr size_t OFF_VTC = OFF_KC + SZ_TILE;
constexpr size_t OFF_SST = OFF_KC;
constexpr size_t OFF_QK = OFF_VTC + SZ_TILE;
constexpr size_t OFF_GC = OFF_QK + (size_t)6144 * 8192;
constexpr size_t OFF_MISC = OFF_GC + (size_t)6144 * 64 * 4;
constexpr size_t OFF_BAR = OFF_MISC + 512;
constexpr size_t WS_TOTAL = OFF_BAR + 3456 * 4;
static_assert(WS_TOTAL <= (size_t)536870912, "workspace too large");
static_assert((size_t)MTOK * DFFP * 2 <= OFF_BG - OFF_BIG, "hidden does not fit");

struct Params {
    const float* in[18];
    float* out;
    unsigned char* ws;
    int p0, p1;
};

DI unsigned pk2(float a, float b) { f32x2 v = {a, b}; bf16v2 r = __builtin_convertvector(v, bf16v2); return __builtin_bit_cast(unsigned, r); }
DI bf16_t f2bf(float a) { return (bf16_t)(pk2(a, 0.f) & 0xffffu); }
DI float bf2f(bf16_t v) { return __uint_as_float(((unsigned)v) << 16); }
DI float bflo(unsigned v) { return __uint_as_float(v << 16); }
DI float bfhi(unsigned v) { return __uint_as_float(v & 0xffff0000u); }
DI float wave_sum(float v) {
    v += __builtin_bit_cast(float, __builtin_amdgcn_update_dpp(0, __builtin_bit_cast(int, v), 0xB1, 0xf, 0xf, true));
    v += __builtin_bit_cast(float, __builtin_amdgcn_update_dpp(0, __builtin_bit_cast(int, v), 0x4E, 0xf, 0xf, true));
    v += __builtin_bit_cast(float, __builtin_amdgcn_update_dpp(0, __builtin_bit_cast(int, v), 0x141, 0xf, 0xf, true));
    v += __builtin_bit_cast(float, __builtin_amdgcn_update_dpp(0, __builtin_bit_cast(int, v), 0x140, 0xf, 0xf, true));
    const int iv = __builtin_bit_cast(int, v);
    const float a = __builtin_bit_cast(float, __builtin_amdgcn_readlane(iv, 0)), b = __builtin_bit_cast(float, __builtin_amdgcn_readlane(iv, 16));
    const float c = __builtin_bit_cast(float, __builtin_amdgcn_readlane(iv, 32)), d = __builtin_bit_cast(float, __builtin_amdgcn_readlane(iv, 48));
    return (a + b) + (c + d);
}
DI bf16x8 ld2x8(const bf16_t* a, const bf16_t* b) { u32x2 x = *(const u32x2*)a, y = *(const u32x2*)b; u32x4 r = {x.x, x.y, y.x, y.y}; return __builtin_bit_cast(bf16x8, r); }
DI unsigned rot16(unsigned x) { return (x >> 16) | (x << 16); }
DI bf16x8 ld2x8rev(const bf16_t* a, const bf16_t* b) {
    u32x2 x = *(const u32x2*)a, y = *(const u32x2*)b; u32x4 r = {rot16(x.y), rot16(x.x), rot16(y.y), rot16(y.x)}; return __builtin_bit_cast(bf16x8, r);
}
DI bf16x8 pack8(f32x4 a, f32x4 b) { u32x4 r = {pk2(a[0], a[1]), pk2(a[2], a[3]), pk2(b[0], b[1]), pk2(b[2], b[3])}; return __builtin_bit_cast(bf16x8, r); }
DI float fexp2(float x) { return __builtin_amdgcn_exp2f(x); }
DI float fexp(float x) { return __builtin_amdgcn_exp2f(x * LOG2E); }
DI float silu(float x) { return x * __builtin_amdgcn_rcpf(1.f + fexp(-x)); }
DI float row_rstd(const float* rp, int row) {
    const f32x4 a = *(const f32x4*)(rp + (size_t)row * 16), b = *(const f32x4*)(rp + (size_t)row * 16 + 4), c = *(const f32x4*)(rp + (size_t)row * 16 + 8), d = *(const f32x4*)(rp + (size_t)row * 16 + 12);
    const float s = ((a[0] + a[1]) + (a[2] + a[3])) + ((b[0] + b[1]) + (b[2] + b[3])) + ((c[0] + c[1]) + (c[2] + c[3])) + ((d[0] + d[1]) + (d[2] + d[3]));
    return __builtin_amdgcn_rsqf(s * (1.f / DM) + EPS);
}
#define MFMA16(a, b, c) __builtin_amdgcn_mfma_f32_16x16x32_bf16((a), (b), (c), 0, 0, 0)
#define MFMA32(a, b, c) __builtin_amdgcn_mfma_f32_32x32x16_bf16((a), (b), (c), 0, 0, 0)

namespace pg8 {
constexpr int BM = 256, BK = 64, HALF = 128, HTB = HALF * BK * 2, STAGE_BYTES = 8 * HTB, NXCD = 8, WGM = 8;
DI int lds_byte(int r, int c) { const int st = (r >> 4) * 2 + (c >> 5), rr = r & 15, cc = c & 31, ob = rr * 64 + cc * 2; return st * 1024 + (ob ^ (((ob >> 9) & 1) << 5)); }
DI void stage_rc(int b, int& R, int& C) { const int st = b / 1024, sb = b % 1024, swz = sb ^ (((sb >> 9) & 1) << 5); R = (st >> 1) * 16 + swz / 64; C = (st & 1) * 32 + (swz % 64) / 2; }
DI int perm32(int rho) { const int n = rho >> 4, i = rho & 15; return 8 * (i >> 2) + 4 * n + (i & 3); }
struct Unit { int pm, pn; };
struct Gemm { const bf16_t* A; const bf16_t* Bt; int M, N, K; };
struct StaticOrder {
    int nM, nN, nwg, G, c;
    DI void init(int M, int N, int G_, int c_) { nM = M / BM; nN = N / BM; nwg = nM * nN; G = G_; c = c_; }
    DI bool next(int i, Unit& u) const {
        const long L = (long)i * G + c; if (L >= nwg) return false;
        int wgid = (int)L; { const int q = nwg / NXCD, r = nwg % NXCD, xcd = wgid % NXCD, off = wgid / NXCD; wgid = (xcd < r ? xcd * (q + 1) : r * (q + 1) + (xcd - r) * q) + off; }
        const int nig = WGM * nN, gid = wgid / nig, fm = gid * WGM, gsz = (nM - fm) < WGM ? (nM - fm) : WGM;
        u.pm = fm + ((wgid % nig) % gsz); u.pn = (wgid % nig) / gsz; return true;
    }
};
template <class Epi>
DI void gemm_phase(int tid, LAS unsigned char* lds, const Gemm g, const StaticOrder& S, const Epi& E) {
    const int wid = __builtin_amdgcn_readfirstlane(tid >> 6), lane = tid & 63, wr = wid >> 2, wc = wid & 3, fr = lane & 15, fq = lane >> 4;
    const int K = g.K, nt = K / BK;
    unsigned voffA[2], voffB[2];
#pragma unroll
    for (int i = 0; i < 2; ++i) { int R, C; stage_rc(tid * 16 + i * 8192, R, C); const int Rb = (R & ~31) + perm32(R & 31);
        voffA[i] = (unsigned)(R * K + C) * 2u; voffB[i] = (unsigned)(Rb * K + C) * 2u; }
    const size_t kstep = (size_t)(BK * 2);
    const size_t hstep = (size_t)HALF * K * 2;
    const size_t tstep = 2 * hstep;
    const unsigned ldsw = (unsigned)wid * 1024u;
    const int aoff = lds_byte(wr * 64 + fr, fq * 8), boff = lds_byte(wc * 32 + fr, fq * 8);
#define PG8_SA(b, h) (((b) * 2 + (h)) * HTB)
#define PG8_SB(b, h) ((4 + (b) * 2 + (h)) * HTB)
#define PG8_STAGE(bufoff, gbase, voff) do { _Pragma("unroll") for (int _i = 0; _i < 2; ++_i) \
        __builtin_amdgcn_global_load_lds((const unsigned*)((const char*)(gbase) + (voff)[_i]), (LAS unsigned*)(lds + (bufoff) + ldsw + _i * 8192), 16, 0, 0); } while (0)
#define PG8_LDA(dst, b, h) do { _Pragma("unroll") for (int m = 0; m < 4; ++m) _Pragma("unroll") for (int k = 0; k < 2; ++k) dst[m][k] = *(const LAS bf16x8*)(lds + PG8_SA(b, h) + aoff + m * 2048 + k * 1024); } while (0)
#define PG8_LDB(dst, b, h) do { _Pragma("unroll") for (int n = 0; n < 2; ++n) _Pragma("unroll") for (int k = 0; k < 2; ++k) dst[n][k] = *(const LAS bf16x8*)(lds + PG8_SB(b, h) + boff + n * 2048 + k * 1024); } while (0)
#define PG8_MMA(ai, bj, At, Bt) do { __builtin_amdgcn_s_setprio(1); _Pragma("unroll") for (int m = 0; m < 4; ++m) _Pragma("unroll") for (int n = 0; n < 2; ++n) _Pragma("unroll") for (int k = 0; k < 2; ++k) \
        acc[ai][bj][m][n] = __builtin_amdgcn_mfma_f32_16x16x32_bf16(Bt[n][k], At[m][k], acc[ai][bj][m][n], 0, 0, 0); __builtin_amdgcn_s_setprio(0); } while (0)
#define PG8_WAIT_V(n) asm volatile("s_waitcnt vmcnt(" #n ")" ::: "memory")
#define PG8_WAIT_L(n) asm volatile("s_waitcnt lgkmcnt(" #n ")" ::: "memory")
#define PG8_BAR __builtin_amdgcn_s_barrier()
#define PG8_SCHED __builtin_amdgcn_sched_barrier(0)
    Unit cur, nxt; int ui = 0;
    if (!S.next(0, cur)) return;
    f32x4 acc[2][2][4][2];
#pragma unroll
    for (int a = 0; a < 2; ++a)
#pragma unroll
        for (int b = 0; b < 2; ++b)
#pragma unroll
            for (int m = 0; m < 4; ++m)
#pragma unroll
                for (int n = 0; n < 2; ++n) acc[a][b][m][n] = (f32x4){0.f, 0.f, 0.f, 0.f};
    bf16x8 At[4][2], B0[2][2], B1[2][2];
    const char* cA = (const char*)g.A + (size_t)cur.pm * tstep; const char* cB = (const char*)g.Bt + (size_t)cur.pn * tstep;
    PG8_STAGE(PG8_SB(0, 0), cB, voffB); PG8_STAGE(PG8_SB(0, 1), cB + hstep, voffB); PG8_STAGE(PG8_SA(0, 0), cA, voffA); PG8_STAGE(PG8_SA(0, 1), cA + hstep, voffA);
    if (wr == 1) PG8_BAR;
    PG8_WAIT_V(2); PG8_BAR;
    PG8_STAGE(PG8_SB(1, 0), cB + kstep, voffB); PG8_STAGE(PG8_SA(1, 0), cA + kstep, voffA); PG8_STAGE(PG8_SB(1, 1), cB + hstep + kstep, voffB);
    PG8_WAIT_V(6); PG8_BAR;
    for (;;) {
        const bool has_next = S.next(ui + 1, nxt);
        const char* nA = has_next ? (const char*)g.A + (size_t)nxt.pm * tstep : cA; const char* nB = has_next ? (const char*)g.Bt + (size_t)nxt.pn * tstep : cB;
        for (int t = 0; t < nt; t += 2) {
            const bool last = (t == nt - 2);
            const char* a1 = cA + (size_t)(t + 1) * kstep;
            const char* a2 = last ? nA : cA + (size_t)(t + 2) * kstep; const char* b2 = last ? nB : cB + (size_t)(t + 2) * kstep;
            const char* a3 = a2 + kstep; const char* b3 = b2 + kstep;
            PG8_LDB(B0, 0, 0); PG8_LDB(B1, 0, 1); PG8_SCHED; PG8_LDA(At, 0, 0); PG8_STAGE(PG8_SA(1, 1), a1 + hstep, voffA);
            PG8_WAIT_V(8); PG8_WAIT_L(0); PG8_BAR; PG8_MMA(0, 0, At, B0); PG8_MMA(0, 1, At, B1); PG8_BAR; PG8_SCHED;
            PG8_LDA(At, 0, 1); PG8_STAGE(PG8_SB(0, 0), b2, voffB); PG8_STAGE(PG8_SB(0, 1), b2 + hstep, voffB); PG8_STAGE(PG8_SA(0, 0), a2, voffA);
            PG8_WAIT_V(8); PG8_WAIT_L(0); PG8_BAR; PG8_MMA(1, 0, At, B0); PG8_MMA(1, 1, At, B1); PG8_BAR; PG8_SCHED;
            PG8_LDB(B0, 1, 0); PG8_LDB(B1, 1, 1); PG8_SCHED; PG8_LDA(At, 1, 0); PG8_STAGE(PG8_SA(0, 1), a2 + hstep, voffA);
            PG8_WAIT_V(8); PG8_WAIT_L(0); PG8_BAR; PG8_MMA(0, 0, At, B0); PG8_MMA(0, 1, At, B1); PG8_BAR; PG8_SCHED;
            PG8_LDA(At, 1, 1); PG8_STAGE(PG8_SB(1, 0), b3, voffB); PG8_STAGE(PG8_SB(1, 1), b3 + hstep, voffB); PG8_STAGE(PG8_SA(1, 0), a3, voffA);
            PG8_WAIT_V(8); PG8_WAIT_L(0); PG8_BAR; PG8_MMA(1, 0, At, B0); PG8_MMA(1, 1, At, B1); PG8_BAR; PG8_SCHED;
        }
        if (wr == 0) PG8_BAR;
        E(acc, cur, wr, wc, fr, fq);
        if (!has_next) break;
#pragma unroll
        for (int a = 0; a < 2; ++a)
#pragma unroll
            for (int b = 0; b < 2; ++b)
#pragma unroll
                for (int m = 0; m < 4; ++m)
#pragma unroll
                    for (int n = 0; n < 2; ++n) acc[a][b][m][n] = (f32x4){0.f, 0.f, 0.f, 0.f};
        cur = nxt; cA = nA; cB = nB; ++ui;
        if (wr == 1) PG8_BAR;
    }
    PG8_WAIT_V(0);
    PG8_BAR;
#undef PG8_SA
#undef PG8_SB
#undef PG8_STAGE
#undef PG8_LDA
#undef PG8_LDB
#undef PG8_MMA
#undef PG8_WAIT_V
#undef PG8_WAIT_L
#undef PG8_BAR
#undef PG8_SCHED
}
}
using pg8::Unit;
typedef f32x4 AccT[2][2][4][2];

struct EpiSwiglu {
    bf16_t* H; const float* rss;
    DI void operator()(const AccT& acc, const Unit& u, int wr, int wc, int fr, int fq) const {
        const int row0 = u.pm * 256 + wr * 64 + fr, col0 = u.pn * 128 + wc * 32 + 8 * fq;
#pragma unroll
        for (int ai = 0; ai < 2; ++ai)
#pragma unroll
            for (int m = 0; m < 4; ++m) {
                const int row = row0 + ai * 128 + m * 16;
                const float rstd = row_rstd(rss, row);
                float hv[8];
#pragma unroll
                for (int n = 0; n < 2; ++n)
#pragma unroll
                    for (int j = 0; j < 4; ++j) { const float gg = acc[ai][0][m][n][j] * rstd, uu = acc[ai][1][m][n][j] * rstd; hv[4 * n + j] = silu(gg) * uu; }
                u32x4 w = {pk2(hv[0], hv[1]), pk2(hv[2], hv[3]), pk2(hv[4], hv[5]), pk2(hv[6], hv[7])};
                *(u32x4*)(H + (size_t)row * DFFP + col0) = w;
            }
    }
};
struct EpiResid {
    const float* Xin; float* X; bf16_t* XB; float* rssn; float scale;
    DI void operator()(const AccT& acc, const Unit& u, int wr, int wc, int fr, int fq) const {
        const int row0 = u.pm * 256 + wr * 64 + fr, col0 = u.pn * 256 + wc * 32 + 8 * fq;
#pragma unroll
        for (int ai = 0; ai < 2; ++ai)
#pragma unroll
            for (int m = 0; m < 4; ++m) {
                const int row = row0 + ai * 128 + m * 16; float ss = 0.f;
#pragma unroll
                for (int bj = 0; bj < 2; ++bj) {
                    float* xp = X + (size_t)row * DM + col0 + bj * 128; const float* xi = Xin + (size_t)row * DM + col0 + bj * 128;
                    f32x4 x0 = *(const f32x4*)xi, x1 = *(const f32x4*)(xi + 4);
                    x0 += acc[ai][bj][m][0] * scale; x1 += acc[ai][bj][m][1] * scale;
                    *(f32x4*)xp = x0; *(f32x4*)(xp + 4) = x1;
                    u32x4 w = {pk2(x0[0], x0[1]), pk2(x0[2], x0[3]), pk2(x1[0], x1[1]), pk2(x1[2], x1[3])};
                    *(u32x4*)(XB + (size_t)row * DM + col0 + bj * 128) = w;
#pragma unroll
                    for (int j = 0; j < 4; ++j) ss += x0[j] * x0[j] + x1[j] * x1[j];
                }
                ss += __shfl_xor(ss, 16); ss += __shfl_xor(ss, 32);
                if (fq == 0) rssn[(size_t)row * 16 + u.pn * 4 + wc] = ss;
            }
    }
};
struct EpiMixIn {
    bf16_t* PAB; bf16_t* PC; float* BG; const float* rss;
    DI void operator()(const AccT& acc, const Unit& u, int wr, int wc, int fr, int fq) const {
        const int row0 = u.pm * 256 + wr * 64 + fr;
        bf16_t* base; int ld, ct;
        if (u.pn < 7) { base = PAB; ld = LDAB; ct = u.pn * 256; } else { base = PC; ld = LDC; ct = (u.pn - 7) * 256; }
        const int col0 = ct + wc * 32 + 8 * fq;
        const bool isbg = (u.pn == 11) && (wc == 0) && (fq < 3);
#pragma unroll
        for (int ai = 0; ai < 2; ++ai)
#pragma unroll
            for (int m = 0; m < 4; ++m) {
                const int row = row0 + ai * 128 + m * 16;
                const float rstd = row_rstd(rss, row);
#pragma unroll
                for (int bj = 0; bj < 2; ++bj) {
                    const f32x4 v0 = acc[ai][bj][m][0] * rstd, v1 = acc[ai][bj][m][1] * rstd;
                    u32x4 w = {pk2(v0[0], v0[1]), pk2(v0[2], v0[3]), pk2(v1[0], v1[1]), pk2(v1[2], v1[3])};
                    *(u32x4*)(base + (size_t)row * ld + col0 + bj * 128) = w;
                    if (bj == 1 && isbg) { float* bp = BG + (size_t)row * 24 + 8 * fq; *(f32x4*)bp = v0; *(f32x4*)(bp + 4) = v1; }
                }
            }
    }
};

DI int map_src(int kind, int n) {
    if (kind == 0) return n;
    if (kind == 1) { const int pn = n >> 8, bj = (n >> 7) & 1, i = n & 127; const int hid = pn * 128 + i; return hid < DFF ? hid + bj * DFF : -1; }
    if (n < 1408) return n;
    if (n < 1792) return 2560 + (n - 1408);
    if (n < 2944) return 1408 + (n - 1792);
    if (n < 2968) return n;
    return -1;
}
DI void conv_w(const float* __restrict__ W, int ldw, int Kreal, bf16_t* __restrict__ Bt, int Np, int Kp, const float* __restrict__ gain, int kind, float* tile, int tid) {
    const int tnn = Np >> 8, ntile = tnn * (Kp >> 6);
    for (int t = blockIdx.x; t < ntile; t += gridDim.x) {
        const int n0 = (t % tnn) << 8, k0 = (t / tnn) << 6;
        {
            const int tn = tid & 255, tk = tid >> 8; const int src = map_src(kind, n0 + tn);
            float v[32];
#pragma unroll
            for (int r = 0; r < 32; ++r) { const int k = k0 + tk + 2 * r; v[r] = 0.f;
                if (src >= 0 && k < Kreal) { v[r] = W[(size_t)k * ldw + src]; if (gain) v[r] *= gain[k]; } }
#pragma unroll
            for (int r = 0; r < 32; ++r) tile[(tk + 2 * r) * 257 + tn] = v[r];
        }
        __syncthreads();
#pragma unroll
        for (int i = 0; i < 4; ++i) {
            const int id = tid + i * 512; const int rn = id >> 3, kk = (id & 7) * 8; float a[8];
#pragma unroll
            for (int j = 0; j < 8; ++j) a[j] = tile[(kk + j) * 257 + rn];
            u32x4 w = {pk2(a[0], a[1]), pk2(a[2], a[3]), pk2(a[4], a[5]), pk2(a[6], a[7])};
            *(u32x4*)(Bt + (size_t)(n0 + rn) * Kp + k0 + kk) = w;
        }
        __syncthreads();
    }
}
DI void phase_convw(const Params& p, int l, unsigned char* shm, int tid) {
    float* tile = (float*)shm; unsigned char* ws = p.ws;
    conv_w(p.in[2] + (size_t)l * DM * 2 * DFF, 2 * DFF, DM, (bf16_t*)(ws + OFF_W_FFN1IN), NFF, DM, p.in[1] + l * DM, 1, tile, tid);
    conv_w(p.in[3] + (size_t)l * DFF * DM, DM, DFF, (bf16_t*)(ws + OFF_W_FFN1OUT), DM, DFFP, nullptr, 0, tile, tid);
    conv_w(p.in[5] + (size_t)l * DM * 2968, 2968, DM, (bf16_t*)(ws + OFF_W_MIXIN), NMIX, DM, p.in[4] + l * DM, 2, tile, tid);
    conv_w(p.in[13] + (size_t)l * DM * DM, DM, DM, (bf16_t*)(ws + OFF_W_MIXOUT), DM, DM, nullptr, 0, tile, tid);
    conv_w(p.in[15] + (size_t)l * DM * 2 * DFF, 2 * DFF, DM, (bf16_t*)(ws + OFF_W_FFN2IN), NFF, DM, p.in[14] + l * DM, 1, tile, tid);
    conv_w(p.in[16] + (size_t)l * DFF * DM, DM, DFF, (bf16_t*)(ws + OFF_W_FFN2OUT), DM, DFFP, nullptr, 0, tile, tid);
}

DI void phase_init(const Params& p, int gw, int nw, int lane) {
    const float* x = p.in[0]; float* X = p.out; bf16_t* XB = (bf16_t*)(p.ws + OFF_XB); float* rss = (float*)(p.ws + OFF_RSS);
    for (int row0 = gw * 4; row0 < MTOK; row0 += nw * 4) {
        f32x4 v[4][4];
#pragma unroll
        for (int r = 0; r < 4; ++r)
#pragma unroll
            for (int i = 0; i < 4; ++i) v[r][i] = *(const f32x4*)(x + (size_t)(row0 + r) * DM + i * 256 + lane * 4);
#pragma unroll
        for (int r = 0; r < 4; ++r) {
            float ss = 0.f;
#pragma unroll
            for (int i = 0; i < 4; ++i) {
                const size_t o = (size_t)(row0 + r) * DM + i * 256 + lane * 4;
                u32x2 w = {pk2(v[r][i][0], v[r][i][1]), pk2(v[r][i][2], v[r][i][3])}; *(u32x2*)(XB + o) = w;
                ss += v[r][i][0] * v[r][i][0] + v[r][i][1] * v[r][i][1] + v[r][i][2] * v[r][i][2] + v[r][i][3] * v[r][i][3];
            }
            ss = wave_sum(ss); if (lane < 16) rss[(size_t)(row0 + r) * 16 + lane] = lane == 0 ? ss : 0.f;
        }
    }
    if (gw == 0) { unsigned* misc = (unsigned*)(p.ws + OFF_MISC); misc[lane] = 0u; misc[64 + lane] = 0u; }
}
DI void phase_final(const Params& p, int gw, int nw, int lane) {
    float* X = p.out; const float* rss = (const float*)(p.ws + OFF_RSS); const float* g = p.in[17];
    for (int row0 = gw * 4; row0 < MTOK; row0 += nw * 4) {
        f32x4 v[4][4]; float rstd[4];
#pragma unroll
        for (int r = 0; r < 4; ++r) {
            rstd[r] = row_rstd(rss, row0 + r);
#pragma unroll
            for (int i = 0; i < 4; ++i) v[r][i] = *(const f32x4*)(X + (size_t)(row0 + r) * DM + i * 256 + lane * 4);
        }
#pragma unroll
        for (int r = 0; r < 4; ++r)
#pragma unroll
            for (int i = 0; i < 4; ++i) {
                const int c = i * 256 + lane * 4; const f32x4 gv = *(const f32x4*)(g + c);
                *(f32x4*)(X + (size_t)(row0 + r) * DM + c) = v[r][i] * rstd[r] * gv;
            }
    }
}

DI void store_row64(bf16_t* dst, const float (&val)[64]) {
#pragma unroll
    for (int i = 0; i < 8; ++i) { u32x4 w = {pk2(val[8 * i], val[8 * i + 1]), pk2(val[8 * i + 2], val[8 * i + 3]), pk2(val[8 * i + 4], val[8 * i + 5]), pk2(val[8 * i + 6], val[8 * i + 7])};
        *(u32x4*)(dst + 8 * i) = w; }
}
DI void phase_prep(const Params& p, int l, int gw, int nw, int lane0) {
    unsigned char* ws = p.ws;
    const bf16_t* PAB = (const bf16_t*)(ws + OFF_PAB); const bf16_t* PC = (const bf16_t*)(ws + OFF_PC);
    bf16_t* QC = (bf16_t*)(ws + OFF_QC); bf16_t* KC = (bf16_t*)(ws + OFF_KC); bf16_t* KTC = (bf16_t*)(ws + OFF_KTC); bf16_t* VTC = (bf16_t*)(ws + OFF_VTC);
    bf16_t* VT = (bf16_t*)(ws + OFF_VT);
    const float* cw = p.in[6] + (size_t)l * 5 * 1152;
    for (int u = gw; u < 512 * 25; u += nw) {
        int lane = lane0; asm volatile("" : "+v"(lane));
        const int grp = u % 25, ck = u / 25, b = ck >> 7, chunk = ck & 127;
        if (grp == 24) {
            const bf16_t* kr = PAB + ((size_t)b * SEQ + chunk * 64 + lane) * LDAB + 896;
            unsigned* kmx = (unsigned*)(ws + OFF_MISC) + l * 32 + b * 8;
#pragma unroll
            for (int hm = 0; hm < 8; ++hm) {
                float ss = 0.f;
#pragma unroll
                for (int c4 = 0; c4 < 4; ++c4) { const u32x4 v = *(const u32x4*)(kr + hm * 32 + c4 * 8);
#pragma unroll
                    for (int e = 0; e < 4; ++e) { const float a = bflo(v[e]), bb = bfhi(v[e]); ss += a * a + bb * bb; } }
#pragma unroll
                for (int o = 32; o > 0; o >>= 1) ss = fmaxf(ss, __shfl_xor(ss, o));
                if (lane == 0) atomicMax(kmx + hm, __float_as_uint(ss));
            }
            continue;
        }
        float val[64];
        if (grp < 18) {
            const int type = grp / 6, h = grp % 6, col = type * 384 + h * 64 + lane;
            const float w0 = cw[col], w1 = cw[1152 + col], w2 = cw[2 * 1152 + col], w3 = cw[3 * 1152 + col], w4 = cw[4 * 1152 + col];
            float xv[68];
#pragma unroll
            for (int i = 0; i < 68; ++i) { const int pos = chunk * 64 - 2 + i;
                xv[i] = (pos >= 0 && pos < SEQ) ? bf2f(PC[((size_t)b * SEQ + pos) * LDC + col]) : 0.f; }
#pragma unroll
            for (int t = 0; t < 64; ++t) { const float v = w0 * xv[t] + w1 * xv[t + 1] + w2 * xv[t + 2] + w3 * xv[t + 3] + w4 * xv[t + 4]; val[t] = silu(v); }
            if (type < 2) {
                const float sc = type == 0 ? 0.125f : 1.f;
#pragma unroll
                for (int t = 0; t < 64; ++t) { const float ss = wave_sum(val[t] * val[t]); val[t] *= __builtin_amdgcn_rsqf(ss + EPS) * sc; }
            }
            const size_t tb = ((size_t)(b * 6 + h) * 128 + chunk) * 4096;
            if (type == 0) {
#pragma unroll
                for (int t = 0; t < 64; ++t) QC[tb + t * 64 + lane] = f2bf(val[t]);
            } else if (type == 1) {
#pragma unroll
                for (int t = 0; t < 64; ++t) KC[tb + t * 64 + lane] = f2bf(val[t]);
                store_row64(KTC + tb + lane * 64, val);
            } else {
                store_row64(VTC + tb + lane * 64, val);
            }
        } else {
            const int vh = grp - 18; const int col = (vh < 2 ? 512 + vh * 64 : 1152 + (vh - 2) * 64) + lane;
            const size_t tok0 = (size_t)b * SEQ + chunk * 64;
#pragma unroll
            for (int t = 0; t < 64; ++t) val[t] = bf2f(PAB[(tok0 + t) * LDAB + col]);
            store_row64(VT + ((size_t)(b * 6 + vh) * 64 + lane) * SEQ + chunk * 64, val);
        }
    }
}

DI void phase_chunk(const Params& p, int l, int gw, int nw, int lane0, int wid, unsigned char* shm) {
    unsigned char* ws = p.ws;
    float* Mf = (float*)(shm + wid * 16384); bf16_t* AB = (bf16_t*)Mf; bf16_t* ABG = AB + 4096;
    const bf16_t* QC = (const bf16_t*)(ws + OFF_QC); const bf16_t* KC = (const bf16_t*)(ws + OFF_KC);
    const bf16_t* KTC = (const bf16_t*)(ws + OFF_KTC); const bf16_t* VTC = (const bf16_t*)(ws + OFF_VTC);
    const float* BG = (const float*)(ws + OFF_BG);
    bf16_t* U = (bf16_t*)(ws + OFF_U); bf16_t* WB = (bf16_t*)(ws + OFF_WB); bf16_t* QK = (bf16_t*)(ws + OFF_QK); float* GC = (float*)(ws + OFF_GC);
    for (int it = gw; it < 6144; it += nw) {
        int lane = lane0; asm volatile("" : "+v"(lane));
        const int fr = lane & 15, q = lane >> 4;
        const int chunk = it & 127, seq = it >> 7, dir = seq & 1, bh = seq >> 1, b = bh / 6, h = bh % 6;
        const int pch = dir ? 127 - chunk : chunk;
        const size_t tb = ((size_t)bh * 128 + pch) * 4096;
        const int tkl = dir ? 63 - lane : lane;
        const size_t tok = (size_t)b * SEQ + pch * 64 + tkl;
        const float braw = BG[tok * 24 + dir * 6 + h], araw = BG[tok * 24 + 12 + dir * 6 + h];
        const float beta = 1.f / (1.f + expf(-braw));
        const float Aa = expf(p.in[10][l * 12 + dir * 6 + h]); const float xx = araw + p.in[11][l * 12 + dir * 6 + h];
        const float sp = fmaxf(xx, 0.f) + log1pf(expf(-fabsf(xx)));
        const float g = -Aa * sp;
        float gc = g;
#pragma unroll
        for (int o = 1; o < 64; o <<= 1) { const float t = __shfl_up(gc, o); if (lane >= o) gc += t; }
        GC[(size_t)it * 64 + lane] = gc;
        bf16x8 kf[4][2], qf[4][2];
#pragma unroll
        for (int m = 0; m < 4; ++m)
#pragma unroll
            for (int s = 0; s < 2; ++s) { const int row = 16 * m + fr; const int tr = dir ? 63 - row : row;
                kf[m][s] = *(const bf16x8*)(KC + tb + tr * 64 + 32 * s + 8 * q); qf[m][s] = *(const bf16x8*)(QC + tb + tr * 64 + 32 * s + 8 * q); }
#pragma unroll
        for (int m = 0; m < 4; ++m)
#pragma unroll
            for (int n = 0; n <= m; ++n) {
                f32x4 acc = {0.f, 0.f, 0.f, 0.f};
                acc = MFMA16(kf[m][0], kf[n][0], acc); acc = MFMA16(kf[m][1], kf[n][1], acc);
                const int s_ = 16 * n + fr; const float gcs = __shfl(gc, s_);
#pragma unroll
                for (int r = 0; r < 4; ++r) { const int c = 16 * m + 4 * q + r; const float gcc = __shfl(gc, c), bc = __shfl(beta, c);
                    Mf[c * 64 + s_] = (s_ < c) ? bc * acc[r] * fexp(gcc - gcs) : 0.f; }
                __builtin_amdgcn_sched_barrier(0);
            }
#pragma unroll
        for (int n = 0; n < 4; ++n)
#pragma unroll
            for (int m = 0; m < 4; ++m) {
                f32x4 v = {0.f, 0.f, 0.f, 0.f};
                const int c = 16 * n + fr;
                if (m <= n) {
                    f32x4 acc = {0.f, 0.f, 0.f, 0.f};
                    acc = MFMA16(kf[m][0], qf[n][0], acc); acc = MFMA16(kf[m][1], qf[n][1], acc);
                    const float gcc = __shfl(gc, c);
#pragma unroll
                    for (int r = 0; r < 4; ++r) { const int s_ = 16 * m + 4 * q + r; const float gcs = __shfl(gc, s_); v[r] = (s_ <= c) ? acc[r] * fexp(gcc - gcs) : 0.f; }
                }
                u32x2 w = {pk2(v[0], v[1]), pk2(v[2], v[3])};
                *(u32x2*)(QK + (size_t)it * 4096 + c * 64 + 16 * m + 4 * q) = w;
                __builtin_amdgcn_sched_barrier(0);
            }
        __builtin_amdgcn_sched_barrier(0);
        bf16x8 vfr[4][2], ktf[4][2];
#pragma unroll
        for (int n = 0; n < 4; ++n) {
            const bf16_t* vp = VTC + tb + (16 * n + fr) * 64 + 8 * q; vfr[n][0] = *(const bf16x8*)vp; vfr[n][1] = *(const bf16x8*)(vp + 32);
            const bf16_t* kp = KTC + tb + (16 * n + fr) * 64 + 8 * q; ktf[n][0] = *(const bf16x8*)kp; ktf[n][1] = *(const bf16x8*)(kp + 32);
        }
        float x[64];
#pragma unroll
        for (int i = 0; i < 64; ++i) {
            float a = (i == lane) ? 1.f : 0.f;
#pragma unroll
            for (int m = 0; m < i; ++m) a -= Mf[i * 64 + m] * x[m];
            x[i] = a;
            __builtin_amdgcn_sched_barrier(0);
        }
        {
            const float bj = beta, bgj = beta * fexp(gc);
#pragma unroll
            for (int i = 0; i < 64; ++i) { AB[i * 64 + tkl] = f2bf(x[i] * bj); ABG[i * 64 + tkl] = f2bf(x[i] * bgj); }
        }
        __builtin_amdgcn_sched_barrier(0);
#pragma unroll
        for (int m = 0; m < 4; ++m) {
            const bf16x8 a0 = *(const bf16x8*)(AB + (16 * m + fr) * 64 + 8 * q), a1 = *(const bf16x8*)(AB + (16 * m + fr) * 64 + 32 + 8 * q);
#pragma unroll
            for (int n = 0; n < 4; ++n) {
                const bf16x8 b0 = vfr[n][0], b1 = vfr[n][1];
                f32x4 acc = {0.f, 0.f, 0.f, 0.f};
                acc = MFMA16(a0, b0, acc); acc = MFMA16(a1, b1, acc);
                u32x2 w = {pk2(acc[0], acc[1]), pk2(acc[2], acc[3])};
                *(u32x2*)(U + (size_t)it * 4096 + (16 * n + fr) * 64 + 16 * m + 4 * q) = w;
            }
        }
        __builtin_amdgcn_sched_barrier(0);
#pragma unroll
        for (int n = 0; n < 4; ++n) {
            const bf16x8 b0 = *(const bf16x8*)(ABG + (16 * n + fr) * 64 + 8 * q), b1 = *(const bf16x8*)(ABG + (16 * n + fr) * 64 + 32 + 8 * q);
#pragma unroll
            for (int m = 0; m < 4; ++m) {
                const bf16x8 a0 = ktf[m][0], a1 = ktf[m][1];
                f32x4 acc = {0.f, 0.f, 0.f, 0.f};
                acc = MFMA16(a0, b0, acc); acc = MFMA16(a1, b1, acc);
                u32x2 w = {pk2(acc[0], acc[1]), pk2(acc[2], acc[3])};
                *(u32x2*)(WB + (size_t)it * 4096 + (16 * n + fr) * 64 + 16 * m + 4 * q) = w;
            }
        }
    }
}

constexpr int SCAN_SLOT = 25600;
DI void scan_issue(LAS unsigned char* slot, const bf16_t* WB, const bf16_t* U, const bf16_t* KTC, const float* GC, int seq, int bh, int dir, int lw, int i, int lane) {
    const int it = seq * 128 + i; const int pch = dir ? 127 - i : i;
    const bf16_t* Wp = WB + (size_t)it * 4096; const bf16_t* Kp = KTC + ((size_t)bh * 128 + pch) * 4096;
    const bf16_t* Up = U + (size_t)it * 4096 + (16 * lw) * 64; const float* gcp = GC + (size_t)it * 64;
    const int r8 = lane >> 3, c8 = lane & 7;
#pragma unroll
    for (int jj = 0; jj < 2; ++jj) {
        const int j = 2 * lw + jj;
        const int row = 8 * j + r8; const int cid = c8 ^ (row & 7);
        __builtin_amdgcn_global_load_lds((const unsigned*)(Wp + row * 64 + cid * 8), (LAS unsigned*)(slot + j * 1024), 16, 0, 0);
        __builtin_amdgcn_global_load_lds((const unsigned*)(Kp + row * 64 + cid * 8), (LAS unsigned*)(slot + 8192 + j * 1024), 16, 0, 0);
    }
#pragma unroll
    for (int j = 0; j < 2; ++j) {
        const int row = 8 * j + r8; const int cid = c8 ^ (row & 7);
        __builtin_amdgcn_global_load_lds((const unsigned*)(Up + row * 64 + cid * 8), (LAS unsigned*)(slot + 16384 + lw * 2048 + j * 1024), 16, 0, 0);
    }
    __builtin_amdgcn_global_load_lds((const unsigned*)(gcp + (lane & 15) * 4), (LAS unsigned*)(slot + 24576), 16, 0, 0);
}
DI u32x2 lds_piece(const LAS unsigned char* tile, int row, int e) {
    return *(const LAS u32x2*)(tile + row * 128 + ((((e >> 3) ^ (row & 7))) << 4) + ((e & 4) << 1));
}
DI bf16x8 mk8(u32x2 x, u32x2 y) { u32x4 r = {x.x, x.y, y.x, y.y}; return __builtin_bit_cast(bf16x8, r); }
DI bf16x8 mk8rev(u32x2 x, u32x2 y) { u32x4 r = {rot16(x.y), rot16(x.x), rot16(y.y), rot16(y.x)}; return __builtin_bit_cast(bf16x8, r); }
DI void scan_step(const LAS unsigned char* slot, int vs, int dir, int fr, int q, f32x4 (&S)[4], bf16_t* sst) {
    bf16x8 Sb[2];
    Sb[0] = pack8(S[0], S[1]); Sb[1] = pack8(S[2], S[3]);
    {
        const u32x4 s0 = __builtin_bit_cast(u32x4, Sb[0]), s1 = __builtin_bit_cast(u32x4, Sb[1]);
        *(u32x2*)(sst + 0) = (u32x2){s0.x, s0.y}; *(u32x2*)(sst + 16) = (u32x2){s0.z, s0.w};
        *(u32x2*)(sst + 32) = (u32x2){s1.x, s1.y}; *(u32x2*)(sst + 48) = (u32x2){s1.z, s1.w};
    }
    const LAS unsigned char* ut = slot + 16384 + vs * 2048;
    const LAS float* gcl_p = (const LAS float*)(slot + 24576);
    const float gcl = gcl_p[63]; const float gl = fexp(gcl);
    f32x4 vg[4];
#pragma unroll
    for (int m = 0; m < 4; ++m) {
        const int c = 16 * m + fr;
        const bf16x8 w0 = mk8(lds_piece(slot, c, 4 * q), lds_piece(slot, c, 16 + 4 * q)), w1 = mk8(lds_piece(slot, c, 32 + 4 * q), lds_piece(slot, c, 48 + 4 * q));
        f32x4 acc = {0.f, 0.f, 0.f, 0.f};
        acc = MFMA16(w0, Sb[0], acc); acc = MFMA16(w1, Sb[1], acc);
        const u32x2 uu = lds_piece(ut, fr, 16 * m + 4 * q);
        const f32x4 gcv = *(const LAS f32x4*)(slot + 24576 + (16 * m + 4 * q) * 4);
        vg[m][0] = (bflo(uu.x) - acc[0]) * fexp(gcl - gcv[0]); vg[m][1] = (bfhi(uu.x) - acc[1]) * fexp(gcl - gcv[1]);
        vg[m][2] = (bflo(uu.y) - acc[2]) * fexp(gcl - gcv[2]); vg[m][3] = (bfhi(uu.y) - acc[3]) * fexp(gcl - gcv[3]);
    }
    bf16x8 Vg[2];
    Vg[0] = pack8(vg[0], vg[1]); Vg[1] = pack8(vg[2], vg[3]);
#pragma unroll
    for (int kt = 0; kt < 4; ++kt) {
        const int k = 16 * kt + fr;
        bf16x8 k0, k1;
        if (dir == 0) { k0 = mk8(lds_piece(slot + 8192, k, 4 * q), lds_piece(slot + 8192, k, 16 + 4 * q)); k1 = mk8(lds_piece(slot + 8192, k, 32 + 4 * q), lds_piece(slot + 8192, k, 48 + 4 * q)); }
        else { k0 = mk8rev(lds_piece(slot + 8192, k, 60 - 4 * q), lds_piece(slot + 8192, k, 44 - 4 * q)); k1 = mk8rev(lds_piece(slot + 8192, k, 28 - 4 * q), lds_piece(slot + 8192, k, 12 - 4 * q)); }
        f32x4 acc = S[kt] * gl;
        acc = MFMA16(k0, Vg[0], acc); acc = MFMA16(k1, Vg[1], acc);
        S[kt] = acc;
    }
}
DI void phase_scan(const Params& p, int lane, int wid, unsigned char* shm) {
    unsigned char* ws = p.ws;
    const bf16_t* KTC = (const bf16_t*)(ws + OFF_KTC);
    const bf16_t* U = (const bf16_t*)(ws + OFF_U); const bf16_t* WB = (const bf16_t*)(ws + OFF_WB);
    const float* GC = (const float*)(ws + OFF_GC); bf16_t* SST = (bf16_t*)(ws + OFF_SST);
    const int seq = blockIdx.x, dir = seq & 1, bh = seq >> 1;
    const int fr = lane & 15, q = lane >> 4;
    LAS unsigned char* ring = (LAS unsigned char*)shm;
    if (wid >= 4) {
        const int lw = wid - 4;
        scan_issue(ring, WB, U, KTC, GC, seq, bh, dir, lw, 0, lane);
        scan_issue(ring + SCAN_SLOT, WB, U, KTC, GC, seq, bh, dir, lw, 1, lane);
        scan_issue(ring + 2 * SCAN_SLOT, WB, U, KTC, GC, seq, bh, dir, lw, 2, lane);
        int slot_n = 3;
        for (int i = 0; i < 128; ++i) {
            scan_issue(ring + slot_n * SCAN_SLOT, WB, U, KTC, GC, seq, bh, dir, lw, i + 3 < 128 ? i + 3 : 127, lane);
            asm volatile("s_waitcnt vmcnt(21)" ::: "memory");
            __builtin_amdgcn_s_barrier();
            slot_n = slot_n == 4 ? 0 : slot_n + 1;
        }
        asm volatile("s_waitcnt vmcnt(0)" ::: "memory");
    } else {
        const int vs = wid;
        f32x4 S[4];
#pragma unroll
        for (int i = 0; i < 4; ++i) S[i] = (f32x4){0.f, 0.f, 0.f, 0.f};
        bf16_t* sst = SST + (size_t)seq * 128 * 4096 + (16 * vs + fr) * 64 + 4 * q;
        int slot_c = 0;
        for (int i = 0; i < 128; ++i) {
            __builtin_amdgcn_s_barrier();
            asm volatile("" ::: "memory");
            scan_step(ring + slot_c * SCAN_SLOT, vs, dir, fr, q, S, sst + (size_t)i * 4096);
            slot_c = slot_c == 4 ? 0 : slot_c + 1;
        }
    }
}
DI void phase_outp(const Params& p, int gw, int nw, int lane0) {
    unsigned char* ws = p.ws;
    const bf16_t* QC = (const bf16_t*)(ws + OFF_QC);
    const bf16_t* U = (const bf16_t*)(ws + OFF_U); const bf16_t* WB = (const bf16_t*)(ws + OFF_WB); const bf16_t* QK = (const bf16_t*)(ws + OFF_QK);
    const float* GC = (const float*)(ws + OFF_GC); const bf16_t* SST = (const bf16_t*)(ws + OFF_SST);
    for (int it = gw; it < 6144; it += nw) {
        int lane = lane0; asm volatile("" : "+v"(lane));
        const int fr = lane & 15, q = lane >> 4;
        const int chunk = it & 127, seq = it >> 7, dir = seq & 1, bh = seq >> 1, b = bh / 6, h = bh % 6;
        const int pch = dir ? 127 - chunk : chunk;
        const size_t tb = ((size_t)bh * 128 + pch) * 4096;
        const bf16_t* Wp = WB + (size_t)it * 4096; const bf16_t* Up = U + (size_t)it * 4096; const bf16_t* QKp = QK + (size_t)it * 4096;
        const bf16_t* Sp = SST + (size_t)it * 4096; const float* gcp = GC + (size_t)it * 64;
        bf16_t* OT = (bf16_t*)(ws + OFF_WB) + (size_t)it * 4096;
        bf16x8 wf[4][2], qf[4][2], kf[4][2]; f32x4 eg[4];
#pragma unroll
        for (int m = 0; m < 4; ++m) {
            const int c = 16 * m + fr; const int tr = dir ? 63 - c : c;
            wf[m][0] = *(const bf16x8*)(Wp + c * 64 + 8 * q); wf[m][1] = *(const bf16x8*)(Wp + c * 64 + 32 + 8 * q);
            qf[m][0] = *(const bf16x8*)(QC + tb + tr * 64 + 8 * q); qf[m][1] = *(const bf16x8*)(QC + tb + tr * 64 + 32 + 8 * q);
            const bf16_t* kp = QKp + c * 64 + 4 * q;
            kf[m][0] = ld2x8(kp, kp + 16); kf[m][1] = ld2x8(kp + 32, kp + 48);
            const f32x4 gcv = *(const f32x4*)(gcp + 16 * m + 4 * q);
#pragma unroll
            for (int r = 0; r < 4; ++r) eg[m][r] = fexp(gcv[r]);
        }
#pragma unroll 1
        for (int vs = 0; vs < 4; ++vs) {
            const bf16x8 Sb0 = *(const bf16x8*)(Sp + (16 * vs + fr) * 64 + 8 * q), Sb1 = *(const bf16x8*)(Sp + (16 * vs + fr) * 64 + 32 + 8 * q);
            f32x4 vn[4], o[4];
#pragma unroll
            for (int m = 0; m < 4; ++m) {
                f32x4 acc = {0.f, 0.f, 0.f, 0.f};
                acc = MFMA16(wf[m][0], Sb0, acc); acc = MFMA16(wf[m][1], Sb1, acc);
                const u32x2 uu = *(const u32x2*)(Up + (16 * vs + fr) * 64 + 16 * m + 4 * q);
                vn[m][0] = bflo(uu.x) - acc[0]; vn[m][1] = bfhi(uu.x) - acc[1]; vn[m][2] = bflo(uu.y) - acc[2]; vn[m][3] = bfhi(uu.y) - acc[3];
                f32x4 a2 = {0.f, 0.f, 0.f, 0.f};
                a2 = MFMA16(qf[m][0], Sb0, a2); a2 = MFMA16(qf[m][1], Sb1, a2);
                o[m] = a2 * eg[m];
            }
            const bf16x8 Vb0 = pack8(vn[0], vn[1]), Vb1 = pack8(vn[2], vn[3]);
#pragma unroll
            for (int m = 0; m < 4; ++m) {
                f32x4 acc = o[m];
                acc = MFMA16(kf[m][0], Vb0, acc); acc = MFMA16(kf[m][1], Vb1, acc);
#pragma unroll
                for (int r = 0; r < 4; ++r) { const int c = 16 * m + 4 * q + r; OT[c * 64 + 16 * vs + fr] = f2bf(acc[r]); }
            }
        }
    }
}

DI bf16x8 packpv(const f32x16& pv, int s) {
    u32x4 r = {pk2(pv[8 * s], pv[8 * s + 1]), pk2(pv[8 * s + 2], pv[8 * s + 3]), pk2(pv[8 * s + 4], pv[8 * s + 5]), pk2(pv[8 * s + 6], pv[8 * s + 7])};
    return __builtin_bit_cast(bf16x8, r);
}
DI bf16x8 packp(const float (&pv)[16], int s) {
    u32x4 r = {pk2(pv[8 * s], pv[8 * s + 1]), pk2(pv[8 * s + 2], pv[8 * s + 3]), pk2(pv[8 * s + 4], pv[8 * s + 5]), pk2(pv[8 * s + 6], pv[8 * s + 7])};
    return __builtin_bit_cast(bf16x8, r);
}
#define CRW(reg) ((float)(((reg) & 3) + 8 * ((reg) >> 2)))

DI void phase_win(const Params& p, int l, int gw, int nw, int lane) {
    unsigned char* ws = p.ws;
    const bf16_t* PAB = (const bf16_t*)(ws + OFF_PAB); const bf16_t* VT = (const bf16_t*)(ws + OFF_VT); bf16_t* OB = (bf16_t*)(ws + OFF_OB);
    const int r32 = lane & 31, hh = lane >> 5;
    for (int item = gw; item < 6144; item += nw) {
        const int qt = item & 255, qh = (item >> 8) % 6, b = item / 1536, kvh = qh / 3;
        const int q0 = qt * 32, qi = q0 + r32;
        const bf16_t* qrow = PAB + ((size_t)b * SEQ + qi) * LDAB + qh * 64;
        bf16x8 qf[4];
#pragma unroll
        for (int st = 0; st < 4; ++st) qf[st] = *(const bf16x8*)(qrow + 16 * st + 8 * hh);
        const float slope2 = exp2f(-8.f * (float)(qh + 1) / 6.f) * LOG2E, scale2 = 0.125f * LOG2E;
        float m = p.in[7][l * 6 + qh] * LOG2E, lsum = hh == 0 ? 1.f : 0.f;
        f32x16 O[2];
#pragma unroll
        for (int i = 0; i < 16; ++i) { O[0][i] = 0.f; O[1][i] = 0.f; }
        const int kb0 = q0 - 128 < 0 ? 0 : q0 - 128, kb1 = q0 + 160 > SEQ ? SEQ : q0 + 160;
        for (int kb = kb0; kb < kb1; kb += 32) {
            const bf16_t* krow = PAB + ((size_t)b * SEQ + kb + r32) * LDAB + 384 + kvh * 64;
            f32x16 s;
#pragma unroll
            for (int i = 0; i < 16; ++i) s[i] = 0.f;
#pragma unroll
            for (int st = 0; st < 4; ++st) { const bf16x8 kf = *(const bf16x8*)(krow + 16 * st + 8 * hh); s = MFMA32(kf, qf[st], s); }
            bf16x8 vf[2][2];
#pragma unroll
            for (int dt = 0; dt < 2; ++dt) { const bf16_t* vrow = VT + ((size_t)(b * 6 + kvh) * 64 + 32 * dt + r32) * SEQ + kb + 4 * hh;
                vf[dt][0] = ld2x8(vrow, vrow + 8); vf[dt][1] = ld2x8(vrow + 16, vrow + 24); }
            const float qoff = (float)(kb + 4 * hh - qi);
            float t[16]; float mx = m;
#pragma unroll
            for (int reg = 0; reg < 16; ++reg) { const float ad = fabsf(qoff + CRW(reg)); float tv = s[reg] * scale2 - slope2 * ad; tv = (ad <= 128.f) ? tv : -1e30f; t[reg] = tv; mx = fmaxf(mx, tv); }
            mx = fmaxf(mx, __shfl_xor(mx, 32));
            const float alpha = fexp2(m - mx); m = mx;
            float ps = 0.f;
#pragma unroll
            for (int reg = 0; reg < 16; ++reg) { t[reg] = fexp2(t[reg] - m); ps += t[reg]; }
            lsum = lsum * alpha + ps;
#pragma unroll
            for (int i = 0; i < 16; ++i) { O[0][i] *= alpha; O[1][i] *= alpha; }
            const bf16x8 pf0 = packp(t, 0), pf1 = packp(t, 1);
#pragma unroll
            for (int dt = 0; dt < 2; ++dt) { O[dt] = MFMA32(vf[dt][0], pf0, O[dt]); O[dt] = MFMA32(vf[dt][1], pf1, O[dt]); }
        }
        lsum += __shfl_xor(lsum, 32);
        const float inv = 1.f / lsum;
        bf16_t* orow = OB + ((size_t)b * SEQ + qi) * DM + qh * 64;
#pragma unroll
        for (int dt = 0; dt < 2; ++dt)
#pragma unroll
            for (int g4 = 0; g4 < 4; ++g4) {
                u32x2 w = {pk2(O[dt][4 * g4] * inv, O[dt][4 * g4 + 1] * inv), pk2(O[dt][4 * g4 + 2] * inv, O[dt][4 * g4 + 3] * inv)};
                *(u32x2*)(orow + 32 * dt + 8 * g4 + 4 * hh) = w;
            }
    }
}

DI void win_block(const Params& p, int l, int item, int tid, unsigned char* shm) {
    unsigned char* ws = p.ws;
    const bf16_t* PAB = (const bf16_t*)(ws + OFF_PAB); const bf16_t* VT = (const bf16_t*)(ws + OFF_VT); bf16_t* OB = (bf16_t*)(ws + OFF_OB);
    const int lane = tid & 63, wid = tid >> 6, r32 = lane & 31, hh = lane >> 5;
    const int qblk = item & 31, kvh = (item >> 5) & 1, b = item >> 6;
    const int Q0 = qblk * 256, K0 = Q0 - 128;
    {
        const int srow = tid >> 3, sch = tid & 7;
        const int kwoff = srow * 128 + ((sch ^ (srow & 7)) * 16);
        const int vblk = sch >> 1, vhalf = sch & 1;
        const int vwoff0 = 65536 + srow * 128 + (((2 * vblk) ^ (srow & 7)) * 16) + 8 * vhalf;
        const int vwoff1 = 65536 + srow * 128 + (((2 * vblk + 1) ^ (srow & 7)) * 16) + 8 * vhalf;
        __syncthreads();
#pragma unroll 1
        for (int g0 = 0; g0 < 8; g0 += 4) {
            u32x4 kr[4], vr[4];
#pragma unroll
            for (int gg = 0; gg < 4; ++gg) {
                const int g = g0 + gg;
                int kpos = K0 + g * 64 + srow; kpos = kpos < 0 ? 0 : (kpos > SEQ - 1 ? SEQ - 1 : kpos);
                int key0 = K0 + g * 64; key0 = key0 < 0 ? 0 : (key0 > SEQ - 64 ? SEQ - 64 : key0);
                kr[gg] = *(const u32x4*)(PAB + ((size_t)b * SEQ + kpos) * LDAB + 384 + kvh * 64 + sch * 8);
                vr[gg] = *(const u32x4*)(VT + ((size_t)(b * 6 + kvh) * 64 + srow) * SEQ + key0 + sch * 8);
            }
#pragma unroll
            for (int gg = 0; gg < 4; ++gg) {
                const int g = g0 + gg;
                *(u32x4*)(shm + g * 8192 + kwoff) = kr[gg];
                *(u32x2*)(shm + g * 8192 + vwoff0) = (u32x2){vr[gg].x, vr[gg].y}; *(u32x2*)(shm + g * 8192 + vwoff1) = (u32x2){vr[gg].z, vr[gg].w};
            }
        }
        __syncthreads();
    }
    const int q0 = Q0 + wid * 32, qi = q0 + r32;
    const int kb0 = q0 - 128 < 0 ? 0 : q0 - 128, kb1 = q0 + 160 > SEQ ? SEQ : q0 + 160;
#pragma unroll 1
    for (int g3 = 0; g3 < 3; ++g3) {
        const int qh = kvh * 3 + g3;
        const bf16_t* qrow = PAB + ((size_t)b * SEQ + qi) * LDAB + qh * 64;
        bf16x8 qf[4];
#pragma unroll
        for (int st = 0; st < 4; ++st) qf[st] = *(const bf16x8*)(qrow + 16 * st + 8 * hh);
        const float slope2 = exp2f(-8.f * (float)(qh + 1) / 6.f) * LOG2E, scale2 = 0.125f * LOG2E;
        float m = p.in[7][l * 6 + qh] * LOG2E, lsum = hh == 0 ? 1.f : 0.f;
        f32x16 O[2];
#pragma unroll
        for (int i = 0; i < 16; ++i) { O[0][i] = 0.f; O[1][i] = 0.f; }
        for (int kb = kb0; kb < kb1; kb += 32) {
            const int kl = kb - K0, g = kl >> 6, j = (kl >> 5) & 1;
            const unsigned char* Ks = shm + g * 8192; const unsigned char* Vs = shm + 65536 + g * 8192;
            f32x16 s;
#pragma unroll
            for (int i = 0; i < 16; ++i) s[i] = 0.f;
#pragma unroll
            for (int st = 0; st < 4; ++st) { const bf16x8 kf = *(const bf16x8*)(Ks + (32 * j + r32) * 128 + (((2 * st + hh) ^ (r32 & 7)) * 16)); s = MFMA32(kf, qf[st], s); }
            bf16x8 vf[2][2];
#pragma unroll
            for (int dt = 0; dt < 2; ++dt)
#pragma unroll
                for (int s_ = 0; s_ < 2; ++s_) vf[dt][s_] = *(const bf16x8*)(Vs + (32 * dt + r32) * 128 + (((4 * j + 2 * s_ + hh) ^ (r32 & 7)) * 16));
            float qoff = (float)(kb + 4 * hh - qi); asm volatile("" : "+v"(qoff));
            float t[16]; float mx = m;
#pragma unroll
            for (int reg = 0; reg < 16; ++reg) { const float ad = fabsf(qoff + CRW(reg)); float tv = s[reg] * scale2 - slope2 * ad; tv = (ad <= 128.f) ? tv : -1e30f; t[reg] = tv; mx = fmaxf(mx, tv); }
            mx = fmaxf(mx, __shfl_xor(mx, 32));
            const float alpha = fexp2(m - mx); m = mx;
            float ps = 0.f;
#pragma unroll
            for (int reg = 0; reg < 16; ++reg) { t[reg] = fexp2(t[reg] - m); ps += t[reg]; }
            lsum = lsum * alpha + ps;
#pragma unroll
            for (int i = 0; i < 16; ++i) { O[0][i] *= alpha; O[1][i] *= alpha; }
            const bf16x8 pf0 = packp(t, 0), pf1 = packp(t, 1);
#pragma unroll
            for (int dt = 0; dt < 2; ++dt) { O[dt] = MFMA32(vf[dt][0], pf0, O[dt]); O[dt] = MFMA32(vf[dt][1], pf1, O[dt]); }
        }
        lsum += __shfl_xor(lsum, 32);
        const float inv = 1.f / lsum;
        bf16_t* orow = OB + ((size_t)b * SEQ + qi) * DM + qh * 64;
#pragma unroll
        for (int dt = 0; dt < 2; ++dt)
#pragma unroll
            for (int g4 = 0; g4 < 4; ++g4) {
                u32x2 w = {pk2(O[dt][4 * g4] * inv, O[dt][4 * g4 + 1] * inv), pk2(O[dt][4 * g4 + 2] * inv, O[dt][4 * g4 + 3] * inv)};
                *(u32x2*)(orow + 32 * dt + 8 * g4 + 4 * hh) = w;
            }
    }
}

DI bf16x8 scale_frag(bf16x8 v, float sc) {
    u32x4 u = __builtin_bit_cast(u32x4, v), r;
#pragma unroll
    for (int i = 0; i < 4; ++i) r[i] = pk2(bflo(u[i]) * sc, bfhi(u[i]) * sc);
    return __builtin_bit_cast(bf16x8, r);
}
DI void phase_diff(const Params& p, int l, int tid0, unsigned char* shm) {
    unsigned char* ws = p.ws;
    const bf16_t* PAB = (const bf16_t*)(ws + OFF_PAB); const bf16_t* VT = (const bf16_t*)(ws + OFF_VT); bf16_t* OB = (bf16_t*)(ws + OFF_OB);
    const float lam_init = l == 0 ? 0.2f : (0.8f - 0.6f * 0.7408182206817179f);
    float lam;
    {
        const int lane = tid0 & 63;
        const float* dl = p.in[8] + l * 128;
        float a = 0.f, c = 0.f;
        if (lane < 32) { a = dl[lane] * dl[32 + lane]; c = dl[64 + lane] * dl[96 + lane]; }
        a = wave_sum(a); c = wave_sum(c);
        lam = expf(a) - expf(c) + lam_init;
    }
    const float* dg = p.in[9] + l * 64;
    unsigned* qctr = (unsigned*)(ws + OFF_MISC) + 64 + l;
    const unsigned* kmx = (const unsigned*)(ws + OFF_MISC) + l * 32;
    __shared__ unsigned sq_words[32];
    volatile LAS unsigned* sq = (volatile LAS unsigned*)&sq_words[0];
    int first_win = 768;
    for (;;) {
        int tid = tid0; asm volatile("" : "+v"(tid));
        __syncthreads();
        if (tid == 0) sq[0] = atomicAdd(qctr, 1u);
        __syncthreads();
        const int idx_item = (int)sq[0];
        if (idx_item >= 512) { first_win = idx_item; break; }
        const int lane = tid & 63, wid = tid >> 6, r32 = lane & 31, hh = lane >> 5;
        const int qb = idx_item & 31, b = (idx_item >> 5) & 3, h = 3 - (idx_item >> 7);
        const int q0 = qb * 256 + wid * 32, qi = q0 + r32;
        const bf16_t* qrow = PAB + ((size_t)b * SEQ + qi) * LDAB + 640 + h * 64;
        const float scale2 = 0.17677669529663687f * LOG2E;
        bf16x8 qf[2][2];
#pragma unroll
        for (int mp = 0; mp < 2; ++mp)
#pragma unroll
            for (int st = 0; st < 2; ++st) qf[mp][st] = scale_frag(*(const bf16x8*)(qrow + mp * 32 + 16 * st + 8 * hh), scale2);
        const float slope2 = exp2f(-2.f * (float)(h + 1)) * LOG2E;
        float mA = -1e30f, mB = -1e30f, lA = 0.f, lB = 0.f;
        f32x16 OA[2], OBb[2];
#pragma unroll
        for (int i = 0; i < 16; ++i) { OA[0][i] = 0.f; OA[1][i] = 0.f; OBb[0][i] = 0.f; OBb[1][i] = 0.f; }
        const int srow = tid >> 3, sch = tid & 7;
        const bf16_t* kg = PAB + ((size_t)b * SEQ + srow) * LDAB + 896 + h * 64 + sch * 8;
        const bf16_t* vg = VT + ((size_t)(b * 6 + 2 + h) * 64 + srow) * SEQ + sch * 8;
        const int kwoff = srow * 128 + ((sch ^ (srow & 7)) * 16);
        const int vblk = sch >> 1, vhalf = sch & 1;
        const int vwoff0 = 32768 + srow * 128 + (((2 * vblk) ^ (srow & 7)) * 16) + 8 * vhalf;
        const int vwoff1 = 32768 + srow * 128 + (((2 * vblk + 1) ^ (srow & 7)) * 16) + 8 * vhalf;
        int lo, hi;
        {
            float qa = 0.f, qbm = 0.f;
#pragma unroll
            for (int st = 0; st < 2; ++st) { const u32x4 va = __builtin_bit_cast(u32x4, qf[0][st]), vb = __builtin_bit_cast(u32x4, qf[1][st]);
#pragma unroll
                for (int e = 0; e < 4; ++e) { qa += bflo(va[e]) * bflo(va[e]) + bfhi(va[e]) * bfhi(va[e]); qbm += bflo(vb[e]) * bflo(vb[e]) + bfhi(vb[e]) * bfhi(vb[e]); } }
            qa += __shfl_xor(qa, 32); qbm += __shfl_xor(qbm, 32);
            const float qaL = qa, qbL = qbm;
#pragma unroll
            for (int o = 16; o > 0; o >>= 1) { qa = fmaxf(qa, __shfl_xor(qa, o)); qbm = fmaxf(qbm, __shfl_xor(qbm, o)); }
            if (lane == 0) { sq[8 + 2 * wid] = __float_as_uint(qa); sq[9 + 2 * wid] = __float_as_uint(qbm); }
            __syncthreads();
            float qA = 0.f, qB = 0.f;
#pragma unroll
            for (int w8 = 0; w8 < 8; ++w8) { qA = fmaxf(qA, __uint_as_float(sq[8 + 2 * w8])); qB = fmaxf(qB, __uint_as_float(sq[9 + 2 * w8])); }
            const float kA = __uint_as_float(kmx[b * 8 + h * 2]), kB = __uint_as_float(kmx[b * 8 + h * 2 + 1]);
            mA = -sqrtf(qaL * kA) - 1.f; mB = -sqrtf(qbL * kB) - 1.f;
            const float bnd = 2.02f * fmaxf(sqrtf(qA * kA), sqrtf(qB * kB)) + 1.f;
            const float dsk = (168.f + bnd) / slope2;
            const int Dsk = dsk > 16384.f ? 16384 : (int)dsk + 1;
            const int Q0 = qb * 256;
            const int x = Q0 - 63 - Dsk; lo = x <= 0 ? 0 : (x + 63) >> 6;
            const int y = (Q0 + 255 + Dsk) >> 6; hi = y > 127 ? 127 : y;
        }
        lo >>= 1; hi >>= 1;
        const int d0 = qb * 2, nright = hi - d0 + 1, nstage = hi - lo + 1;
        u32x4 kreg[2], vreg[2];
#pragma unroll
        for (int g = 0; g < 2; ++g) { const int kb = d0 * 128 + g * 64; kreg[g] = *(const u32x4*)(kg + (size_t)kb * LDAB); vreg[g] = *(const u32x4*)(vg + kb); }
        __syncthreads();
#pragma unroll
        for (int g = 0; g < 2; ++g) {
            *(u32x4*)(shm + g * 8192 + kwoff) = kreg[g];
            *(u32x2*)(shm + g * 8192 + vwoff0) = (u32x2){vreg[g].x, vreg[g].y}; *(u32x2*)(shm + g * 8192 + vwoff1) = (u32x2){vreg[g].z, vreg[g].w};
        }
        __syncthreads();
        for (int idx = 0; idx < nstage; ++idx) {
            const int kt = idx < nright ? d0 + idx : d0 - 1 - (idx - nright);
            const int buf = idx & 1;
            if (idx + 1 < nstage) {
                const int idn = idx + 1; const int ktn = idn < nright ? d0 + idn : d0 - 1 - (idn - nright);
#pragma unroll
                for (int g = 0; g < 2; ++g) { const int kbn = ktn * 128 + g * 64; kreg[g] = *(const u32x4*)(kg + (size_t)kbn * LDAB); vreg[g] = *(const u32x4*)(vg + kbn); }
            }
#pragma unroll
            for (int g = 0; g < 2; ++g) {
            const unsigned char* Ks = shm + buf * 16384 + g * 8192; const unsigned char* Vs = shm + 32768 + buf * 16384 + g * 8192;
#pragma unroll
            for (int j = 0; j < 2; ++j) {
                const int kb = kt * 128 + g * 64 + 32 * j;
                bf16x8 kf[2][2], vf[2][2];
#pragma unroll
                for (int mp = 0; mp < 2; ++mp)
#pragma unroll
                    for (int st = 0; st < 2; ++st) kf[mp][st] = *(const bf16x8*)(Ks + (32 * j + r32) * 128 + (((mp * 4 + 2 * st + hh) ^ (r32 & 7)) * 16));
#pragma unroll
                for (int dt = 0; dt < 2; ++dt)
#pragma unroll
                    for (int s_ = 0; s_ < 2; ++s_) vf[dt][s_] = *(const bf16x8*)(Vs + (32 * dt + r32) * 128 + (((4 * j + 2 * s_ + hh) ^ (r32 & 7)) * 16));
                float qoff = (float)(kb + 4 * hh - qi); asm volatile("" : "+v"(qoff));
                f32x16 tA, tB;
                if (kb >= q0 + 32 || kb + 32 <= q0) {
                    const bool right = kb >= q0 + 32;
                    const float Lq = right ? -slope2 * qoff : slope2 * qoff;
                    const float LA = Lq - mA, LB = Lq - mB, sl = right ? -slope2 : slope2;
#pragma unroll
                    for (int reg = 0; reg < 16; ++reg) { tA[reg] = __builtin_fmaf(sl, CRW(reg), LA); tB[reg] = __builtin_fmaf(sl, CRW(reg), LB); }
                } else {
#pragma unroll
                    for (int reg = 0; reg < 16; ++reg) { const float bias = -slope2 * fabsf(qoff + CRW(reg)); tA[reg] = bias - mA; tB[reg] = bias - mB; }
                }
                tA = MFMA32(kf[0][0], qf[0][0], tA); tA = MFMA32(kf[0][1], qf[0][1], tA);
                tB = MFMA32(kf[1][0], qf[1][0], tB); tB = MFMA32(kf[1][1], qf[1][1], tB);
                float mxA = 0.f, mxB = 0.f;
#pragma unroll
                for (int reg = 0; reg < 16; ++reg) { mxA = fmaxf(mxA, tA[reg]); mxB = fmaxf(mxB, tB[reg]); }
                mxA = fmaxf(mxA, __shfl_xor(mxA, 32)); mxB = fmaxf(mxB, __shfl_xor(mxB, 32));
                if (__builtin_amdgcn_ballot_w64(mxA > 0.f) != 0ull) {
                    const float alpha = fexp2(-mxA); mA += mxA; lA *= alpha;
#pragma unroll
                    for (int i = 0; i < 16; ++i) { OA[0][i] *= alpha; OA[1][i] *= alpha; tA[i] -= mxA; }
                }
                if (__builtin_amdgcn_ballot_w64(mxB > 0.f) != 0ull) {
                    const float alpha = fexp2(-mxB); mB += mxB; lB *= alpha;
#pragma unroll
                    for (int i = 0; i < 16; ++i) { OBb[0][i] *= alpha; OBb[1][i] *= alpha; tB[i] -= mxB; }
                }
                float psA = 0.f, psB = 0.f;
#pragma unroll
                for (int reg = 0; reg < 16; ++reg) { tA[reg] = fexp2(tA[reg]); psA += tA[reg]; tB[reg] = fexp2(tB[reg]); psB += tB[reg]; }
                lA += psA; lB += psB;
                const bf16x8 pA0 = packpv(tA, 0), pA1 = packpv(tA, 1), pB0 = packpv(tB, 0), pB1 = packpv(tB, 1);
#pragma unroll
                for (int dt = 0; dt < 2; ++dt) {
                    OA[dt] = MFMA32(vf[dt][0], pA0, OA[dt]); OA[dt] = MFMA32(vf[dt][1], pA1, OA[dt]);
                    OBb[dt] = MFMA32(vf[dt][0], pB0, OBb[dt]); OBb[dt] = MFMA32(vf[dt][1], pB1, OBb[dt]);
                }
            }
            }
            if (idx + 1 < nstage) {
                unsigned char* wb = shm + (buf ^ 1) * 16384;
#pragma unroll
                for (int g = 0; g < 2; ++g) {
                    *(u32x4*)(wb + g * 8192 + kwoff) = kreg[g];
                    *(u32x2*)(wb + g * 8192 + vwoff0) = (u32x2){vreg[g].x, vreg[g].y}; *(u32x2*)(wb + g * 8192 + vwoff1) = (u32x2){vreg[g].z, vreg[g].w};
                }
            }
            __syncthreads();
        }
        lA += __shfl_xor(lA, 32); lB += __shfl_xor(lB, 32);
        const float iA = 1.f / lA, iB = lam / lB;
        float ss = 0.f;
#pragma unroll
        for (int dt = 0; dt < 2; ++dt)
#pragma unroll
            for (int i = 0; i < 16; ++i) { const float v = OA[dt][i] * iA - OBb[dt][i] * iB; OA[dt][i] = v; ss += v * v; }
        ss += __shfl_xor(ss, 32);
        const float rstd = __builtin_amdgcn_rsqf(ss * (1.f / 64.f) + EPS) * (1.f - lam_init);
        bf16_t* orow = OB + ((size_t)b * SEQ + qi) * DM + 384 + h * 64;
#pragma unroll
        for (int dt = 0; dt < 2; ++dt)
#pragma unroll
            for (int g4 = 0; g4 < 4; ++g4) {
                const int d = 32 * dt + 8 * g4 + 4 * hh;
                const f32x4 gv = *(const f32x4*)(dg + d);
                u32x2 w = {pk2(OA[dt][4 * g4] * rstd * gv[0], OA[dt][4 * g4 + 1] * rstd * gv[1]), pk2(OA[dt][4 * g4 + 2] * rstd * gv[2], OA[dt][4 * g4 + 3] * rstd * gv[3])};
                *(u32x2*)(orow + d) = w;
            }
    }
    for (int item = first_win; item < 768;) {
        int tid = tid0; asm volatile("" : "+v"(tid));
        win_block(p, l, item - 512, tid, shm);
        __syncthreads();
        if (tid == 0) sq[0] = atomicAdd(qctr, 1u);
        __syncthreads();
        item = (int)sq[0];
    }
}

DI void phase_post(const Params& p, int l, int gw, int nw, int lane) {
    unsigned char* ws = p.ws;
    const bf16_t* OT = (const bf16_t*)(ws + OFF_WB); const bf16_t* PAB = (const bf16_t*)(ws + OFF_PAB); bf16_t* OB = (bf16_t*)(ws + OFF_OB);
    const float gl = p.in[12][l * 64 + lane];
    for (int u = gw; u < 6144; u += nw) {
        const int half = u & 1, h = (u % 12) >> 1, ck = u / 12, b = ck >> 7, chunk = ck & 127;
        const size_t itf = ((size_t)((b * 6 + h) * 2) * 128 + chunk), itb = ((size_t)((b * 6 + h) * 2 + 1) * 128 + (127 - chunk));
        const size_t tok0 = (size_t)b * SEQ + chunk * 64 + half * 32;
#pragma unroll 1
        for (int g = 0; g < 2; ++g) {
            float av[16], zv[16];
#pragma unroll
            for (int j = 0; j < 16; ++j) {
                const int t = half * 32 + g * 16 + j;
                av[j] = bf2f(OT[itf * 4096 + t * 64 + lane]) + bf2f(OT[itb * 4096 + (63 - t) * 64 + lane]);
                zv[j] = bf2f(PAB[(tok0 + g * 16 + j) * LDAB + 1408 + h * 64 + lane]);
            }
#pragma unroll
            for (int j = 0; j < 16; ++j) {
                const float ss = wave_sum(av[j] * av[j]);
                const float y = av[j] * __builtin_amdgcn_rsqf(ss * (1.f / 64.f) + EPS) * gl;
                OB[(tok0 + g * 16 + j) * DM + 640 + h * 64 + lane] = f2bf(y * silu(zv[j]));
            }
        }
    }
}

#define XB_TMO      128
#define XB_XCNT(j)  (256  + 64 * (j))
#define XB_XSUB(j)  (1280 + 64 * (j))
#define XB_XGEN(j)  (2304 + 64 * (j))
#define XB_TOP      3328
#define XB_TOPGEN   3392
#define XCD_BAR_WORDS 3456
#define XB_SPIN_CAP (1u << 18)
DI unsigned xb_ld(unsigned* p)              { return __hip_atomic_load(p, __ATOMIC_RELAXED, __HIP_MEMORY_SCOPE_AGENT); }
DI unsigned xb_add(unsigned* p, unsigned v) { return __hip_atomic_fetch_add(p, v, __ATOMIC_RELAXED, __HIP_MEMORY_SCOPE_AGENT); }
DI unsigned xb_xcc_id() { return (unsigned)__builtin_amdgcn_s_getreg((3 << 11) | 20) & 0xFu; }
#define XB_SPIN(cond, bar) do { unsigned _sp = 0; while (cond) { __builtin_amdgcn_s_sleep(1); \
    if ((++_sp & 255u) == 0u) { if (xb_ld(&(bar)[XB_TMO])) break; if (_sp > XB_SPIN_CAP) { atomicAdd(&(bar)[XB_TMO], 1u); break; } } } } while (0)
struct XcdBarrier { unsigned* bar; unsigned x; volatile LAS unsigned* st; };
DI XcdBarrier xcd_barrier_post(unsigned* bar, volatile LAS unsigned* st) {
    XcdBarrier b; b.bar = bar; b.x = xb_xcc_id(); b.st = st;
    if (threadIdx.x == 0) (void)xb_add(&bar[XB_XCNT(b.x)], 1u);
    return b;
}
DI void xcd_barrier_complete(unsigned* bar, unsigned x, unsigned& nloc, unsigned& nx) {
    const unsigned G = gridDim.x * gridDim.y * gridDim.z;
    unsigned sum, cnt, mine, sp = 0u;
    for (;;) {
        sum = 0u; cnt = 0u; mine = 0u;
#pragma unroll
        for (unsigned j = 0; j < 16; ++j) { const unsigned c = xb_ld(&bar[XB_XCNT(j)]); sum += c; cnt += (c > 0u) ? 1u : 0u; mine = (j == x) ? c : mine; }
        if (sum == G) break;
        __builtin_amdgcn_s_sleep(1);
        if ((++sp & 255u) == 0u) { if (xb_ld(&bar[XB_TMO])) break; if (sp > XB_SPIN_CAP) { atomicAdd(&bar[XB_TMO], 1u); break; } }
    }
    nloc = mine > 0u ? mine : 1u; nx = cnt > 0u ? cnt : 1u;
}
DI void xcd_barrier(const XcdBarrier& b) {
    asm volatile("s_waitcnt vmcnt(0)" ::: "memory");
    __syncthreads();
    if (threadIdx.x == 0) {
        unsigned* bar = b.bar;
        __builtin_amdgcn_s_waitcnt(0);
        unsigned nloc = b.st[0], nx = b.st[1];
        if (nloc == 0u) { xcd_barrier_complete(bar, b.x, nloc, nx); b.st[0] = nloc; b.st[1] = nx; }
        const unsigned old = xb_add(&bar[XB_XSUB(b.x)], 1u);
        const unsigned gen = old / nloc;
        if (old + 1u == (gen + 1u) * nloc) {
            __builtin_amdgcn_fence(__ATOMIC_RELEASE, "agent");
            asm volatile("s_waitcnt vmcnt(0)" ::: "memory");
            const unsigned og = xb_add(&bar[XB_TOP], 1u);
            const unsigned tg = og / nx;
            if (og + 1u == (tg + 1u) * nx) xb_add(&bar[XB_TOPGEN], 1u);
            else XB_SPIN(xb_ld(&bar[XB_TOPGEN]) == tg, bar);
            __builtin_amdgcn_fence(__ATOMIC_ACQUIRE, "agent");
            xb_add(&bar[XB_XGEN(b.x)], 1u);
            asm volatile("s_waitcnt vmcnt(0)" ::: "memory");
        } else {
            XB_SPIN(xb_ld(&bar[XB_XGEN(b.x)]) == gen, bar);
            __builtin_amdgcn_fence(__ATOMIC_ACQUIRE, "agent");
            asm volatile("s_waitcnt vmcnt(0)" ::: "memory");
        }
    }
    __syncthreads();
}

constexpr int NPHASE = 30;
DI void run_phase(const Params& p, int ph, unsigned char* shm, int tid) {
    const int wid = tid >> 6, lane = tid & 63;
    const int gw = blockIdx.x * 8 + wid, nw = gridDim.x * 8;
    unsigned char* ws = p.ws;
    if (ph == 0) { if (EN(0)) { phase_init(p, gw, nw, lane); phase_convw(p, 0, shm, tid); } return; }
    if (ph == NPHASE - 1) { if (EN(27)) phase_final(p, gw, nw, lane); return; }
    const int l = (ph - 1) / 14, sub = (ph - 1) % 14;
    float* rss = (float*)(ws + OFF_RSS);
    bf16_t* XB = (bf16_t*)(ws + OFF_XB);
    LAS unsigned char* lds = (LAS unsigned char*)shm;
    pg8::StaticOrder S;
    if (sub == 0) { if (EN(0)) if (l > 0) phase_convw(p, l, shm, tid); return; }
    if (EN(1)) if (sub == 1 || sub == 12) {
        const int f = sub == 1 ? 0 : 1;
        pg8::Gemm g{XB, (const bf16_t*)(ws + (f ? OFF_W_FFN2IN : OFF_W_FFN1IN)), MTOK, NFF, DM};
        EpiSwiglu E{(bf16_t*)(ws + OFF_BIG), rss + (size_t)((3 * l + (f ? 2 : 0)) & 1) * MTOK * 16};
        S.init(MTOK, NFF, gridDim.x, blockIdx.x);
        pg8::gemm_phase(tid, lds, g, S, E);
        if ((REPMASK >> 1) & 1) { __syncthreads(); pg8::gemm_phase(tid, lds, g, S, E); }
        return;
    }
    if (EN(2)) if (sub == 2 || sub == 13 || sub == 11) {
        const bf16_t* A; const bf16_t* Bt; int K; float scale; int nn;
        if (sub == 2) { A = (const bf16_t*)(ws + OFF_BIG); Bt = (const bf16_t*)(ws + OFF_W_FFN1OUT); K = DFFP; scale = 0.5f; nn = 3 * l + 1; }
        else if (sub == 13) { A = (const bf16_t*)(ws + OFF_BIG); Bt = (const bf16_t*)(ws + OFF_W_FFN2OUT); K = DFFP; scale = 0.5f; nn = 3 * l + 3; }
        else { A = (const bf16_t*)(ws + OFF_OB); Bt = (const bf16_t*)(ws + OFF_W_MIXOUT); K = DM; scale = 1.f; nn = 3 * l + 2; }
        pg8::Gemm g{A, Bt, MTOK, DM, K};
        EpiResid E{(l == 0 && sub == 2) ? p.in[0] : (const float*)p.out, p.out, XB, rss + (size_t)(nn & 1) * MTOK * 16, scale};
        S.init(MTOK, DM, gridDim.x, blockIdx.x);
        pg8::gemm_phase(tid, lds, g, S, E); return;
    }
    if (EN(3)) if (sub == 3) {
        pg8::Gemm g{XB, (const bf16_t*)(ws + OFF_W_MIXIN), MTOK, NMIX, DM};
        EpiMixIn E{(bf16_t*)(ws + OFF_PAB), (bf16_t*)(ws + OFF_PC), (float*)(ws + OFF_BG), rss + (size_t)((3 * l + 1) & 1) * MTOK * 16};
        S.init(MTOK, NMIX, gridDim.x, blockIdx.x);
        pg8::gemm_phase(tid, lds, g, S, E);
        return;
    }
    if (EN(4)) if (sub == 4) { REP(4) phase_prep(p, l, gw, nw, lane); return; }
    if (EN(5)) if (sub == 5) { REP(5) phase_chunk(p, l, gw, nw, lane, wid, shm); return; }
    if (EN(6)) if (sub == 6) {
        if (blockIdx.x < 48) phase_scan(p, lane, wid, shm);
        phase_diff(p, l, tid, shm);
        return;
    }
    if (EN(10)) if (sub == 7) { phase_outp(p, gw, nw, lane); return; }


    if (EN(9)) if (sub == 10) { REP(9) phase_post(p, l, gw, nw, lane); return; }
}

__global__ __launch_bounds__(512, 2) void mega(Params p) {
    extern __shared__ __attribute__((aligned(16))) unsigned char shm[];
    __shared__ uint4 xb_words;
    if (threadIdx.x == 0) xb_words = make_uint4(0u, 0u, 0u, 0u);
    __syncthreads();
    const XcdBarrier xb = xcd_barrier_post((unsigned*)(p.ws + OFF_BAR), (volatile LAS unsigned*)&xb_words);
#ifndef PROBE_DUP
    for (int ph = p.p0; ph < p.p1; ++ph) {
        if (ph == 1 || ph == 9 || ph == 10 || ph == 23 || ph == 24) continue;
        int tid = threadIdx.x; asm volatile("" : "+v"(tid));
        Params q = p;
#if defined(__HIP_DEVICE_COMPILE__)
        {
            typedef __attribute__((address_space(1))) unsigned char GUC; typedef __attribute__((address_space(1))) float GF; typedef __attribute__((address_space(1))) const float GCF;
            unsigned long long wsi = (unsigned long long)p.ws, oi = (unsigned long long)p.out; asm volatile("" : "+s"(wsi), "+s"(oi));
            q.ws = (unsigned char*)(GUC*)wsi; q.out = (float*)(GF*)oi;
#pragma unroll
            for (int ii = 0; ii < 18; ++ii) q.in[ii] = (const float*)(GCF*)(unsigned long long)p.in[ii];
        }
#endif
        run_phase(q, ph, shm, tid);
        if (ph + 1 < p.p1) {
            if (ph == 0) cg::this_grid().sync();
            else xcd_barrier(xb);
        }
    }
#else
    for (int st = 0; st < 2 * NPHASE; ++st) {
        const int ph = st >> 1;
        if (ph == 1 || ph == 9 || ph == 10 || ph == 23 || ph == 24) continue;
        const int subp = (ph >= 1 && ph <= 28) ? (ph - 1) % 14 : (ph == 0 ? 14 : 15);
        if ((st & 1) && !((PROBE_DUP >> subp) & 1)) continue;
        int tid = threadIdx.x; asm volatile("" : "+v"(tid));
        Params q = p; asm volatile("" : "+s"(q.ws), "+s"(q.out));
        run_phase(q, ph, shm, tid);
        cg::this_grid().sync();
    }
#endif
}

extern "C" void kernel_launch(void* const* d_in, const int* in_sizes, int n_in, void* d_out, int out_size, void* d_ws, size_t ws_size, hipStream_t stream) {
    static int grid = 0;
    if (!grid) {
        hipFuncSetAttribute((const void*)mega, hipFuncAttributeMaxDynamicSharedMemorySize, LDS_BYTES);
        int dev = 0, cus = 0, per = 0;
        hipGetDevice(&dev);
        hipDeviceGetAttribute(&cus, hipDeviceAttributeMultiprocessorCount, dev);
        hipOccupancyMaxActiveBlocksPerMultiprocessor(&per, mega, 512, LDS_BYTES);
        if (per < 1) per = 1;
        grid = cus * per;
        if (grid > 256) grid = 256;
    }
    (void)hipMemsetAsync((unsigned char*)d_ws + OFF_BAR, 0, 3456 * 4, stream);
    Params p{};
    for (int i = 0; i < 18; ++i) p.in[i] = (const float*)d_in[i];
    p.out = (float*)d_out; p.ws = (unsigned char*)d_ws;
#if MULTI
    for (int ph = 0; ph < NPHASE; ++ph) {
        if (ph == 1 || ph == 9 || ph == 10 || ph == 23 || ph == 24) continue;
        p.p0 = ph; p.p1 = ph + 1;
        hipLaunchKernelGGL(mega, dim3(grid), dim3(512), LDS_BYTES, stream, p);
    }
#else
    p.p0 = 0; p.p1 = NPHASE;
    void* args[] = {&p};
    hipError_t e = hipLaunchCooperativeKernel((const void*)mega, dim3(grid), dim3(512), args, LDS_BYTES, stream);
    if (e != hipSuccess) fprintf(stderr, "cooperative launch failed: %s (grid %d)\n", hipGetErrorString(e), grid);
#endif
}
```
